# Optimizing an MI355X kernel written in HIP

```python
import math
import jax, jax.numpy as jnp
from jax import lax
import numpy as np

D_MODEL = 1024
BATCH = 8
SEQ = 2048
DEPTH = 2
DEC_BATCH = 8
DEC_SEQ = 8192
PAST_LEN = 128

HEAD_DIM = 64
D_MIX = D_MODEL
D_DIL = 3 * D_MIX // 8
D_NA = D_MIX // 4
D_CONV = D_MIX - D_DIL - D_NA
N_DIL_HEADS = D_DIL // HEAD_DIM
N_NA_HEADS = D_NA // HEAD_DIM
D_IN = 3 * D_MIX
CONV_WIDTH = 3
DIL_BRANCHES = ((128, 1), (512, 4), (2048, 16))
DIL_BLOCK = 128
GRID_W = 64
NA_ROWS = 8
NA_COLS = 16
NA_COL_BLOCK = 16
NA_KEY_COLS = 32
ROPE_THETA = 10000.0
D_FF = -(-8 * D_MODEL // (3 * 256)) * 256
RMS_EPS = 1e-6

kernel_name = 'hybrid_bidir_conv_dilated_natten_encoder'


def rmsnorm(x, g):
    xf = x.astype(jnp.float32)
    y = xf * lax.rsqrt(jnp.mean(xf * xf, axis=-1, keepdims=True) + RMS_EPS)
    return (y * g.astype(jnp.float32)).astype(x.dtype)


def rope(x, pos):
    hd = x.shape[-1]
    inv = 1.0 / (ROPE_THETA ** (jnp.arange(0, hd, 2, dtype=jnp.float32) / hd))
    ang = pos[:, None] * inv[None, :]
    cos = jnp.cos(ang)[None, :, None, :]
    sin = jnp.sin(ang)[None, :, None, :]
    x1, x2 = jnp.split(x.astype(jnp.float32), 2, axis=-1)
    out = jnp.concatenate([x1 * cos - x2 * sin, x1 * sin + x2 * cos], axis=-1)
    return out.astype(x.dtype)


def masked_softmax(scores, mask):
    s = jnp.where(mask, scores, -jnp.inf)
    lse = jax.nn.logsumexp(s, axis=-1, keepdims=True)
    return jnp.exp(s - lse), lse[..., 0]


def dilated_branch(q, k, v, window, dilation):
    b, h, s, hd = q.shape
    half = window // (2 * dilation)
    L = s // dilation
    qb = math.gcd(L, DIL_BLOCK)
    nb = L // qb
    klen = qb + 2 * half

    def residues(t):
        return t.reshape(b, h, L, dilation, hd).swapaxes(2, 3)

    qr = residues(q).reshape(b, h, dilation, nb, qb, hd)
    pad = ((0, 0), (0, 0), (0, 0), (half, half), (0, 0))
    kp = jnp.pad(residues(k), pad)
    vp = jnp.pad(residues(v), pad)
    blk = np.arange(nb)
    kk = np.arange(klen)
    qq = np.arange(qb)
    idx = blk[:, None] * qb + kk[None, :]
    kw = kp[:, :, :, idx, :]
    vw = vp[:, :, :, idx, :]
    scores = jnp.einsum('bhrnqe,bhrnke->bhrnqk', qr, kw,
                        preferred_element_type=jnp.float32) * (hd ** -0.5)
    off = kk[None, :] - half - qq[:, None]
    key_pos = idx - half
    mask = (np.abs(off) <= half)[None] & ((key_pos >= 0) & (key_pos < L))[:, None, :]
    p, lse = masked_softmax(scores, mask)
    out = jnp.einsum('bhrnqk,bhrnke->bhrnqe', p.astype(v.dtype), vw,
                     preferred_element_type=jnp.float32)
    out = out.reshape(b, h, dilation, L, hd).swapaxes(2, 3).reshape(b, h, s, hd)
    lse = lse.reshape(b, h, dilation, L).swapaxes(2, 3).reshape(b, h, s)
    return out, lse


def dilated_attention(q, k, v):
    outs, lses = [], []
    for window, dilation in DIL_BRANCHES:
        o, l = dilated_branch(q, k, v, window, dilation)
        outs.append(o)
        lses.append(l)
    w = jax.nn.softmax(jnp.stack(lses, axis=0), axis=0)
    return jnp.einsum('gbhs,gbhse->bhse', w, jnp.stack(outs, axis=0))


def neighbourhood_attention(q, k, v, rpb):
    b, h, s, hd = q.shape
    rows = s // GRID_W
    wr = min(NA_ROWS, rows)
    ncb = GRID_W // NA_COL_BLOCK
    nk = wr * NA_KEY_COLS
    r = np.arange(rows)
    row_start = np.clip(r - wr // 2, 0, rows - wr)
    key_rows = row_start[:, None] + np.arange(wr)
    c0 = np.arange(ncb) * NA_COL_BLOCK
    kc0 = np.clip(c0 - NA_COLS // 2, 0, GRID_W - NA_KEY_COLS)
    key_cols = kc0[:, None] + np.arange(NA_KEY_COLS)
    key_idx = (key_rows[:, None, :, None] * GRID_W
               + key_cols[None, :, None, :]).reshape(rows, ncb, nk)
    kg = k[:, :, key_idx, :]
    vg = v[:, :, key_idx, :]
    qg = q.reshape(b, h, rows, ncb, NA_COL_BLOCK, hd)
    scores = jnp.einsum('bhrcqe,bhrcke->bhrcqk', qg, kg,
                        preferred_element_type=jnp.float32) * (hd ** -0.5)
    qc = c0[:, None] + np.arange(NA_COL_BLOCK)
    col_start = np.clip(qc - NA_COLS // 2, 0, GRID_W - NA_COLS)
    kcol = np.broadcast_to(key_cols[:, None, :], (ncb, wr, NA_KEY_COLS)).reshape(ncb, nk)
    col_ok = (kcol[:, None, :] >= col_start[:, :, None]) & (kcol[:, None, :] < col_start[:, :, None] + NA_COLS)
    drow = np.broadcast_to(key_rows[:, :, None] - r[:, None, None], (rows, wr, NA_KEY_COLS)).reshape(rows, nk)
    dcol = kcol[:, None, :] - qc[:, :, None]
    ri = drow + NA_ROWS - 1
    ci = np.clip(dcol + NA_COLS - 1, 0, 2 * NA_COLS - 2)
    bias = rpb[:, ri[:, None, None, :], ci[None, :, :, :]]
    scores = scores + bias[None].astype(jnp.float32)
    p, _ = masked_softmax(scores, col_ok)
    out = jnp.einsum('bhrcqk,bhrcke->bhrcqe', p.astype(v.dtype), vg,
                     preferred_element_type=jnp.float32)
    return out.reshape(b, h, s, hd)


def short_conv_mixer(gate_b, gate_c, h_in, conv_w):
    u = gate_c * h_in
    conv = lax.conv_general_dilated(
        u, conv_w[:, None, :].astype(u.dtype), window_strides=(1,),
        padding=((CONV_WIDTH // 2, CONV_WIDTH // 2),),
        dimension_numbers=('NWC', 'WIO', 'NWC'), feature_group_count=u.shape[-1])
    return gate_b * conv


def encoder_layer(x, g_pre_mix, w_in, conv_w, rpb, w_out, g_post_mix,
                  g_pre_ffn, w_gate, w_up, w_down, g_post_ffn):
    b, s, _ = x.shape
    hn = rmsnorm(x, g_pre_mix)
    proj = hn @ w_in
    sizes = [D_DIL] * 3 + [D_NA] * 3 + [D_CONV] * 3
    cuts = list(np.cumsum(sizes)[:-1])
    q_d, k_d, v_d, q_n, k_n, v_n, gate_b, gate_c, h_in = jnp.split(proj, cuts, axis=-1)

    pos = jnp.arange(s, dtype=jnp.float32)
    heads = lambda t, n: t.reshape(b, s, n, HEAD_DIM)
    to_bhsd = lambda t: t.transpose(0, 2, 1, 3)
    qd = to_bhsd(rope(heads(q_d, N_DIL_HEADS), pos))
    kd = to_bhsd(rope(heads(k_d, N_DIL_HEADS), pos))
    vd = to_bhsd(heads(v_d, N_DIL_HEADS))
    y_dil = dilated_attention(qd, kd, vd).astype(x.dtype)
    y_dil = y_dil.transpose(0, 2, 1, 3).reshape(b, s, D_DIL)

    qn = to_bhsd(heads(q_n, N_NA_HEADS))
    kn = to_bhsd(heads(k_n, N_NA_HEADS))
    vn = to_bhsd(heads(v_n, N_NA_HEADS))
    y_na = neighbourhood_attention(qn, kn, vn, rpb).astype(x.dtype)
    y_na = y_na.transpose(0, 2, 1, 3).reshape(b, s, D_NA)

    y_conv = short_conv_mixer(gate_b, gate_c, h_in, conv_w)

    mixed = jnp.concatenate([y_dil, y_na, y_conv], axis=-1) @ w_out
    x = x + rmsnorm(mixed, g_post_mix)

    hf = rmsnorm(x, g_pre_ffn)
    f = (jax.nn.silu(hf @ w_gate) * (hf @ w_up)) @ w_down
    return x + rmsnorm(f, g_post_ffn)


def setup_inputs(seed: int = 0) -> dict:
    key = jax.random.key(seed)
    ks = jax.random.split(key, 14)
    nrm = lambda k, shape, scale: jax.random.normal(k, shape, jnp.float32) * scale
    gain = lambda k: 1.0 + 0.05 * jax.random.normal(k, (DEPTH, D_MODEL), jnp.float32)
    return {
        'x_prompt': nrm(ks[0], (BATCH, SEQ, D_MODEL), 1.0),
        'x_sample': nrm(ks[1], (DEC_BATCH, DEC_SEQ, D_MODEL), 1.0),
        'g_pre_mix': gain(ks[2]),
        'w_in': nrm(ks[3], (DEPTH, D_MODEL, D_IN), D_MODEL ** -0.5),
        'conv_w': nrm(ks[4], (DEPTH, CONV_WIDTH, D_CONV), CONV_WIDTH ** -0.5),
        'rpb': nrm(ks[5], (DEPTH, N_NA_HEADS, 2 * NA_ROWS - 1, 2 * NA_COLS - 1), 0.2),
        'w_out': nrm(ks[6], (DEPTH, D_MIX, D_MODEL), D_MIX ** -0.5),
        'g_post_mix': gain(ks[7]),
        'g_pre_ffn': gain(ks[8]),
        'w_gate': nrm(ks[9], (DEPTH, D_MODEL, D_FF), D_MODEL ** -0.5),
        'w_up': nrm(ks[10], (DEPTH, D_MODEL, D_FF), D_MODEL ** -0.5),
        'w_down': nrm(ks[11], (DEPTH, D_FF, D_MODEL), D_FF ** -0.5),
        'g_post_ffn': gain(ks[12]),
    }


def reference(x_prompt, x_sample, g_pre_mix, w_in, conv_w, rpb, w_out, g_post_mix,
              g_pre_ffn, w_gate, w_up, w_down, g_post_ffn):
    y_prompt = x_prompt
    y_sample = x_sample
    for l in range(DEPTH):
        y_prompt = encoder_layer(y_prompt, g_pre_mix[l], w_in[l], conv_w[l], rpb[l], w_out[l],
                                 g_post_mix[l], g_pre_ffn[l], w_gate[l], w_up[l], w_down[l],
                                 g_post_ffn[l])
        y_sample = encoder_layer(y_sample, g_pre_mix[l], w_in[l], conv_w[l], rpb[l], w_out[l],
                                 g_post_mix[l], g_pre_ffn[l], w_gate[l], w_up[l], w_down[l],
                                 g_post_ffn[l])
    return (y_prompt, y_sample)
```

```cpp
#include <hip/hip_runtime.h>
#include <hip/hip_cooperative_groups.h>
#include <cstdio>
namespace cg = cooperative_groups;
namespace pg8 {
#define PG8_LAS __attribute__((address_space(3)))
typedef unsigned short bf16_t;
typedef short bf16x8 __attribute__((ext_vector_type(8)));
typedef float f32x4 __attribute__((ext_vector_type(4)));
typedef unsigned u32x4 __attribute__((ext_vector_type(4)));
constexpr int BM = 256, BK = 64, HALF = 128, HTB = HALF * BK * 2  , STAGE_BYTES = 8 * HTB, NXCD = 8, WGM = 8;

__host__ __device__ __forceinline__ int lds_byte(int r, int c) { const int st = (r >> 4) * 2 + (c >> 5), rr = r & 15, cc = c & 31, ob = rr * 64 + cc * 2; return st * 1024 + (ob ^ (((ob >> 9) & 1) << 5)); }
__host__ __device__ __forceinline__ void stage_rc(int b, int& R, int& C) { const int st = b / 1024, sb = b % 1024, swz = sb ^ (((sb >> 9) & 1) << 5); R = (st >> 1) * 16 + swz / 64; C = (st & 1) * 32 + (swz % 64) / 2; }
__host__ __device__ __forceinline__ int perm32(int rho) { const int n = rho >> 4, i = rho & 15; return 8 * (i >> 2) + 4 * n + (i & 3); }

struct Unit { int pm, pn; };
struct Gemm { const bf16_t* A; const bf16_t* Bt; int M, N, K; };

struct StaticOrder {
    int nM, nN, nwg, G, c;
    __host__ __device__ void init(int M, int N, int G_, int c_) { nM = M / BM; nN = N / BM; nwg = nM * nN; G = G_; c = c_; }
    __host__ __device__ bool next(int i, Unit& u) const {
        const long L = (long)i * G + c; if (L >= nwg) return false;
        int wgid = (int)L; { const int q = nwg / NXCD, r = nwg % NXCD, xcd = wgid % NXCD, off = wgid / NXCD; wgid = (xcd < r ? xcd * (q + 1) : r * (q + 1) + (xcd - r) * q) + off; }
        const int nig = WGM * nN, gid = wgid / nig, fm = gid * WGM, gsz = (nM - fm) < WGM ? (nM - fm) : WGM;
        u.pm = fm + ((wgid % nig) % gsz); u.pn = (wgid % nig) / gsz; return true;
    }
    __device__ __forceinline__ void a_ready(const Unit&) const {}
    __device__ __forceinline__ void done(const Unit&) const {}
};
__device__ __forceinline__ unsigned cvt_pk_bf16(float lo, float hi) { unsigned r; asm volatile("v_cvt_pk_bf16_f32 %0, %1, %2" : "=v"(r) : "v"(lo), "v"(hi)); return r; }
typedef float f32x2 __attribute__((ext_vector_type(2)));
template <class Epi, class Sched, bool STAMP = false>
__device__ __forceinline__ void gemm_phase(PG8_LAS unsigned char* lds, const Gemm g, const Sched& S, const Epi& E, unsigned long long* stamps) {
    int tid_ = threadIdx.x; asm volatile("" : "+v"(tid_));
    const int tid = tid_, wid = __builtin_amdgcn_readfirstlane(tid >> 6), lane = tid & 63, wr = wid >> 2, wc = wid & 3, fr = lane & 15, fq = lane >> 4;
    const int K = g.K, nt = K / BK;
    int ts_lo = 0, ts_hi = 0, nts = 0; const unsigned long long rt_entry = STAMP ? (unsigned long long)wall_clock64() : 0ull;
#define PG8_STAMP() do { if (STAMP && wid == 0 && nts < 64) { const unsigned long long _c = (unsigned long long)clock64(); \
        ts_lo = (lane == nts) ? (int)(unsigned)_c : ts_lo; ts_hi = (lane == nts) ? (int)(unsigned)(_c >> 32) : ts_hi; ++nts; } } while (0)
    PG8_STAMP();
    unsigned voffA[2], voffB[2];
#pragma unroll
    for (int i = 0; i < 2; ++i) { int R, C; stage_rc(tid * 16 + i * 8192, R, C); const int Rb = Epi::PERM ? ((R & ~31) + perm32(R & 31)) : R;
        voffA[i] = (unsigned)(R * K + C) * 2u; voffB[i] = (unsigned)(Rb * K + C) * 2u; }
    const size_t kstep = (size_t)(BK * 2);
    const size_t hstep = (size_t)HALF * K * 2;
    const size_t tstep = 2 * hstep;
    const unsigned ldsw = (unsigned)wid * 1024u;
    const int aoff = lds_byte(wr * 64 + fr, fq * 8), boff = lds_byte(wc * 32 + fr, fq * 8);
#define PG8_SA(b, h) (((b) * 2 + (h)) * HTB)
#define PG8_SB(b, h) ((4 + (b) * 2 + (h)) * HTB)
#define PG8_STAGE(bufoff, gbase, voff) do { _Pragma("unroll") for (int _i = 0; _i < 2; ++_i) \
        __builtin_amdgcn_global_load_lds((const unsigned*)((const char*)(gbase) + (voff)[_i]), (PG8_LAS unsigned*)(lds + (bufoff) + ldsw + _i * 8192), 16, 0, 0); } while (0)
#define PG8_LDA(dst, b, h) do { _Pragma("unroll") for (int m = 0; m < 4; ++m) _Pragma("unroll") for (int k = 0; k < 2; ++k) dst[m][k] = *(const PG8_LAS bf16x8*)(lds + PG8_SA(b, h) + aoff + m * 2048 + k * 1024); } while (0)
#define PG8_LDB(dst, b, h) do { _Pragma("unroll") for (int n = 0; n < 2; ++n) _Pragma("unroll") for (int k = 0; k < 2; ++k) dst[n][k] = *(const PG8_LAS bf16x8*)(lds + PG8_SB(b, h) + boff + n * 2048 + k * 1024); } while (0)
#define PG8_MMA(ai, bj, At, Bt) do { __builtin_amdgcn_s_setprio(1); _Pragma("unroll") for (int m = 0; m < 4; ++m) _Pragma("unroll") for (int n = 0; n < 2; ++n) _Pragma("unroll") for (int k = 0; k < 2; ++k) \
        acc[ai][bj][m][n] = __builtin_amdgcn_mfma_f32_16x16x32_bf16(Bt[n][k], At[m][k], acc[ai][bj][m][n], 0, 0, 0); __builtin_amdgcn_s_setprio(0); } while (0)
#define PG8_WAIT_V(n) asm volatile("s_waitcnt vmcnt(" #n ")" ::: "memory")
#define PG8_WAIT_L(n) asm volatile("s_waitcnt lgkmcnt(" #n ")" ::: "memory")
#define PG8_BAR __builtin_amdgcn_s_barrier()
#define PG8_SCHED __builtin_amdgcn_sched_barrier(0)
    Unit cur, nxt; int ui = 0;
    if (!S.next(0, cur)) return;
    f32x4 acc[2][2][4][2];
#pragma unroll
    for (int a = 0; a < 2; ++a)
#pragma unroll
        for (int b = 0; b < 2; ++b)
#pragma unroll
            for (int m = 0; m < 4; ++m)
#pragma unroll
                for (int n = 0; n < 2; ++n) acc[a][b][m][n] = (f32x4){0.f, 0.f, 0.f, 0.f};
    bf16x8 At[4][2], B0[2][2], B1[2][2];
    const char* cA = (const char*)g.A + (size_t)cur.pm * tstep; const char* cB = (const char*)g.Bt + (size_t)cur.pn * tstep;
    S.a_ready(cur);
    PG8_STAGE(PG8_SB(0, 0), cB, voffB); PG8_STAGE(PG8_SA(0, 0), cA, voffA); PG8_STAGE(PG8_SB(0, 1), cB + hstep, voffB); PG8_STAGE(PG8_SA(0, 1), cA + hstep, voffA);
    if (wr == 1) PG8_BAR;
    PG8_WAIT_V(4); PG8_BAR;
    PG8_STAGE(PG8_SB(1, 0), cB + kstep, voffB); PG8_STAGE(PG8_SA(1, 0), cA + kstep, voffA); PG8_STAGE(PG8_SB(1, 1), cB + hstep + kstep, voffB);
    PG8_WAIT_V(6); PG8_BAR;
    PG8_STAMP();
    for (;;) {
        const bool has_next = S.next(ui + 1, nxt);
        const char* nA = has_next ? (const char*)g.A + (size_t)nxt.pm * tstep : cA; const char* nB = has_next ? (const char*)g.Bt + (size_t)nxt.pn * tstep : cB;
        for (int t = 0; t < nt; t += 2) {
            const bool last = (t == nt - 2);
            const char* a1 = cA + (size_t)(t + 1) * kstep;
            const char* a2 = last ? nA : cA + (size_t)(t + 2) * kstep; const char* b2 = last ? nB : cB + (size_t)(t + 2) * kstep;
            const char* a3 = a2 + kstep; const char* b3 = b2 + kstep;
            if (last && has_next) S.a_ready(nxt);
            PG8_LDB(B0, 0, 0); PG8_SCHED; PG8_LDA(At, 0, 0); PG8_STAGE(PG8_SA(1, 1), a1 + hstep, voffA);
            PG8_WAIT_L(8); PG8_BAR; PG8_WAIT_L(0); PG8_MMA(0, 0, At, B0); PG8_BAR; PG8_SCHED;
            PG8_LDB(B1, 0, 1); PG8_STAGE(PG8_SB(0, 0), b2, voffB);
            PG8_BAR; PG8_WAIT_L(0); PG8_MMA(0, 1, At, B1); PG8_BAR;
            PG8_LDA(At, 0, 1); PG8_STAGE(PG8_SA(0, 0), a2, voffA);
            PG8_BAR; PG8_WAIT_L(0); PG8_MMA(1, 0, At, B0); PG8_BAR; PG8_SCHED;
            PG8_STAGE(PG8_SB(0, 1), b2 + hstep, voffB);
            PG8_WAIT_V(6); PG8_BAR; PG8_MMA(1, 1, At, B1); PG8_BAR;
            PG8_LDB(B0, 1, 0); PG8_SCHED; PG8_LDA(At, 1, 0); PG8_STAGE(PG8_SA(0, 1), a2 + hstep, voffA);
            PG8_WAIT_L(8); PG8_BAR; PG8_WAIT_L(0); PG8_MMA(0, 0, At, B0); PG8_BAR; PG8_SCHED;
            PG8_LDB(B1, 1, 1); PG8_STAGE(PG8_SB(1, 0), b3, voffB);
            PG8_BAR; PG8_WAIT_L(0); PG8_MMA(0, 1, At, B1); PG8_BAR;
            PG8_LDA(At, 1, 1); PG8_STAGE(PG8_SA(1, 0), a3, voffA);
            PG8_BAR; PG8_WAIT_L(0); PG8_MMA(1, 0, At, B0); PG8_BAR; PG8_SCHED;
            PG8_STAGE(PG8_SB(1, 1), b3 + hstep, voffB);
            PG8_WAIT_V(6); PG8_BAR; PG8_MMA(1, 1, At, B1); PG8_BAR;
        }
        PG8_STAMP();
        if constexpr (!Epi::AFTER_DRAIN) { E(acc, cur, wr, wc, fr, fq); S.done(cur); }
        PG8_STAMP();
        if (!has_next) break;
#pragma unroll
        for (int a = 0; a < 2; ++a)
#pragma unroll
            for (int b = 0; b < 2; ++b)
#pragma unroll
                for (int m = 0; m < 4; ++m)
#pragma unroll
                    for (int n = 0; n < 2; ++n) acc[a][b][m][n] = (f32x4){0.f, 0.f, 0.f, 0.f};
        cur = nxt; cA = nA; cB = nB; ++ui;
    }
    PG8_WAIT_V(0);
    if (wr == 0) PG8_BAR;
    PG8_BAR;
    if constexpr (Epi::AFTER_DRAIN) { E.fused(acc, cur, wr, wc, fr, fq, lds, wid, lane); S.done(cur); }
    PG8_STAMP();
    if (STAMP && wid == 0) { stamps[lane] = lane < nts ? (((unsigned long long)(unsigned)ts_hi << 32) | (unsigned)ts_lo) : 0ull;
        if (lane == 62) stamps[62] = rt_entry; if (lane == 63) stamps[63] = (unsigned long long)wall_clock64(); }
#undef PG8_STAMP
#undef PG8_SA
#undef PG8_SB
#undef PG8_STAGE
#undef PG8_LDA
#undef PG8_LDB
#undef PG8_MMA
#undef PG8_WAIT_V
#undef PG8_WAIT_L
#undef PG8_BAR
#undef PG8_SCHED
}
}

using pg8::bf16_t; using pg8::bf16x8; using pg8::f32x4; using pg8::u32x4;
#define LAS __attribute__((address_space(3)))
typedef short s16x4 __attribute__((ext_vector_type(4)));
typedef unsigned u32x2 __attribute__((ext_vector_type(2)));
constexpr int M_TOK = 81920, NP_ROWS = 16384, DM = 1024, DIN = 3072, DFF = 2816;
constexpr float RMS_EPS = 1e-6f, LOG2E = 1.4426950408889634f, QSCALE = 0.125f * 1.4426950408889634f;
constexpr size_t MiB = 1u << 20;
constexpr size_t WS_WIN = 0, WS_WOUT = 12 * MiB, WS_WGU = 16 * MiB, WS_WDN = 38 * MiB, WS_COS = 49 * MiB, WS_SIN = 50 * MiB, WS_RS = 51 * MiB,
                 WS_XB = 52 * MiB, WS_MIXED = 212 * MiB, WS_Y = 372 * MiB, WS_PROJ = 532 * MiB, WS_H = 532 * MiB, WS_END = 1012 * MiB;
constexpr int LDS_BYTES = 147456;
constexpr int NWAVES = 8;

struct Params {
    const float *x_p, *x_s, *g_pre_mix, *w_in, *conv_w, *rpb, *w_out, *g_post_mix, *g_pre_ffn, *w_gate, *w_up, *w_down, *g_post_ffn;
    float* out; unsigned char* ws;
};

__device__ __forceinline__ unsigned pk_bf16(float lo, float hi) { unsigned r; asm("v_cvt_pk_bf16_f32 %0, %1, %2" : "=v"(r) : "v"(lo), "v"(hi)); return r; }
__device__ __forceinline__ float bf_lo(unsigned w) { return __uint_as_float(w << 16); }
__device__ __forceinline__ float bf_hi(unsigned w) { return __uint_as_float(w & 0xffff0000u); }
__device__ __forceinline__ float wave_sum(float v) {
#pragma unroll
    for (int o = 1; o < 64; o <<= 1) v += __shfl_xor(v, o);
    return v;
}
__device__ __forceinline__ void seq_of_row(int row, int& S, int& seq0) {
    if (row < NP_ROWS) { S = 2048; seq0 = row & ~2047; } else { S = 8192; seq0 = NP_ROWS + ((row - NP_ROWS) & ~8191); }
}

struct EpiProj {
    static constexpr bool PERM = true, AFTER_DRAIN = false;
    bf16_t* O; const float* rs; const float* cs; const float* sn;
    __device__ __forceinline__ void operator()(const f32x4 (&acc)[2][2][4][2], const pg8::Unit& u, int wr, int wc, int fr, int fq) const {
        const int row0 = u.pm * 256 + wr * 64 + fr, col0 = u.pn * 256 + wc * 32 + 8 * fq;
        const int p4 = ((4 * wc + fq) & 7) * 4;
#pragma unroll
        for (int ai = 0; ai < 2; ++ai)
#pragma unroll
            for (int m = 0; m < 4; ++m) {
                const int row = row0 + ai * 128 + m * 16; const float r = rs[row];
                const int pos = row < NP_ROWS ? (row & 2047) : ((row - NP_ROWS) & 8191);
                bf16_t* rowp = O + (size_t)row * DIN + col0;
#pragma unroll
                for (int bj = 0; bj < 2; ++bj) {
                    const int cb = 2 * u.pn + bj;
                    f32x4 v0 = acc[ai][bj][m][0] * r, v1 = acc[ai][bj][m][1] * r;
                    if (cb < 6) {
                        const f32x4 c4 = *(const f32x4*)(cs + pos * 32 + p4), s4 = *(const f32x4*)(sn + pos * 32 + p4);
                        const f32x4 n0 = v0 * c4 - v1 * s4, n1 = v0 * s4 + v1 * c4; v0 = n0; v1 = n1;
                    }
                    if (cb < 3 || cb == 9 || cb == 10) { v0 = v0 * QSCALE; v1 = v1 * QSCALE; }
                    u32x4 w; w.x = pk_bf16(v0[0], v0[1]); w.y = pk_bf16(v0[2], v0[3]); w.z = pk_bf16(v1[0], v1[1]); w.w = pk_bf16(v1[2], v1[3]);
                    *(u32x4*)(rowp + bj * 128) = w;
                }
            }
    }
};
struct EpiPlain {
    static constexpr bool PERM = true, AFTER_DRAIN = false;
    bf16_t* O; int ldc;
    __device__ __forceinline__ void operator()(const f32x4 (&acc)[2][2][4][2], const pg8::Unit& u, int wr, int wc, int fr, int fq) const {
        const int row0 = u.pm * 256 + wr * 64 + fr, col0 = u.pn * 256 + wc * 32 + 8 * fq;
#pragma unroll
        for (int ai = 0; ai < 2; ++ai)
#pragma unroll
            for (int m = 0; m < 4; ++m) {
                bf16_t* rowp = O + (size_t)(row0 + ai * 128 + m * 16) * ldc + col0;
#pragma unroll
                for (int bj = 0; bj < 2; ++bj) {
                    const f32x4 v0 = acc[ai][bj][m][0], v1 = acc[ai][bj][m][1];
                    u32x4 w; w.x = pk_bf16(v0[0], v0[1]); w.y = pk_bf16(v0[2], v0[3]); w.z = pk_bf16(v1[0], v1[1]); w.w = pk_bf16(v1[2], v1[3]);
                    *(u32x4*)(rowp + bj * 128) = w;
                }
            }
    }
};
__device__ __forceinline__ float silu_mul(float g, float u) { return g * __builtin_amdgcn_rcpf(1.0f + __builtin_amdgcn_exp2f(-g * LOG2E)) * u; }
struct EpiSwiglu {
    static constexpr bool PERM = true, AFTER_DRAIN = false;
    bf16_t* O; const float* rs;
    __device__ __forceinline__ void operator()(const f32x4 (&acc)[2][2][4][2], const pg8::Unit& u, int wr, int wc, int fr, int fq) const {
        const int row0 = u.pm * 256 + wr * 64 + fr, col0 = u.pn * 128 + wc * 32 + 8 * fq;
#pragma unroll
        for (int ai = 0; ai < 2; ++ai)
#pragma unroll
            for (int m = 0; m < 4; ++m) {
                const int row = row0 + ai * 128 + m * 16; const float r = rs[row];
                const f32x4 g0 = acc[ai][0][m][0] * r, g1 = acc[ai][0][m][1] * r, u0 = acc[ai][1][m][0] * r, u1 = acc[ai][1][m][1] * r;
                u32x4 w; w.x = pk_bf16(silu_mul(g0[0], u0[0]), silu_mul(g0[1], u0[1])); w.y = pk_bf16(silu_mul(g0[2], u0[2]), silu_mul(g0[3], u0[3]));
                w.z = pk_bf16(silu_mul(g1[0], u1[0]), silu_mul(g1[1], u1[1])); w.w = pk_bf16(silu_mul(g1[2], u1[2]), silu_mul(g1[3], u1[3]));
                *(u32x4*)(O + (size_t)row * DFF + col0) = w;
            }
    }
};

__device__ __forceinline__ void wt_item(const float* __restrict__ W, int ldw, int srccol, const float* __restrict__ gain, bf16_t* __restrict__ WT, int K, int n0, int k0, LAS float* scr, int lane) {
#pragma unroll 8
    for (int i = 0; i < 32; ++i) { const int kk = 2 * i + (lane >> 5); float v = W[(size_t)(k0 + kk) * ldw + srccol]; if (gain) v *= gain[k0 + kk]; scr[kk * 33 + (lane & 31)] = v; }
    asm volatile("s_waitcnt lgkmcnt(0)" ::: "memory");
    const int c = lane & 7;
#pragma unroll
    for (int j = 0; j < 4; ++j) { const int n = (lane >> 3) + 8 * j; const LAS float* s = scr + (8 * c) * 33 + n;
        u32x4 o; o.x = pk_bf16(s[0 * 33], s[1 * 33]); o.y = pk_bf16(s[2 * 33], s[3 * 33]); o.z = pk_bf16(s[4 * 33], s[5 * 33]); o.w = pk_bf16(s[6 * 33], s[7 * 33]);
        *(u32x4*)(WT + (size_t)(n0 + n) * K + k0 + 8 * c) = o; }
    asm volatile("s_waitcnt lgkmcnt(0)" ::: "memory");
}
__device__ __forceinline__ void prologue(const Params& p, LAS unsigned char* lds, int tid, int lane, int wave) {
    unsigned char* ws = p.ws;
    LAS float* scr = (LAS float*)(lds + wave * 16384);
    const int gw = blockIdx.x * NWAVES + wave, NGW = gridDim.x * NWAVES;
    constexpr int I_IN = 16 * 96, I_OUT = 16 * 32, I_GU = 16 * 176, I_DN = 44 * 32, I_L = I_IN + I_OUT + I_GU + I_DN;
    for (int it = gw; it < 2 * I_L; it += NGW) {
        const int l = it / I_L; int r = it - l * I_L; const int n = lane & 31;
        if (r < I_IN) { const int kb = r / 96, nb = r % 96, n0 = 32 * nb; const int ph = n0 + n; int src = ph;
            if (ph < 768) { const int fl = ph & 63; src = (ph & ~63) + 32 * ((fl >> 2) & 1) + 4 * (fl >> 3) + (fl & 3); }
            wt_item(p.w_in + (size_t)l * DM * DIN, DIN, src, p.g_pre_mix + l * DM, (bf16_t*)(ws + WS_WIN) + (size_t)l * DIN * DM, DM, n0, 64 * kb, scr, lane); continue; }
        r -= I_IN;
        if (r < I_OUT) { const int kb = r / 32, nb = r % 32, n0 = 32 * nb;
            wt_item(p.w_out + (size_t)l * DM * DM, DM, n0 + n, nullptr, (bf16_t*)(ws + WS_WOUT) + (size_t)l * DM * DM, DM, n0, 64 * kb, scr, lane); continue; }
        r -= I_OUT;
        if (r < I_GU) { const int kb = r / 176, nb = r % 176, n0 = 32 * nb, pn = n0 >> 8, cc = n0 & 255;
            const float* W = (cc < 128 ? p.w_gate : p.w_up) + (size_t)l * DM * DFF;
            wt_item(W, DFF, 128 * pn + (cc & 127) + n, p.g_pre_ffn + l * DM, (bf16_t*)(ws + WS_WGU) + (size_t)l * 2 * DFF * DM, DM, n0, 64 * kb, scr, lane); continue; }
        r -= I_GU;
        { const int kb = r / 32, nb = r % 32, n0 = 32 * nb;
            wt_item(p.w_down + (size_t)l * DFF * DM, DM, n0 + n, nullptr, (bf16_t*)(ws + WS_WDN) + (size_t)l * DM * DFF, DFF, n0, 64 * kb, scr, lane); }
    }
    { float* cs = (float*)(ws + WS_COS); float* sn = (float*)(ws + WS_SIN);
      for (int idx = blockIdx.x * 512 + tid; idx < 8192 * 32; idx += gridDim.x * 512) {
          const int pos = idx >> 5, i = idx & 31; double inv = 1.0; for (int k = 0; k < i; ++k) inv *= 0.7498942093324559;
          double rev = (double)pos * inv * 0.15915494309189535; rev -= __builtin_rint(rev);
          const float f = (float)rev; cs[idx] = __builtin_amdgcn_cosf(f); sn[idx] = __builtin_amdgcn_sinf(f); } }
    { bf16_t* xb = (bf16_t*)(ws + WS_XB); float* rs = (float*)(ws + WS_RS);
      for (int row = gw; row < M_TOK; row += NGW) {
          const float* xr = row < NP_ROWS ? p.x_p + (size_t)row * DM : p.x_s + (size_t)(row - NP_ROWS) * DM;
          f32x4 v[4]; float ss = 0.f;
#pragma unroll
          for (int j = 0; j < 4; ++j) { v[j] = ((const f32x4*)xr)[64 * j + lane]; ss += (v[j][0] * v[j][0] + v[j][1] * v[j][1]) + (v[j][2] * v[j][2] + v[j][3] * v[j][3]); }
          ss = wave_sum(ss);
          u32x2* o8 = (u32x2*)(xb + (size_t)row * DM);
#pragma unroll
          for (int j = 0; j < 4; ++j) { u32x2 w; w.x = pk_bf16(v[j][0], v[j][1]); w.y = pk_bf16(v[j][2], v[j][3]); o8[64 * j + lane] = w; }
          if (lane == 0) rs[row] = 1.0f / sqrtf(ss * (1.0f / DM) + RMS_EPS);
      } }
}

__device__ __forceinline__ void ew_phase(const Params& p, int layer0_input, const float* __restrict__ g, bool write_next, int lane, int wave) {
    unsigned char* ws = p.ws; const bf16_t* Y = (const bf16_t*)(ws + WS_Y); bf16_t* xb = (bf16_t*)(ws + WS_XB); float* rs = (float*)(ws + WS_RS);
    const int gw = blockIdx.x * NWAVES + wave, NGW = gridDim.x * NWAVES;
    f32x4 gv[4];
#pragma unroll
    for (int j = 0; j < 4; ++j) gv[j] = ((const f32x4*)g)[64 * j + lane];
    for (int row = gw; row < M_TOK; row += NGW) {
        const float* xr = layer0_input ? (row < NP_ROWS ? p.x_p + (size_t)row * DM : p.x_s + (size_t)(row - NP_ROWS) * DM) : p.out + (size_t)row * DM;
        const u32x2* yr = (const u32x2*)(Y + (size_t)row * DM);
        f32x4 xv[4], yf[4]; float ss = 0.f;
#pragma unroll
        for (int j = 0; j < 4; ++j) { const u32x2 w = yr[64 * j + lane]; xv[j] = ((const f32x4*)xr)[64 * j + lane];
            yf[j] = (f32x4){bf_lo(w.x), bf_hi(w.x), bf_lo(w.y), bf_hi(w.y)}; ss += (yf[j][0] * yf[j][0] + yf[j][1] * yf[j][1]) + (yf[j][2] * yf[j][2] + yf[j][3] * yf[j][3]); }
        ss = wave_sum(ss); const float r = 1.0f / sqrtf(ss * (1.0f / DM) + RMS_EPS);
        float s2 = 0.f; float* orow = p.out + (size_t)row * DM;
#pragma unroll
        for (int j = 0; j < 4; ++j) { const f32x4 xn = xv[j] + yf[j] * r * gv[j]; xv[j] = xn; s2 += (xn[0] * xn[0] + xn[1] * xn[1]) + (xn[2] * xn[2] + xn[3] * xn[3]); ((f32x4*)orow)[64 * j + lane] = xn; }
        if (write_next) {
            s2 = wave_sum(s2); u32x2* o8 = (u32x2*)(xb + (size_t)row * DM);
#pragma unroll
            for (int j = 0; j < 4; ++j) { u32x2 w; w.x = pk_bf16(xv[j][0], xv[j][1]); w.y = pk_bf16(xv[j][2], xv[j][3]); o8[64 * j + lane] = w; }
            if (lane == 0) rs[row] = 1.0f / sqrtf(s2 * (1.0f / DM) + RMS_EPS);
        }
    }
}

__device__ __forceinline__ bf16x8 ld8(const bf16_t* p) { return *(const bf16x8*)p; }
__device__ __forceinline__ f32x4 qk_tile(const bf16_t* kp, bf16x8 q0, bf16x8 q1) {
    const bf16x8 k0 = ld8(kp), k1 = ld8(kp + 32);
    f32x4 s = {0.f, 0.f, 0.f, 0.f};
    s = __builtin_amdgcn_mfma_f32_16x16x32_bf16(k0, q0, s, 0, 0, 0);
    s = __builtin_amdgcn_mfma_f32_16x16x32_bf16(k1, q1, s, 0, 0, 0);
    return s;
}
__device__ __forceinline__ void v_stage(const bf16_t* v0, const bf16_t* v1, LAS unsigned char* dst, unsigned wofs) {
    const u32x4 a = *(const u32x4*)v0, b = *(const u32x4*)v1;
    *(LAS u32x4*)(dst + wofs) = a; *(LAS u32x4*)(dst + wofs + 8 * 160) = b;
}
__device__ __forceinline__ void pv_pair(f32x4 (&o)[4], f32x4 pa, f32x4 pb, LAS unsigned char* va, LAS unsigned char* vb, unsigned trofs) {
    union { u32x4 u; bf16x8 h; } pp; pp.u.x = pk_bf16(pa[0], pa[1]); pp.u.y = pk_bf16(pa[2], pa[3]); pp.u.z = pk_bf16(pb[0], pb[1]); pp.u.w = pk_bf16(pb[2], pb[3]);
#pragma unroll
    for (int c = 0; c < 4; ++c) {
        const s16x4 ta = __builtin_amdgcn_ds_read_tr16_b64_v4i16((LAS s16x4*)(va + trofs + c * 32));
        const s16x4 tb = __builtin_amdgcn_ds_read_tr16_b64_v4i16((LAS s16x4*)(vb + trofs + c * 32));
        const bf16x8 a = {ta[0], ta[1], ta[2], ta[3], tb[0], tb[1], tb[2], tb[3]};
        o[c] = __builtin_amdgcn_mfma_f32_16x16x32_bf16(a, pp.h, o[c], 0, 0, 0);
    }
}
__device__ __forceinline__ void attn_store(bf16_t* orow, const f32x4 (&o)[4], float l, int fq) {
    l += __shfl_xor(l, 16); l += __shfl_xor(l, 32);
    const float inv = 1.0f / l;
#pragma unroll
    for (int c = 0; c < 4; ++c) { u32x2 w; w.x = pk_bf16(o[c][0] * inv, o[c][1] * inv); w.y = pk_bf16(o[c][2] * inv, o[c][3] * inv); *(u32x2*)(orow + 16 * c + 4 * fq) = w; }
}

__device__ __forceinline__ void dil_item(const bf16_t* __restrict__ proj, bf16_t* __restrict__ mixed, LAS unsigned char* vst, int item, int lane) {
    const int fr = lane & 15, fq = lane >> 4, vr = lane >> 3;
    const int rho = item & 15, t = item >> 4, h = t % 6, blk = t / 6, row0 = blk * 256;
    int S, seq0; seq_of_row(row0, S, seq0);
    const int pos0 = row0 - seq0 + rho;
    const bf16_t* qp = proj + (size_t)(row0 + rho + 16 * fr) * DIN + h * 64 + 8 * fq;
    const bf16x8 q0 = ld8(qp), q1 = ld8(qp + 32);
    const bf16_t* kbase = proj + (size_t)seq0 * DIN + 384 + h * 64 + 8 * fq;
    const bf16_t* vbase = proj + (size_t)seq0 * DIN + 768 + h * 64 + 8 * (lane & 7);
    f32x4 o[4];
#pragma unroll
    for (int c = 0; c < 4; ++c) o[c] = (f32x4){0.f, 0.f, 0.f, 0.f};
    float l = 0.f;
    LAS unsigned char* va = vst; LAS unsigned char* vb = vst + 2560;
    const unsigned wofs = vr * 160 + (lane & 7) * 16, trofs = (4 * fq + ((lane & 15) >> 2)) * 160 + (lane & 3) * 8;
#pragma unroll
    for (int br = 0; br < 3; ++br) {
        const int d = br == 0 ? 1 : (br == 1 ? 4 : 16), c = 16 / d, nj = (8 + c + 1) & ~1;
        for (int jp = 0; jp < nj; jp += 2) {
            f32x4 pa, pb;
#pragma unroll
            for (int ab = 0; ab < 2; ++ab) {
                const int j = jp + ab;
                int kpos = pos0 + d * (16 * j + fr - 64); kpos = kpos < 0 ? 0 : (kpos > S - 1 ? S - 1 : kpos);
                const f32x4 s = qk_tile(kbase + (size_t)kpos * DIN, q0, q1);
                f32x4 pe;
#pragma unroll
                for (int e = 0; e < 4; ++e) { const int kk = 4 * fq + e, kp = pos0 + d * (16 * j + kk - 64), rel = 16 * j + kk - c * fr;
                    const bool valid = (kp >= 0) && (kp < S) && (rel >= 0) && (rel <= 128);
                    const float ex = __builtin_amdgcn_exp2f(s[e]); pe[e] = valid ? ex : 0.f; l += pe[e]; }
                int v0 = pos0 + d * (16 * j + vr - 64), v1 = v0 + 8 * d;
                v0 = v0 < 0 ? 0 : (v0 > S - 1 ? S - 1 : v0); v1 = v1 < 0 ? 0 : (v1 > S - 1 ? S - 1 : v1);
                v_stage(vbase + (size_t)v0 * DIN, vbase + (size_t)v1 * DIN, ab ? vb : va, wofs);
                if (ab) pb = pe; else pa = pe;
            }
            pv_pair(o, pa, pb, va, vb, trofs);
        }
    }
    attn_store(mixed + (size_t)(row0 + rho + 16 * fr) * DM + h * 64, o, l, fq);
}

__device__ __forceinline__ void na_item(const bf16_t* __restrict__ proj, bf16_t* __restrict__ mixed, LAS unsigned char* vst, const LAS float* tbl, int item, int lane) {
    const int fr = lane & 15, fq = lane >> 4, vr = lane >> 3;
    const int cb = item & 3, h = (item >> 2) & 3, R = item >> 4, row0 = R * 64;
    int S, seq0; seq_of_row(row0, S, seq0);
    const int rows = S >> 6, r = (row0 - seq0) >> 6;
    int rstart = r - 4; rstart = rstart < 0 ? 0 : (rstart > rows - 8 ? rows - 8 : rstart);
    int kc0 = 16 * cb - 8; kc0 = kc0 < 0 ? 0 : (kc0 > 32 ? 32 : kc0);
    const int qc = 16 * cb + fr; int cs = qc - 8; cs = cs < 0 ? 0 : (cs > 48 ? 48 : cs);
    const bf16_t* qp = proj + (size_t)(row0 + qc) * DIN + 1152 + h * 64 + 8 * fq;
    const bf16x8 q0 = ld8(qp), q1 = ld8(qp + 32);
    const bf16_t* kbase = proj + (size_t)seq0 * DIN + 1408 + h * 64 + 8 * fq;
    const bf16_t* vbase = proj + (size_t)seq0 * DIN + 1664 + h * 64 + 8 * (lane & 7);
    f32x4 o[4];
#pragma unroll
    for (int c = 0; c < 4; ++c) o[c] = (f32x4){0.f, 0.f, 0.f, 0.f};
    float l = 0.f;
    LAS unsigned char* va = vst; LAS unsigned char* vb = vst + 2560;
    const unsigned wofs = vr * 160 + (lane & 7) * 16, trofs = (4 * fq + ((lane & 15) >> 2)) * 160 + (lane & 3) * 8;
    for (int rr = 0; rr < 8; ++rr) {
        const int keyrow = rstart + rr, tok0 = keyrow * 64 + kc0;
        const LAS float* brow = tbl + h * 465 + (keyrow - r + 7) * 31;
        f32x4 pa, pb;
#pragma unroll
        for (int hh = 0; hh < 2; ++hh) {
            const f32x4 s = qk_tile(kbase + (size_t)(tok0 + 16 * hh + fr) * DIN, q0, q1);
            f32x4 pe;
#pragma unroll
            for (int e = 0; e < 4; ++e) { const int kc = kc0 + 16 * hh + 4 * fq + e; const bool valid = (kc >= cs) && (kc < cs + 16);
                int dc = kc - qc + 15; dc = dc < 0 ? 0 : (dc > 30 ? 30 : dc);
                const float ex = __builtin_amdgcn_exp2f(s[e] + brow[dc]); pe[e] = valid ? ex : 0.f; l += pe[e]; }
            v_stage(vbase + (size_t)(tok0 + 16 * hh + vr) * DIN, vbase + (size_t)(tok0 + 16 * hh + vr + 8) * DIN, hh ? vb : va, wofs);
            if (hh) pb = pe; else pa = pe;
        }
        pv_pair(o, pa, pb, va, vb, trofs);
    }
    attn_store(mixed + (size_t)(row0 + qc) * DM + 384 + h * 64, o, l, fq);
}

__device__ __forceinline__ void mix_phase(const Params& p, int layer, LAS unsigned char* lds, int tid, int lane, int wave) {
    unsigned char* ws = p.ws; const bf16_t* proj = (const bf16_t*)(ws + WS_PROJ); bf16_t* mixed = (bf16_t*)(ws + WS_MIXED);
    LAS float* tbl = (LAS float*)(lds + 65536);
    for (int i = tid; i < 4 * 465; i += 512) tbl[i] = p.rpb[layer * 4 * 465 + i] * LOG2E;
    __syncthreads();
    LAS unsigned char* vst = lds + wave * 8192;
    const int gw = blockIdx.x * NWAVES + wave, NGW = gridDim.x * NWAVES;
    for (int it = gw; it < (M_TOK / 256) * 6 * 16; it += NGW) dil_item(proj, mixed, vst, it, lane);
    for (int it = gw; it < (M_TOK / 64) * 16; it += NGW) na_item(proj, mixed, vst, tbl, it, lane);
    const float* cw = p.conv_w + layer * 3 * 384;
    for (int idx = blockIdx.x * 512 + tid; idx < M_TOK * 48; idx += gridDim.x * 512) {
        const int row = idx / 48, c0 = (idx - row * 48) * 8;
        int S, seq0; seq_of_row(row, S, seq0); const int pos = row - seq0;
        const bf16_t* base = proj + (size_t)row * DIN + c0;
        const u32x4 gb = *(const u32x4*)(base + 1920);
        float acc[8];
#pragma unroll
        for (int k = 0; k < 8; ++k) acc[k] = 0.f;
#pragma unroll
        for (int j = 0; j < 3; ++j) {
            const int pp = pos + j - 1;
            if (pp >= 0 && pp < S) {
                const bf16_t* bj = base + (ptrdiff_t)(j - 1) * DIN;
                const u32x4 gc = *(const u32x4*)(bj + 2304), hi = *(const u32x4*)(bj + 2688);
                const f32x4 w0 = *(const f32x4*)(cw + j * 384 + c0), w1 = *(const f32x4*)(cw + j * 384 + c0 + 4);
                acc[0] += w0[0] * bf_lo(gc.x) * bf_lo(hi.x); acc[1] += w0[1] * bf_hi(gc.x) * bf_hi(hi.x);
                acc[2] += w0[2] * bf_lo(gc.y) * bf_lo(hi.y); acc[3] += w0[3] * bf_hi(gc.y) * bf_hi(hi.y);
                acc[4] += w1[0] * bf_lo(gc.z) * bf_lo(hi.z); acc[5] += w1[1] * bf_hi(gc.z) * bf_hi(hi.z);
                acc[6] += w1[2] * bf_lo(gc.w) * bf_lo(hi.w); acc[7] += w1[3] * bf_hi(gc.w) * bf_hi(hi.w);
            }
        }
        u32x4 w; w.x = pk_bf16(acc[0] * bf_lo(gb.x), acc[1] * bf_hi(gb.x)); w.y = pk_bf16(acc[2] * bf_lo(gb.y), acc[3] * bf_hi(gb.y));
        w.z = pk_bf16(acc[4] * bf_lo(gb.z), acc[5] * bf_hi(gb.z)); w.w = pk_bf16(acc[6] * bf_lo(gb.w), acc[7] * bf_hi(gb.w));
        *(u32x4*)(mixed + (size_t)row * DM + 640 + c0) = w;
    }
}

__global__ void __launch_bounds__(512) fwd_mega(Params p) {
    extern __shared__ __attribute__((aligned(16))) unsigned char lds_raw[];
    LAS unsigned char* lds = (LAS unsigned char*)lds_raw;
    cg::grid_group grid = cg::this_grid();
    unsigned char* ws = p.ws;
#define FRESH_TID() int tid = threadIdx.x; asm volatile("" : "+v"(tid)); const int lane = tid & 63, wave = __builtin_amdgcn_readfirstlane(tid >> 6)
    bf16_t* xb = (bf16_t*)(ws + WS_XB); bf16_t* proj = (bf16_t*)(ws + WS_PROJ); bf16_t* mixed = (bf16_t*)(ws + WS_MIXED); bf16_t* Y = (bf16_t*)(ws + WS_Y); bf16_t* H = (bf16_t*)(ws + WS_H);
    const float* rs = (const float*)(ws + WS_RS);

    { FRESH_TID(); prologue(p, lds, tid, lane, wave); }
    grid.sync();
    for (int layer = 0; layer < 2; ++layer) {
        {
            pg8::Gemm g{xb, (const bf16_t*)(ws + WS_WIN) + (size_t)layer * DIN * DM, M_TOK, DIN, DM}; pg8::StaticOrder S; S.init(M_TOK, DIN, (int)gridDim.x, (int)blockIdx.x);
            EpiProj E{proj, rs, (const float*)(ws + WS_COS), (const float*)(ws + WS_SIN)};
            pg8::gemm_phase<EpiProj, pg8::StaticOrder>(lds, g, S, E, nullptr);
        }
        grid.sync();
        { FRESH_TID(); mix_phase(p, layer, lds, tid, lane, wave); }
        grid.sync();
        {
            pg8::Gemm g{mixed, (const bf16_t*)(ws + WS_WOUT) + (size_t)layer * DM * DM, M_TOK, DM, DM}; pg8::StaticOrder S; S.init(M_TOK, DM, (int)gridDim.x, (int)blockIdx.x);
            EpiPlain E{Y, DM};
            pg8::gemm_phase<EpiPlain, pg8::StaticOrder>(lds, g, S, E, nullptr);
        }
        grid.sync();
        { FRESH_TID(); (void)tid; ew_phase(p, layer == 0, p.g_post_mix + layer * DM, true, lane, wave); }
        grid.sync();
        {
            pg8::Gemm g{xb, (const bf16_t*)(ws + WS_WGU) + (size_t)layer * 2 * DFF * DM, M_TOK, 2 * DFF, DM}; pg8::StaticOrder S; S.init(M_TOK, 2 * DFF, (int)gridDim.x, (int)blockIdx.x);
            EpiSwiglu E{H, rs};
            pg8::gemm_phase<EpiSwiglu, pg8::StaticOrder>(lds, g, S, E, nullptr);
        }
        grid.sync();
        {
            pg8::Gemm g{H, (const bf16_t*)(ws + WS_WDN) + (size_t)layer * DM * DFF, M_TOK, DM, DFF}; pg8::StaticOrder S; S.init(M_TOK, DM, (int)gridDim.x, (int)blockIdx.x);
            EpiPlain E{Y, DM};
            pg8::gemm_phase<EpiPlain, pg8::StaticOrder>(lds, g, S, E, nullptr);
        }
        grid.sync();
        { FRESH_TID(); (void)tid; ew_phase(p, 0, p.g_post_ffn + layer * DM, layer == 0, lane, wave); }
        if (layer == 0) grid.sync();
    }
}

extern "C" void kernel_launch(void* const* d_in, const int* in_sizes, int n_in, void* d_out, int out_size, void* d_ws, size_t ws_size, hipStream_t stream) {
    static int grid_blocks = 0;
    if (!grid_blocks) {
        if (n_in != 13 || out_size != M_TOK * DM || ws_size < WS_END) { fprintf(stderr, "kernel_launch: unexpected sizes (n_in %d out %d ws %zu)\n", n_in, out_size, ws_size); grid_blocks = -1; return; }
        int dev = 0, cus = 0, per_cu = 0;
        hipGetDevice(&dev); hipDeviceGetAttribute(&cus, hipDeviceAttributeMultiprocessorCount, dev);
        hipFuncSetAttribute((const void*)fwd_mega, hipFuncAttributeMaxDynamicSharedMemorySize, LDS_BYTES);
        hipOccupancyMaxActiveBlocksPerMultiprocessor(&per_cu, (const void*)fwd_mega, 512, LDS_BYTES);
        if (per_cu < 1) { fprintf(stderr, "kernel_launch: occupancy query says %d blocks per CU\n", per_cu); per_cu = 1; }
        (void)hipGetLastError();
        grid_blocks = cus * per_cu;
    }
    if (grid_blocks < 0) return;
    Params p{};
    p.x_p = (const float*)d_in[0]; p.x_s = (const float*)d_in[1]; p.g_pre_mix = (const float*)d_in[2]; p.w_in = (const float*)d_in[3]; p.conv_w = (const float*)d_in[4];
    p.rpb = (const float*)d_in[5]; p.w_out = (const float*)d_in[6]; p.g_post_mix = (const float*)d_in[7]; p.g_pre_ffn = (const float*)d_in[8]; p.w_gate = (const float*)d_in[9];
    p.w_up = (const float*)d_in[10]; p.w_down = (const float*)d_in[11]; p.g_post_ffn = (const float*)d_in[12]; p.out = (float*)d_out; p.ws = (unsigned char*)d_ws;
    void* args[] = {&p};
    hipError_t e = hipLaunchCooperativeKernel((const void*)fwd_mega, dim3(grid_blocks), dim3(512), args, LDS_BYTES, stream);
    if (e != hipSuccess) fprintf(stderr, "cooperative launch failed: %s (grid %d)\n", hipGetErrorString(e), grid_blocks);
}
```

```cpp
#include <hip/hip_runtime.h>
#include <hip/hip_cooperative_groups.h>
#include <cstdio>
namespace cg = cooperative_groups;
namespace pg8 {
#define PG8_LAS __attribute__((address_space(3)))
typedef unsigned short bf16_t;
typedef short bf16x8 __attribute__((ext_vector_type(8)));
typedef float f32x4 __attribute__((ext_vector_type(4)));
typedef unsigned u32x4 __attribute__((ext_vector_type(4)));
constexpr int BM = 256, BK = 64, HALF = 128, HTB = HALF * BK * 2  , STAGE_BYTES = 8 * HTB, NXCD = 8, WGM = 8;

__host__ __device__ __forceinline__ int lds_byte(int r, int c) { const int st = (r >> 4) * 2 + (c >> 5), rr = r & 15, cc = c & 31, ob = rr * 64 + cc * 2; return st * 1024 + (ob ^ (((ob >> 9) & 1) << 5)); }
__host__ __device__ __forceinline__ void stage_rc(int b, int& R, int& C) { const int st = b / 1024, sb = b % 1024, swz = sb ^ (((sb >> 9) & 1) << 5); R = (st >> 1) * 16 + swz / 64; C = (st & 1) * 32 + (swz % 64) / 2; }
__host__ __device__ __forceinline__ int perm32(int rho) { const int n = rho >> 4, i = rho & 15; return 8 * (i >> 2) + 4 * n + (i & 3); }

struct Unit { int pm, pn; };
struct Gemm { const bf16_t* A; const bf16_t* Bt; int M, N, K; };

struct StaticOrder {
    int nM, nN, nwg, G, c;
    __host__ __device__ void init(int M, int N, int G_, int c_) { nM = M / BM; nN = N / BM; nwg = nM * nN; G = G_; c = c_; }
    __host__ __device__ bool next(int i, Unit& u) const {
        const long L = (long)i * G + c; if (L >= nwg) return false;
        int wgid = (int)L; { const int q = nwg / NXCD, r = nwg % NXCD, xcd = wgid % NXCD, off = wgid / NXCD; wgid = (xcd < r ? xcd * (q + 1) : r * (q + 1) + (xcd - r) * q) + off; }
        const int nig = WGM * nN, gid = wgid / nig, fm = gid * WGM, gsz = (nM - fm) < WGM ? (nM - fm) : WGM;
        u.pm = fm + ((wgid % nig) % gsz); u.pn = (wgid % nig) / gsz; return true;
    }
    __device__ __forceinline__ void a_ready(const Unit&) const {}
    __device__ __forceinline__ void done(const Unit&) const {}
};
typedef float f32x2 __attribute__((ext_vector_type(2)));
template <class Epi, class Sched, bool ALIGN_EPI = true, bool SP2 = true>
__device__ __forceinline__ void gemm_phase(PG8_LAS unsigned char* lds, const Gemm g, const Sched& S, const Epi& E) {
    int tid_ = threadIdx.x; asm volatile("" : "+v"(tid_));
    const int tid = tid_, wid = __builtin_amdgcn_readfirstlane(tid >> 6), lane = tid & 63, wr = wid >> 2, wc = wid & 3, fr = lane & 15, fq = lane >> 4;
    const int K = g.K, nt = K / BK;
    unsigned voffA[2], voffB[2];
#pragma unroll
    for (int i = 0; i < 2; ++i) { int R, C; stage_rc(tid * 16 + i * 8192, R, C); const int Rb = Epi::PERM ? ((R & ~31) + perm32(R & 31)) : R;
        voffA[i] = (unsigned)(R * K + C) * 2u; voffB[i] = (unsigned)(Rb * K + C) * 2u; }
    const size_t kstep = (size_t)(BK * 2);
    const size_t hstep = (size_t)HALF * K * 2;
    const size_t tstep = 2 * hstep;
    const unsigned ldsw = (unsigned)wid * 1024u;
    const int aoff = lds_byte(wr * 64 + fr, fq * 8), boff = lds_byte(wc * 32 + fr, fq * 8);
#define PG8_SA(b, h) (((b) * 2 + (h)) * HTB)
#define PG8_SB(b, h) ((4 + (b) * 2 + (h)) * HTB)
#define PG8_STAGE(bufoff, gbase, voff) do { _Pragma("unroll") for (int _i = 0; _i < 2; ++_i) \
        __builtin_amdgcn_global_load_lds((const unsigned*)((const char*)(gbase) + (voff)[_i]), (PG8_LAS unsigned*)(lds + (bufoff) + ldsw + _i * 8192), 16, 0, 0); } while (0)
#define PG8_LDA(dst, b, h) do { _Pragma("unroll") for (int m = 0; m < 4; ++m) _Pragma("unroll") for (int k = 0; k < 2; ++k) dst[m][k] = *(const PG8_LAS bf16x8*)(lds + PG8_SA(b, h) + aoff + m * 2048 + k * 1024); } while (0)
#define PG8_LDB(dst, b, h) do { _Pragma("unroll") for (int n = 0; n < 2; ++n) _Pragma("unroll") for (int k = 0; k < 2; ++k) dst[n][k] = *(const PG8_LAS bf16x8*)(lds + PG8_SB(b, h) + boff + n * 2048 + k * 1024); } while (0)
#define PG8_MMA(ai, bj, At, Bt) do { __builtin_amdgcn_s_setprio(1); _Pragma("unroll") for (int m = 0; m < 4; ++m) _Pragma("unroll") for (int n = 0; n < 2; ++n) _Pragma("unroll") for (int k = 0; k < 2; ++k) \
        acc[ai][bj][m][n] = __builtin_amdgcn_mfma_f32_16x16x32_bf16(Bt[n][k], At[m][k], acc[ai][bj][m][n], 0, 0, 0); __builtin_amdgcn_s_setprio(0); } while (0)
#define PG8_WAIT_V(n) asm volatile("s_waitcnt vmcnt(" #n ")" ::: "memory")
#define PG8_WAIT_L(n) asm volatile("s_waitcnt lgkmcnt(" #n ")" ::: "memory")
#define PG8_BAR __builtin_amdgcn_s_barrier()
#define PG8_SCHED __builtin_amdgcn_sched_barrier(0)
    Unit cur, nxt; int ui = 0; unsigned epre[4];
#pragma unroll
    for (int i = 0; i < 4; ++i) epre[i] = 0u;
    if (!S.next(0, cur)) return;
    f32x4 acc[2][2][4][2];
#pragma unroll
    for (int a = 0; a < 2; ++a)
#pragma unroll
        for (int b = 0; b < 2; ++b)
#pragma unroll
            for (int m = 0; m < 4; ++m)
#pragma unroll
                for (int n = 0; n < 2; ++n) acc[a][b][m][n] = (f32x4){0.f, 0.f, 0.f, 0.f};
    bf16x8 At[4][2], B0[2][2], B1[2][2];
    const char* cA = (const char*)g.A + (size_t)cur.pm * tstep; const char* cB = (const char*)g.Bt + (size_t)cur.pn * tstep;
    S.a_ready(cur);
    if constexpr (SP2) {
        PG8_STAGE(PG8_SB(0, 0), cB, voffB); PG8_STAGE(PG8_SB(0, 1), cB + hstep, voffB); PG8_STAGE(PG8_SA(0, 0), cA, voffA); PG8_STAGE(PG8_SA(0, 1), cA + hstep, voffA);
        if (wr == 1) PG8_BAR;
        PG8_WAIT_V(2); PG8_BAR;
        PG8_STAGE(PG8_SB(1, 0), cB + kstep, voffB); PG8_STAGE(PG8_SA(1, 0), cA + kstep, voffA); PG8_STAGE(PG8_SB(1, 1), cB + hstep + kstep, voffB);
        PG8_WAIT_V(6); PG8_BAR;
    } else {
        PG8_STAGE(PG8_SB(0, 0), cB, voffB); PG8_STAGE(PG8_SA(0, 0), cA, voffA); PG8_STAGE(PG8_SB(0, 1), cB + hstep, voffB); PG8_STAGE(PG8_SA(0, 1), cA + hstep, voffA);
        if (wr == 1) PG8_BAR;
        PG8_WAIT_V(4); PG8_BAR;
        PG8_STAGE(PG8_SB(1, 0), cB + kstep, voffB); PG8_STAGE(PG8_SA(1, 0), cA + kstep, voffA); PG8_STAGE(PG8_SB(1, 1), cB + hstep + kstep, voffB);
        PG8_WAIT_V(6); PG8_BAR;
    }
    for (;;) {
        const bool has_next = S.next(ui + 1, nxt);
        const char* nA = has_next ? (const char*)g.A + (size_t)nxt.pm * tstep : cA; const char* nB = has_next ? (const char*)g.Bt + (size_t)nxt.pn * tstep : cB;
        for (int t = 0; t < nt; t += 2) {
            const bool last = (t == nt - 2);
            const char* a1 = cA + (size_t)(t + 1) * kstep;
            const char* a2 = last ? nA : cA + (size_t)(t + 2) * kstep; const char* b2 = last ? nB : cB + (size_t)(t + 2) * kstep;
            const char* a3 = a2 + kstep; const char* b3 = b2 + kstep;
            if (last && has_next) S.a_ready(nxt);
            if (last) E.prefetch(epre, cur, wr, fr);
            if constexpr (SP2) {
            PG8_LDB(B0, 0, 0); PG8_LDB(B1, 0, 1); PG8_SCHED; PG8_LDA(At, 0, 0); PG8_STAGE(PG8_SA(1, 1), a1 + hstep, voffA);
            PG8_WAIT_V(8); PG8_WAIT_L(0); PG8_BAR; PG8_MMA(0, 0, At, B0); PG8_MMA(0, 1, At, B1); PG8_BAR; PG8_SCHED;
            PG8_LDA(At, 0, 1); PG8_STAGE(PG8_SB(0, 0), b2, voffB); PG8_STAGE(PG8_SB(0, 1), b2 + hstep, voffB); PG8_STAGE(PG8_SA(0, 0), a2, voffA);
            PG8_WAIT_V(8); PG8_WAIT_L(0); PG8_BAR; PG8_MMA(1, 0, At, B0); PG8_MMA(1, 1, At, B1); PG8_BAR; PG8_SCHED;
            PG8_LDB(B0, 1, 0); PG8_LDB(B1, 1, 1); PG8_SCHED; PG8_LDA(At, 1, 0); PG8_STAGE(PG8_SA(0, 1), a2 + hstep, voffA);
            PG8_WAIT_V(8); PG8_WAIT_L(0); PG8_BAR; PG8_MMA(0, 0, At, B0); PG8_MMA(0, 1, At, B1); PG8_BAR; PG8_SCHED;
            PG8_LDA(At, 1, 1); PG8_STAGE(PG8_SB(1, 0), b3, voffB); PG8_STAGE(PG8_SB(1, 1), b3 + hstep, voffB); PG8_STAGE(PG8_SA(1, 0), a3, voffA);
            PG8_WAIT_V(8); PG8_WAIT_L(0); PG8_BAR; PG8_MMA(1, 0, At, B0); PG8_MMA(1, 1, At, B1); PG8_BAR; PG8_SCHED;
            } else {
            PG8_LDB(B0, 0, 0); PG8_SCHED; PG8_LDA(At, 0, 0); PG8_STAGE(PG8_SA(1, 1), a1 + hstep, voffA);
            PG8_WAIT_L(8); PG8_BAR; PG8_WAIT_L(0); PG8_MMA(0, 0, At, B0); PG8_BAR; PG8_SCHED;
            PG8_LDB(B1, 0, 1); PG8_STAGE(PG8_SB(0, 0), b2, voffB);
            PG8_BAR; PG8_WAIT_L(0); PG8_MMA(0, 1, At, B1); PG8_BAR;
            PG8_LDA(At, 0, 1); PG8_STAGE(PG8_SA(0, 0), a2, voffA);
            PG8_BAR; PG8_WAIT_L(0); PG8_MMA(1, 0, At, B0); PG8_BAR; PG8_SCHED;
            PG8_STAGE(PG8_SB(0, 1), b2 + hstep, voffB);
            PG8_WAIT_V(6); PG8_BAR; PG8_MMA(1, 1, At, B1); PG8_BAR;
            PG8_LDB(B0, 1, 0); PG8_SCHED; PG8_LDA(At, 1, 0); PG8_STAGE(PG8_SA(0, 1), a2 + hstep, voffA);
            PG8_WAIT_L(8); PG8_BAR; PG8_WAIT_L(0); PG8_MMA(0, 0, At, B0); PG8_BAR; PG8_SCHED;
            PG8_LDB(B1, 1, 1); PG8_STAGE(PG8_SB(1, 0), b3, voffB);
            PG8_BAR; PG8_WAIT_L(0); PG8_MMA(0, 1, At, B1); PG8_BAR;
            PG8_LDA(At, 1, 1); PG8_STAGE(PG8_SA(1, 0), a3, voffA);
            PG8_BAR; PG8_WAIT_L(0); PG8_MMA(1, 0, At, B0); PG8_BAR; PG8_SCHED;
            PG8_STAGE(PG8_SB(1, 1), b3 + hstep, voffB);
            PG8_WAIT_V(6); PG8_BAR; PG8_MMA(1, 1, At, B1); PG8_BAR;
            }
        }
        if constexpr (ALIGN_EPI) { if (wr == 0) PG8_BAR; }
        if constexpr (!Epi::AFTER_DRAIN) { E(acc, cur, wr, wc, fr, fq, epre); S.done(cur); }
        if (!has_next) break;
#pragma unroll
        for (int a = 0; a < 2; ++a)
#pragma unroll
            for (int b = 0; b < 2; ++b)
#pragma unroll
                for (int m = 0; m < 4; ++m)
#pragma unroll
                    for (int n = 0; n < 2; ++n) acc[a][b][m][n] = (f32x4){0.f, 0.f, 0.f, 0.f};
        cur = nxt; cA = nA; cB = nB; ++ui;
        if constexpr (ALIGN_EPI) { if (wr == 1) PG8_BAR; }
    }
    PG8_WAIT_V(0);
    if constexpr (!ALIGN_EPI) { if (wr == 0) PG8_BAR; }
    PG8_BAR;
    if constexpr (Epi::AFTER_DRAIN) { E.fused(acc, cur, wr, wc, fr, fq, lds, wid, lane); S.done(cur); }
#undef PG8_SA
#undef PG8_SB
#undef PG8_STAGE
#undef PG8_LDA
#undef PG8_LDB
#undef PG8_MMA
#undef PG8_WAIT_V
#undef PG8_WAIT_L
#undef PG8_BAR
#undef PG8_SCHED
}
}

using pg8::bf16_t; using pg8::bf16x8; using pg8::f32x4; using pg8::u32x4;
#define LAS __attribute__((address_space(3)))
typedef short s16x4 __attribute__((ext_vector_type(4)));
typedef unsigned u32x2 __attribute__((ext_vector_type(2)));
constexpr int M_TOK = 81920, NP_ROWS = 16384, DM = 1024, DIN = 3072, DFF = 2816;
constexpr float RMS_EPS = 1e-6f, LOG2E = 1.4426950408889634f, QSCALE = 0.125f * 1.4426950408889634f;
constexpr size_t MiB = 1u << 20;
constexpr size_t WS_WIN = 0, WS_WOUT = 12 * MiB, WS_WGU = 16 * MiB, WS_WDN = 38 * MiB, WS_COS = 49 * MiB, WS_SIN = 50 * MiB, WS_RS = 51 * MiB,
                 WS_XB = 52 * MiB, WS_MIXED = 212 * MiB, WS_Y = 372 * MiB, WS_PROJ = 532 * MiB, WS_H = 532 * MiB, WS_CTL = 1012 * MiB, CTL_BYTES = 32768, WS_QCTR = WS_CTL + 16384, WS_END = 1013 * MiB;
constexpr size_t M64 = (size_t)M_TOK * 64;
constexpr size_t PB_QD = 0, PB_KD = 6 * M64, PB_VD = 12 * M64, PB_QN = 18 * M64, PB_KN = 22 * M64, PB_VN = 26 * M64, PB_CV = 30 * M64;
constexpr int DCV = 1152;
constexpr int LDS_BYTES = 147456;
constexpr int NWAVES = 8;

struct Params {
    const float *x_p, *x_s, *g_pre_mix, *w_in, *conv_w, *rpb, *w_out, *g_post_mix, *g_pre_ffn, *w_gate, *w_up, *w_down, *g_post_ffn;
    float* out; unsigned char* ws;
};

typedef float f32x2_t __attribute__((ext_vector_type(2)));
typedef __bf16 bf16x2_t __attribute__((ext_vector_type(2)));
__device__ __forceinline__ unsigned pk_bf16(float lo, float hi) { const f32x2_t v = {lo, hi}; const bf16x2_t b = __builtin_convertvector(v, bf16x2_t); return __builtin_bit_cast(unsigned, b); }
__device__ __forceinline__ float bf_lo(unsigned w) { return __uint_as_float(w << 16); }
__device__ __forceinline__ float bf_hi(unsigned w) { return __uint_as_float(w & 0xffff0000u); }
__device__ __forceinline__ float wave_sum(float v) {
#pragma unroll
    for (int o = 1; o < 64; o <<= 1) v += __shfl_xor(v, o);
    return v;
}
__device__ __forceinline__ void seq_of_row(int row, int& S, int& seq0) {
    if (row < NP_ROWS) { S = 2048; seq0 = row & ~2047; } else { S = 8192; seq0 = NP_ROWS + ((row - NP_ROWS) & ~8191); }
}

__device__ __forceinline__ int rs_idx(int row) { return (row & ~31) | ((row & 15) << 1) | ((row >> 4) & 1); }
__device__ __forceinline__ void rs_store(unsigned short* rsb, int row, float v) { rsb[rs_idx(row)] = (unsigned short)(pk_bf16(v, v) & 0xffffu); }
__device__ __forceinline__ void rs_prefetch(unsigned (&pre)[4], const unsigned short* rsb, int pm, int wr, int fr) {
    const unsigned* r32 = (const unsigned*)rsb;
#pragma unroll
    for (int i = 0; i < 4; ++i) pre[i] = r32[((pm * 256 + wr * 64 + (i >> 1) * 128 + (i & 1) * 32) >> 1) + fr];
}
__device__ __forceinline__ float rs_get(const unsigned (&pre)[4], int ai, int m) { const unsigned w = pre[ai * 2 + (m >> 1)]; return (m & 1) ? bf_hi(w) : bf_lo(w); }
struct EpiProj {
    static constexpr bool PERM = true, AFTER_DRAIN = false;
    bf16_t* O; const unsigned short* rs; const unsigned* cs;
    __device__ __forceinline__ void prefetch(unsigned (&pre)[4], const pg8::Unit& u, int wr, int fr) const { rs_prefetch(pre, rs, u.pm, wr, fr); }
    __device__ __forceinline__ void operator()(const f32x4 (&acc)[2][2][4][2], const pg8::Unit& u, int wr, int wc, int fr, int fq, const unsigned (&pre)[4]) const {
        const int row0 = u.pm * 256 + wr * 64 + fr;
        const int p4 = ((4 * wc + fq) & 7) * 4;
        const unsigned* __restrict__ cs = this->cs; bf16_t* __restrict__ O = this->O;
#pragma unroll
        for (int ai = 0; ai < 2; ++ai)
#pragma unroll
            for (int m = 0; m < 4; ++m) {
                if (m == 0 && ai == 1) asm volatile("" ::: "memory");
                const int row = row0 + ai * 128 + m * 16; const float r = rs_get(pre, ai, m);
                const int pos = row < NP_ROWS ? (row & 2047) : ((row - NP_ROWS) & 8191);
#pragma unroll
                for (int bj = 0; bj < 2; ++bj) {
                    const int cb = 2 * u.pn + bj;
                    bf16_t* dst;
                    if (cb < 15) { const int hl = wc >> 1; size_t tb; int head;
                        if (cb < 3) { tb = PB_QD; head = 2 * cb + hl; } else if (cb < 6) { tb = PB_KD; head = 2 * (cb - 3) + hl; } else if (cb < 9) { tb = PB_VD; head = 2 * (cb - 6) + hl; }
                        else if (cb < 11) { tb = PB_QN; head = 2 * (cb - 9) + hl; } else if (cb < 13) { tb = PB_KN; head = 2 * (cb - 11) + hl; } else { tb = PB_VN; head = 2 * (cb - 13) + hl; }
                        dst = O + tb + ((size_t)head * M_TOK + row) * 64 + 32 * (wc & 1) + 8 * fq;
                    } else dst = O + PB_CV + (size_t)row * DCV + 128 * (cb - 15) + 32 * wc + 8 * fq;
                    f32x4 v0 = acc[ai][bj][m][0] * r, v1 = acc[ai][bj][m][1] * r;
                    if (cb < 6) {
                        const u32x4 t4 = *(const u32x4*)(cs + pos * 32 + p4);
                        const f32x4 c4 = (f32x4){bf_lo(t4.x), bf_lo(t4.y), bf_lo(t4.z), bf_lo(t4.w)}, s4 = (f32x4){bf_hi(t4.x), bf_hi(t4.y), bf_hi(t4.z), bf_hi(t4.w)};
                        const f32x4 n0 = v0 * c4 - v1 * s4, n1 = v0 * s4 + v1 * c4; v0 = n0; v1 = n1;
                    }
                    if (cb < 3 || cb == 9 || cb == 10) { v0 = v0 * QSCALE; v1 = v1 * QSCALE; }
                    u32x4 w; w.x = pk_bf16(v0[0], v0[1]); w.y = pk_bf16(v0[2], v0[3]); w.z = pk_bf16(v1[0], v1[1]); w.w = pk_bf16(v1[2], v1[3]);
                    *(u32x4*)dst = w;
                }
            }
    }
};
struct EpiPlain {
    static constexpr bool PERM = true, AFTER_DRAIN = false;
    bf16_t* O; int ldc;
    __device__ __forceinline__ void prefetch(unsigned (&)[4], const pg8::Unit&, int, int) const {}
    __device__ __forceinline__ void operator()(const f32x4 (&acc)[2][2][4][2], const pg8::Unit& u, int wr, int wc, int fr, int fq, const unsigned (&)[4]) const {
        const int row0 = u.pm * 256 + wr * 64 + fr, col0 = u.pn * 256 + wc * 32 + 8 * fq;
#pragma unroll
        for (int ai = 0; ai < 2; ++ai)
#pragma unroll
            for (int m = 0; m < 4; ++m) {
                bf16_t* rowp = O + (size_t)(row0 + ai * 128 + m * 16) * ldc + col0;
#pragma unroll
                for (int bj = 0; bj < 2; ++bj) {
                    const f32x4 v0 = acc[ai][bj][m][0], v1 = acc[ai][bj][m][1];
                    u32x4 w; w.x = pk_bf16(v0[0], v0[1]); w.y = pk_bf16(v0[2], v0[3]); w.z = pk_bf16(v1[0], v1[1]); w.w = pk_bf16(v1[2], v1[3]);
                    *(u32x4*)(rowp + bj * 128) = w;
                }
            }
    }
};
__device__ __forceinline__ float silu_mul(float g, float u) { return g * __builtin_amdgcn_rcpf(1.0f + __builtin_amdgcn_exp2f(-g * LOG2E)) * u; }
struct EpiSwiglu {
    static constexpr bool PERM = true, AFTER_DRAIN = false;
    bf16_t* O; const unsigned short* rs;
    __device__ __forceinline__ void prefetch(unsigned (&pre)[4], const pg8::Unit& u, int wr, int fr) const { rs_prefetch(pre, rs, u.pm, wr, fr); }
    __device__ __forceinline__ void operator()(const f32x4 (&acc)[2][2][4][2], const pg8::Unit& u, int wr, int wc, int fr, int fq, const unsigned (&pre)[4]) const {
        const int row0 = u.pm * 256 + wr * 64 + fr, col0 = u.pn * 128 + wc * 32 + 8 * fq;
#pragma unroll
        for (int ai = 0; ai < 2; ++ai)
#pragma unroll
            for (int m = 0; m < 4; ++m) {
                const int row = row0 + ai * 128 + m * 16; const float r = rs_get(pre, ai, m);
                const f32x4 g0 = acc[ai][0][m][0] * r, g1 = acc[ai][0][m][1] * r, u0 = acc[ai][1][m][0] * r, u1 = acc[ai][1][m][1] * r;
                u32x4 w; w.x = pk_bf16(silu_mul(g0[0], u0[0]), silu_mul(g0[1], u0[1])); w.y = pk_bf16(silu_mul(g0[2], u0[2]), silu_mul(g0[3], u0[3]));
                w.z = pk_bf16(silu_mul(g1[0], u1[0]), silu_mul(g1[1], u1[1])); w.w = pk_bf16(silu_mul(g1[2], u1[2]), silu_mul(g1[3], u1[3]));
                *(u32x4*)(O + (size_t)row * DFF + col0) = w;
            }
    }
};

__device__ __forceinline__ void wt_item(const float* __restrict__ W, int ldw, int srccol, const float* __restrict__ gain, bf16_t* __restrict__ WT, int K, int n0, int k0, LAS float* scr, int lane) {
#pragma unroll 8
    for (int i = 0; i < 32; ++i) { const int kk = 2 * i + (lane >> 5); float v = W[(size_t)(k0 + kk) * ldw + srccol]; if (gain) v *= gain[k0 + kk]; scr[kk * 33 + (lane & 31)] = v; }
    asm volatile("s_waitcnt lgkmcnt(0)" ::: "memory");
    const int c = lane & 7;
#pragma unroll
    for (int j = 0; j < 4; ++j) { const int n = (lane >> 3) + 8 * j; const LAS float* s = scr + (8 * c) * 33 + n;
        u32x4 o; o.x = pk_bf16(s[0 * 33], s[1 * 33]); o.y = pk_bf16(s[2 * 33], s[3 * 33]); o.z = pk_bf16(s[4 * 33], s[5 * 33]); o.w = pk_bf16(s[6 * 33], s[7 * 33]);
        *(u32x4*)(WT + (size_t)(n0 + n) * K + k0 + 8 * c) = o; }
    asm volatile("s_waitcnt lgkmcnt(0)" ::: "memory");
}
__device__ __forceinline__ void prologue(const Params& p, LAS unsigned char* lds, int tid, int lane, int wave) {
    unsigned char* ws = p.ws;
    LAS float* scr = (LAS float*)(lds + wave * 16384);
    const int gw = blockIdx.x * NWAVES + wave, NGW = gridDim.x * NWAVES;
    constexpr int I_IN = 16 * 96, I_OUT = 16 * 32, I_GU = 16 * 176, I_DN = 44 * 32, I_L = I_IN + I_OUT + I_GU + I_DN;
    for (int it = gw; it < 2 * I_L; it += NGW) {
        const int l = it / I_L; int r = it - l * I_L; const int n = lane & 31;
        if (r < I_IN) { const int kb = r / 96, nb = r % 96, n0 = 32 * nb; const int ph = n0 + n; int src = ph;
            if (ph < 768) { const int fl = ph & 63; src = (ph & ~63) + 32 * ((fl >> 2) & 1) + 4 * (fl >> 3) + (fl & 3); }
            wt_item(p.w_in + (size_t)l * DM * DIN, DIN, src, p.g_pre_mix + l * DM, (bf16_t*)(ws + WS_WIN) + (size_t)l * DIN * DM, DM, n0, 64 * kb, scr, lane); continue; }
        r -= I_IN;
        if (r < I_OUT) { const int kb = r / 32, nb = r % 32, n0 = 32 * nb;
            wt_item(p.w_out + (size_t)l * DM * DM, DM, n0 + n, nullptr, (bf16_t*)(ws + WS_WOUT) + (size_t)l * DM * DM, DM, n0, 64 * kb, scr, lane); continue; }
        r -= I_OUT;
        if (r < I_GU) { const int kb = r / 176, nb = r % 176, n0 = 32 * nb, pn = n0 >> 8, cc = n0 & 255;
            const float* W = (cc < 128 ? p.w_gate : p.w_up) + (size_t)l * DM * DFF;
            wt_item(W, DFF, 128 * pn + (cc & 127) + n, p.g_pre_ffn + l * DM, (bf16_t*)(ws + WS_WGU) + (size_t)l * 2 * DFF * DM, DM, n0, 64 * kb, scr, lane); continue; }
        r -= I_GU;
        { const int kb = r / 32, nb = r % 32, n0 = 32 * nb;
            wt_item(p.w_down + (size_t)l * DFF * DM, DM, n0 + n, nullptr, (bf16_t*)(ws + WS_WDN) + (size_t)l * DM * DFF, DFF, n0, 64 * kb, scr, lane); }
    }
    { unsigned* cs = (unsigned*)(ws + WS_COS);
      for (int idx = blockIdx.x * 512 + tid; idx < 8192 * 32; idx += gridDim.x * 512) {
          const int pos = idx >> 5, i = idx & 31; double inv = 1.0; for (int k = 0; k < i; ++k) inv *= 0.7498942093324559;
          double rev = (double)pos * inv * 0.15915494309189535; rev -= __builtin_rint(rev);
          const float f = (float)rev; cs[idx] = pk_bf16(__builtin_amdgcn_cosf(f), __builtin_amdgcn_sinf(f)); } }
    { bf16_t* xb = (bf16_t*)(ws + WS_XB); unsigned short* rs = (unsigned short*)(ws + WS_RS);
      for (int row = gw; row < M_TOK; row += NGW) {
          const float* xr = row < NP_ROWS ? p.x_p + (size_t)row * DM : p.x_s + (size_t)(row - NP_ROWS) * DM;
          f32x4 v[4]; float ss = 0.f;
#pragma unroll
          for (int j = 0; j < 4; ++j) { v[j] = __builtin_nontemporal_load((const f32x4*)xr + 64 * j + lane); ss += (v[j][0] * v[j][0] + v[j][1] * v[j][1]) + (v[j][2] * v[j][2] + v[j][3] * v[j][3]); }
          ss = wave_sum(ss);
          u32x2* o8 = (u32x2*)(xb + (size_t)row * DM);
#pragma unroll
          for (int j = 0; j < 4; ++j) { u32x2 w; w.x = pk_bf16(v[j][0], v[j][1]); w.y = pk_bf16(v[j][2], v[j][3]); o8[64 * j + lane] = w; }
          if (lane == 0) rs_store(rs, row, 1.0f / sqrtf(ss * (1.0f / DM) + RMS_EPS));
      } }
}

template <bool FINAL>
__device__ __forceinline__ void ew_phase(const Params& p, const float* __restrict__ g, int lane, int wave) {
    unsigned char* ws = p.ws; const bf16_t* Y = (const bf16_t*)(ws + WS_Y); bf16_t* xb = (bf16_t*)(ws + WS_XB); unsigned short* rs = (unsigned short*)(ws + WS_RS);
    const int gw = blockIdx.x * NWAVES + wave, NGW = gridDim.x * NWAVES;
    f32x4 gv[4];
#pragma unroll
    for (int j = 0; j < 4; ++j) gv[j] = ((const f32x4*)g)[64 * j + lane];
    u32x2 yq[2][4], xq[2][4];
#pragma unroll
    for (int d = 0; d < 2; ++d) { int r0 = gw + d * NGW; r0 = r0 < M_TOK ? r0 : gw;
#pragma unroll
        for (int j = 0; j < 4; ++j) { yq[d][j] = __builtin_nontemporal_load((const u32x2*)(Y + (size_t)r0 * DM) + 64 * j + lane); xq[d][j] = ((const u32x2*)(xb + (size_t)r0 * DM))[64 * j + lane]; } }
    for (int row = gw; row < M_TOK; row += NGW) {
        u32x2* xr = (u32x2*)(xb + (size_t)row * DM);
        u32x2 yc[4], xc[4];
#pragma unroll
        for (int j = 0; j < 4; ++j) { yc[j] = yq[0][j]; xc[j] = xq[0][j]; yq[0][j] = yq[1][j]; xq[0][j] = xq[1][j]; }
        { int r2 = row + 2 * NGW; r2 = r2 < M_TOK ? r2 : row;
#pragma unroll
          for (int j = 0; j < 4; ++j) { yq[1][j] = __builtin_nontemporal_load((const u32x2*)(Y + (size_t)r2 * DM) + 64 * j + lane); xq[1][j] = ((const u32x2*)(xb + (size_t)r2 * DM))[64 * j + lane]; } }
        f32x4 xv[4], yf[4]; float ss = 0.f;
#pragma unroll
        for (int j = 0; j < 4; ++j) { const u32x2 w = yc[j], xw = xc[j];
            xv[j] = (f32x4){bf_lo(xw.x), bf_hi(xw.x), bf_lo(xw.y), bf_hi(xw.y)};
            yf[j] = (f32x4){bf_lo(w.x), bf_hi(w.x), bf_lo(w.y), bf_hi(w.y)}; ss += (yf[j][0] * yf[j][0] + yf[j][1] * yf[j][1]) + (yf[j][2] * yf[j][2] + yf[j][3] * yf[j][3]); }
        ss = wave_sum(ss); const float r = 1.0f / sqrtf(ss * (1.0f / DM) + RMS_EPS);
        float s2 = 0.f;
#pragma unroll
        for (int j = 0; j < 4; ++j) { const f32x4 xn = xv[j] + yf[j] * r * gv[j]; xv[j] = xn; s2 += (xn[0] * xn[0] + xn[1] * xn[1]) + (xn[2] * xn[2] + xn[3] * xn[3]); }
        if (FINAL) { float* orow = p.out + (size_t)row * DM;
#pragma unroll
            for (int j = 0; j < 4; ++j) __builtin_nontemporal_store(xv[j], (f32x4*)orow + 64 * j + lane);
        } else {
            s2 = wave_sum(s2);
#pragma unroll
            for (int j = 0; j < 4; ++j) { u32x2 w; w.x = pk_bf16(xv[j][0], xv[j][1]); w.y = pk_bf16(xv[j][2], xv[j][3]); xr[64 * j + lane] = w; }
            if (lane == 0) rs_store(rs, row, 1.0f / sqrtf(s2 * (1.0f / DM) + RMS_EPS));
        }
    }
}

__device__ __forceinline__ bf16x8 ld8(const bf16_t* p) { return *(const bf16x8*)p; }
__device__ __forceinline__ void attn_store(bf16_t* orow, const f32x4 (&o)[4], float l, int fq) {
    l += __shfl_xor(l, 16); l += __shfl_xor(l, 32);
    const float inv = 1.0f / l;
#pragma unroll
    for (int c = 0; c < 4; ++c) { u32x2 w; w.x = pk_bf16(o[c][0] * inv, o[c][1] * inv); w.y = pk_bf16(o[c][2] * inv, o[c][3] * inv); *(u32x2*)(orow + 16 * c + 4 * fq) = w; }
}

struct PairRegs { bf16x8 k[2][2]; u32x4 v[2][2]; };

template <int NG> struct DilU { int seq0, L, r, u0, h; };
template <int D, int NG>
__device__ __forceinline__ DilU<NG> dilu_params(int item) {
    constexpr int CH = 16 * NG;
    DilU<NG> P; P.h = item % 6; const int cidx = item / 6, row0g = cidx * CH;
    int S; seq_of_row(row0g, S, P.seq0);
    constexpr int LG_CH = (CH == 16) ? 4 : (CH == 32) ? 5 : 6, LG_D = (D == 1) ? 0 : (D == 4) ? 2 : 4;
    const int lc = (row0g - P.seq0) >> LG_CH, lgLc = ((S == 2048) ? 11 : 13) - LG_D - LG_CH;
    P.L = S >> LG_D; P.r = lc >> lgLc; P.u0 = (lc & ((1 << lgLc) - 1)) << LG_CH;
    return P;
}
template <int D, int NG>
__device__ __forceinline__ void dilu_load(PairRegs& R, int p, const DilU<NG>& P, const bf16_t* proj, unsigned kofs, unsigned vofs) {
    const int rb = P.h * M_TOK + P.seq0 + P.r;
#pragma unroll
    for (int ab = 0; ab < 2; ++ab) {
        int x0 = P.u0 - 64 + 16 * (2 * p + ab); x0 = x0 < 0 ? 0 : (x0 > P.L - 16 ? P.L - 16 : x0);
        const size_t tb = (size_t)(rb + x0 * D) * 128;
        const char* kb = (const char*)(proj + PB_KD) + tb; const char* vb = (const char*)(proj + PB_VD) + tb;
        R.k[ab][0] = *(const bf16x8*)(kb + kofs); R.k[ab][1] = *(const bf16x8*)(kb + kofs + 64);
        R.v[ab][0] = *(const u32x4*)(vb + vofs); R.v[ab][1] = *(const u32x4*)(vb + vofs + 8 * D * 128);
    }
}
template <int D, int NG, int MODE, int PFD>
__device__ __forceinline__ void dilu_stream(const bf16_t* __restrict__ proj, bf16_t* __restrict__ mixed, bf16_t* __restrict__ ACC, float* __restrict__ LACC, LAS unsigned char* vst, unsigned* ctr, int xcd, int lane) {
    constexpr int NP = (NG + 9) / 2, NPV = ((NP + PFD - 1) / PFD) * PFD, CH = 16 * NG, NITEMS = (M_TOK / CH) * 6, PER = NITEMS / 8;
    static_assert(PFD - 1 <= NP, "ring prologue loads real pairs only");
#define DQ_TICKET(v) do { v = 0u; if (lane == 0) v = __hip_atomic_fetch_add(ctr, 1u, __ATOMIC_RELAXED, __HIP_MEMORY_SCOPE_AGENT); } while (0)
    const int base = xcd * PER;
    unsigned tk0, tk1; DQ_TICKET(tk0); DQ_TICKET(tk1);
    const int first = (int)__builtin_amdgcn_readfirstlane(tk0);
    if (first >= PER) return;
    int nxt = (int)__builtin_amdgcn_readfirstlane(tk1);
    const int fr = lane & 15, fq = lane >> 4, vr = lane >> 3, dlt = 4 * fq - fr;
    const unsigned kofs = (unsigned)((fr * D) * 128 + fq * 16), vofs = (unsigned)((vr * D) * 128 + (lane & 7) * 16);
    const unsigned wofs = vr * 160 + (lane & 7) * 16, trofs = (4 * fq + ((lane & 15) >> 2)) * 160 + (lane & 3) * 8;
    int it = base + first, par = 0;
    DilU<NG> P = dilu_params<D, NG>(it);
    PairRegs ring[PFD];
    bf16x8 q[NG][2];
#pragma unroll
    for (int g = 0; g < NG; ++g) { const bf16_t* qp = proj + PB_QD + (size_t)((P.h * M_TOK + P.seq0 + P.r + (P.u0 + 16 * g + fr) * D) * 64 + 8 * fq); q[g][0] = ld8(qp); q[g][1] = ld8(qp + 32); }
#pragma unroll
    for (int s = 0; s < PFD - 1; ++s) dilu_load<D, NG>(ring[s], s, P, proj, kofs, vofs);
    for (;;) {
        const bool has_next = nxt < PER; const int itn = base + nxt;
        unsigned tkn; DQ_TICKET(tkn);
        const DilU<NG> PN = dilu_params<D, NG>(has_next ? itn : it);
        bf16x8 qn[NG][2];
#pragma unroll
        for (int g = 0; g < NG; ++g) { const bf16_t* qp = proj + PB_QD + (size_t)((PN.h * M_TOK + PN.seq0 + PN.r + (PN.u0 + 16 * g + fr) * D) * 64 + 8 * fq); qn[g][0] = ld8(qp); qn[g][1] = ld8(qp + 32); }
        u32x2 pacc[NG][4]; float pl[NG];
        if (MODE != 0) {
#pragma unroll
            for (int g = 0; g < NG; ++g) { const int rowq = P.seq0 + P.r + (P.u0 + 16 * g + fr) * D; const bf16_t* ap = ACC + (size_t)(rowq * 6 + P.h) * 64 + 4 * fq;
#pragma unroll
                for (int c = 0; c < 4; ++c) pacc[g][c] = *(const u32x2*)(ap + 16 * c);
                pl[g] = LACC[rowq * 6 + P.h]; }
        }
        f32x4 o[NG][4]; float l[NG];
#pragma unroll
        for (int g = 0; g < NG; ++g) { l[g] = 0.f;
#pragma unroll
            for (int c = 0; c < 4; ++c) o[g][c] = (f32x4){0.f, 0.f, 0.f, 0.f}; }
#pragma unroll
        for (int p = 0; p < NPV; ++p) {
            const int m = p + PFD - 1;
            if (m < NPV) { if (m < NP) dilu_load<D, NG>(ring[m % PFD], m, P, proj, kofs, vofs); }
            else { if (m - NPV < NP) dilu_load<D, NG>(ring[m % PFD], m - NPV, PN, proj, kofs, vofs); }
            if (p >= NP) continue;
            const PairRegs& R = ring[p % PFD];
            LAS unsigned char* vbuf = vst + (((p & 1) ^ par) * 5120);
#pragma unroll
            for (int ab = 0; ab < 2; ++ab) { *(LAS u32x4*)(vbuf + ab * 2560 + wofs) = R.v[ab][0]; *(LAS u32x4*)(vbuf + ab * 2560 + wofs + 8 * 160) = R.v[ab][1]; }
            asm volatile("s_waitcnt lgkmcnt(0)" ::: "memory");
            bf16x8 vt[4];
#pragma unroll
            for (int c = 0; c < 4; ++c) {
                const s16x4 ta = __builtin_amdgcn_ds_read_tr16_b64_v4i16((LAS s16x4*)(vbuf + trofs + c * 32));
                const s16x4 tb = __builtin_amdgcn_ds_read_tr16_b64_v4i16((LAS s16x4*)(vbuf + 2560 + trofs + c * 32));
                vt[c] = (bf16x8){ta[0], ta[1], ta[2], ta[3], tb[0], tb[1], tb[2], tb[3]};
            }
            bool tok[2];
#pragma unroll
            for (int ab = 0; ab < 2; ++ab) { const int x0 = P.u0 - 64 + 16 * (2 * p + ab); tok[ab] = (x0 >= 0 && x0 < P.L); }
#pragma unroll
            for (int g = 0; g < NG; ++g) {
                const int dja = 2 * p - g, djb = 2 * p + 1 - g;
                const bool acta = dja >= 0 && dja <= 8, actb = djb >= 0 && djb <= 8;
                if (!acta && !actb) continue;
                f32x4 pr[2];
#pragma unroll
                for (int ab = 0; ab < 2; ++ab) {
                    const int dj = ab ? djb : dja; const bool act = ab ? actb : acta;
                    if (!act) { pr[ab] = (f32x4){0.f, 0.f, 0.f, 0.f}; continue; }
                    f32x4 s = {0.f, 0.f, 0.f, 0.f};
                    s = __builtin_amdgcn_mfma_f32_16x16x32_bf16(R.k[ab][0], q[g][0], s, 0, 0, 0);
                    s = __builtin_amdgcn_mfma_f32_16x16x32_bf16(R.k[ab][1], q[g][1], s, 0, 0, 0);
#pragma unroll
                    for (int e = 0; e < 4; ++e) {
                        float ex = __builtin_amdgcn_exp2f(s[e]);
                        bool ok = tok[ab];
                        if (dj == 0) ok = ok && (dlt + e >= 0);
                        if (dj == 8) ok = ok && (dlt + e <= 0);
                        ex = ok ? ex : 0.f;
                        pr[ab][e] = ex; l[g] += ex;
                    }
                }
                union { u32x4 u; bf16x8 h; } pp; pp.u.x = pk_bf16(pr[0][0], pr[0][1]); pp.u.y = pk_bf16(pr[0][2], pr[0][3]); pp.u.z = pk_bf16(pr[1][0], pr[1][1]); pp.u.w = pk_bf16(pr[1][2], pr[1][3]);
#pragma unroll
                for (int c = 0; c < 4; ++c) o[g][c] = __builtin_amdgcn_mfma_f32_16x16x32_bf16(vt[c], pp.h, o[g][c], 0, 0, 0);
            }
        }
#pragma unroll
        for (int g = 0; g < NG; ++g) {
            float lg = l[g]; lg += __shfl_xor(lg, 16); lg += __shfl_xor(lg, 32);
            const int rowq = P.seq0 + P.r + (P.u0 + 16 * g + fr) * D;
            bf16_t* ap = ACC + (size_t)(rowq * 6 + P.h) * 64 + 4 * fq; float* lp = LACC + rowq * 6 + P.h;
            if (MODE == 0) {
#pragma unroll
                for (int c = 0; c < 4; ++c) { u32x2 w; w.x = pk_bf16(o[g][c][0], o[g][c][1]); w.y = pk_bf16(o[g][c][2], o[g][c][3]); *(u32x2*)(ap + 16 * c) = w; }
                if (fq == 0) *lp = lg;
            } else if (MODE == 1) {
#pragma unroll
                for (int c = 0; c < 4; ++c) { const u32x2 pw = pacc[g][c]; const f32x4 t = (f32x4){bf_lo(pw.x), bf_hi(pw.x), bf_lo(pw.y), bf_hi(pw.y)} + o[g][c];
                    u32x2 w; w.x = pk_bf16(t[0], t[1]); w.y = pk_bf16(t[2], t[3]); *(u32x2*)(ap + 16 * c) = w; }
                if (fq == 0) *lp = pl[g] + lg;
            } else {
                const float inv = 1.0f / (pl[g] + lg);
                bf16_t* orow = mixed + (size_t)rowq * DM + P.h * 64 + 4 * fq;
#pragma unroll
                for (int c = 0; c < 4; ++c) { const u32x2 pw = pacc[g][c]; const f32x4 t = ((f32x4){bf_lo(pw.x), bf_hi(pw.x), bf_lo(pw.y), bf_hi(pw.y)} + o[g][c]) * inv; u32x2 w; w.x = pk_bf16(t[0], t[1]); w.y = pk_bf16(t[2], t[3]); *(u32x2*)(orow + 16 * c) = w; }
            }
        }
        if (!has_next) break;
        it = itn; nxt = (int)__builtin_amdgcn_readfirstlane(tkn); P = PN; par ^= (NP & 1);
#pragma unroll
        for (int g = 0; g < NG; ++g) { q[g][0] = qn[g][0]; q[g][1] = qn[g][1]; }
    }
}

#ifndef CFG_NG
#define CFG_NG 2
#define CFG_PF 2
#endif
#undef DQ_TICKET
struct Na2P { int kvrow; const bf16_t* qp; const LAS float* bb; int rs0, rows, kc0, qc, cs, orow, h, d1; };
__device__ __forceinline__ Na2P na2_params(const bf16_t* proj, const LAS float* tbl, int item, int lane) {
    Na2P P; const int fr = lane & 15, fq = lane >> 4;
    int S, t; if (item < 8 * 16 * 16) { S = 2048; t = item; } else { S = 8192; t = item - 8 * 16 * 16; }
    const int rows = S >> 6, per = (rows >> 1) * 16, seq = t / per, u = t - seq * per, rp = u >> 4, cb = u & 3; P.h = (u >> 2) & 3;
    const int seq0 = (S == 2048) ? seq * 2048 : NP_ROWS + seq * 8192, r = 2 * rp;
    int rs0 = r - 4; rs0 = rs0 < 0 ? 0 : (rs0 > rows - 8 ? rows - 8 : rs0);
    int rs1 = r - 3; rs1 = rs1 < 0 ? 0 : (rs1 > rows - 8 ? rows - 8 : rs1);
    P.rs0 = rs0; P.rows = rows; P.d1 = rs1 - rs0;
    int kc0 = 16 * cb - 8; kc0 = kc0 < 0 ? 0 : (kc0 > 32 ? 32 : kc0); P.kc0 = kc0;
    P.qc = 16 * cb + fr; int cs = P.qc - 8; cs = cs < 0 ? 0 : (cs > 48 ? 48 : cs); P.cs = cs;
    P.kvrow = P.h * M_TOK + seq0 + kc0;
    P.orow = seq0 + r * 64 + P.qc;
    P.qp = proj + PB_QN + ((size_t)P.h * M_TOK + P.orow) * 64 + 8 * fq;
    P.bb = tbl + P.h * 465 + (rs0 - r + 7) * 31;
    return P;
}
__device__ __forceinline__ void na2_load(PairRegs& R, int n, const Na2P& P, const bf16_t* proj, unsigned kofs, unsigned vofs) {
    int kr = P.rs0 + n; kr = kr > P.rows - 1 ? P.rows - 1 : kr;
#pragma unroll
    for (int hh = 0; hh < 2; ++hh) {
        const size_t tb = (size_t)(P.kvrow + kr * 64 + 16 * hh) * 128;
        const char* kb = (const char*)(proj + PB_KN) + tb; const char* vb = (const char*)(proj + PB_VN) + tb;
        R.k[hh][0] = *(const bf16x8*)(kb + kofs); R.k[hh][1] = *(const bf16x8*)(kb + kofs + 64);
        R.v[hh][0] = *(const u32x4*)(vb + vofs); R.v[hh][1] = *(const u32x4*)(vb + vofs + 8 * 128);
    }
}
template <int PFD>
__device__ __forceinline__ void na2_stream(const bf16_t* __restrict__ proj, bf16_t* __restrict__ mixed, LAS unsigned char* vst, const LAS float* tbl, int first, int stride, int lane) {
    constexpr int NP = 9, NPV = ((NP + PFD - 1) / PFD) * PFD, NITEMS = (M_TOK / 128) * 16;
    if (first >= NITEMS) return;
    const int fr = lane & 15, fq = lane >> 4, vr = lane >> 3;
    const unsigned kofs = (unsigned)(fr * 128 + fq * 16), vofs = (unsigned)(vr * 128 + (lane & 7) * 16);
    const unsigned wofs = vr * 160 + (lane & 7) * 16, trofs = (4 * fq + ((lane & 15) >> 2)) * 160 + (lane & 3) * 8;
    int it = first;
    Na2P P = na2_params(proj, tbl, it, lane);
    PairRegs ring[PFD];
    bf16x8 q[2][2];
#pragma unroll
    for (int g = 0; g < 2; ++g) { q[g][0] = ld8(P.qp + g * 4096); q[g][1] = ld8(P.qp + g * 4096 + 32); }
#pragma unroll
    for (int s = 0; s < PFD - 1; ++s) na2_load(ring[s], s, P, proj, kofs, vofs);
    for (;;) {
        const int itn = it + stride; const bool has_next = itn < NITEMS;
        const Na2P PN = na2_params(proj, tbl, has_next ? itn : it, lane);
        bf16x8 qn[2][2];
#pragma unroll
        for (int g = 0; g < 2; ++g) { qn[g][0] = ld8(PN.qp + g * 4096); qn[g][1] = ld8(PN.qp + g * 4096 + 32); }
        f32x4 o[2][4]; float l[2];
#pragma unroll
        for (int g = 0; g < 2; ++g) { l[g] = 0.f;
#pragma unroll
            for (int c = 0; c < 4; ++c) o[g][c] = (f32x4){0.f, 0.f, 0.f, 0.f}; }
#pragma unroll
        for (int p = 0; p < NPV; ++p) {
            const int m = p + PFD - 1;
            if (m < NPV) { if (m < NP) na2_load(ring[m % PFD], m, P, proj, kofs, vofs); }
            else { if (m - NPV < NP) na2_load(ring[m % PFD], m - NPV, PN, proj, kofs, vofs); }
            if (p >= NP) continue;
            const PairRegs& R = ring[p % PFD];
            LAS unsigned char* vbuf = vst + (p % 3) * 5120;
#pragma unroll
            for (int ab = 0; ab < 2; ++ab) { *(LAS u32x4*)(vbuf + ab * 2560 + wofs) = R.v[ab][0]; *(LAS u32x4*)(vbuf + ab * 2560 + wofs + 8 * 160) = R.v[ab][1]; }
            asm volatile("s_waitcnt lgkmcnt(0)" ::: "memory");
            bf16x8 vt[4];
#pragma unroll
            for (int c = 0; c < 4; ++c) {
                const s16x4 ta = __builtin_amdgcn_ds_read_tr16_b64_v4i16((LAS s16x4*)(vbuf + trofs + c * 32));
                const s16x4 tb = __builtin_amdgcn_ds_read_tr16_b64_v4i16((LAS s16x4*)(vbuf + 2560 + trofs + c * 32));
                vt[c] = (bf16x8){ta[0], ta[1], ta[2], ta[3], tb[0], tb[1], tb[2], tb[3]};
            }
#pragma unroll
            for (int g = 0; g < 2; ++g) {
                if (g == 0 && p == 8) continue;
                const bool act = (g == 0) ? true : (p == 0 ? P.d1 == 0 : (p == 8 ? P.d1 == 1 : true));
                const LAS float* brow = P.bb + (p - g) * 31;
                f32x4 pr[2];
#pragma unroll
                for (int hh = 0; hh < 2; ++hh) {
                    f32x4 s = {0.f, 0.f, 0.f, 0.f};
                    s = __builtin_amdgcn_mfma_f32_16x16x32_bf16(R.k[hh][0], q[g][0], s, 0, 0, 0);
                    s = __builtin_amdgcn_mfma_f32_16x16x32_bf16(R.k[hh][1], q[g][1], s, 0, 0, 0);
#pragma unroll
                    for (int e = 0; e < 4; ++e) { const int kc = P.kc0 + 16 * hh + 4 * fq + e; const bool valid = act && (kc >= P.cs) && (kc < P.cs + 16);
                        int dc = kc - P.qc + 15; dc = dc < 0 ? 0 : (dc > 30 ? 30 : dc);
                        const float ex = __builtin_amdgcn_exp2f(s[e] + brow[dc]); pr[hh][e] = valid ? ex : 0.f; l[g] += pr[hh][e]; }
                }
                union { u32x4 u; bf16x8 h; } pp; pp.u.x = pk_bf16(pr[0][0], pr[0][1]); pp.u.y = pk_bf16(pr[0][2], pr[0][3]); pp.u.z = pk_bf16(pr[1][0], pr[1][1]); pp.u.w = pk_bf16(pr[1][2], pr[1][3]);
#pragma unroll
                for (int c = 0; c < 4; ++c) o[g][c] = __builtin_amdgcn_mfma_f32_16x16x32_bf16(vt[c], pp.h, o[g][c], 0, 0, 0);
            }
        }
#pragma unroll
        for (int g = 0; g < 2; ++g) attn_store(mixed + (size_t)(P.orow + g * 64) * DM + 384 + P.h * 64, o[g], l[g], fq);
        if (!has_next) break;
        it = itn; P = PN;
#pragma unroll
        for (int g = 0; g < 2; ++g) { q[g][0] = qn[g][0]; q[g][1] = qn[g][1]; }
    }
}

constexpr int DIL_NG = CFG_NG, DIL_PF = CFG_PF;
__device__ __forceinline__ void mix_a(const Params& p, int layer, LAS unsigned char* lds, int tid, int lane, int wave) {
    unsigned char* ws = p.ws; const bf16_t* proj = (const bf16_t*)(ws + WS_PROJ); bf16_t* mixed = (bf16_t*)(ws + WS_MIXED);
    LAS float* tbl = (LAS float*)(lds + 131072);
    for (int i = tid; i < 4 * 465; i += 512) tbl[i] = p.rpb[layer * 4 * 465 + i] * LOG2E;
    __syncthreads();
    LAS unsigned char* vst = lds + wave * 16384;
    const int vcu = (gridDim.x % 8 == 0) ? (int)(blockIdx.x % 8) * (int)(gridDim.x / 8) + (int)(blockIdx.x / 8) : (int)blockIdx.x;
    const int gw = vcu * NWAVES + wave, NGW = gridDim.x * NWAVES;
    dilu_stream<16, DIL_NG, 0, DIL_PF>(proj, mixed, (bf16_t*)(ws + WS_Y), (float*)(ws + WS_Y + 128 * MiB), vst, (unsigned*)(ws + WS_QCTR) + ((layer * 3 + 0) * 8 + (int)(blockIdx.x & 7)) * 64, (int)(blockIdx.x & 7), lane);
    na2_stream<2>(proj, mixed, vst, tbl, gw, NGW, lane);
}
__device__ __forceinline__ void mix_b(const Params& p, int layer, LAS unsigned char* lds, int tid, int lane, int wave) {
    unsigned char* ws = p.ws; const bf16_t* proj = (const bf16_t*)(ws + WS_PROJ); bf16_t* mixed = (bf16_t*)(ws + WS_MIXED);
    LAS unsigned char* vst = lds + wave * 16384;
    const int vcu = (gridDim.x % 8 == 0) ? (int)(blockIdx.x % 8) * (int)(gridDim.x / 8) + (int)(blockIdx.x / 8) : (int)blockIdx.x;
    const int gw = vcu * NWAVES + wave, NGW = gridDim.x * NWAVES;
    dilu_stream<4, DIL_NG, 1, DIL_PF>(proj, mixed, (bf16_t*)(ws + WS_Y), (float*)(ws + WS_Y + 128 * MiB), vst, (unsigned*)(ws + WS_QCTR) + ((layer * 3 + 1) * 8 + (int)(blockIdx.x & 7)) * 64, (int)(blockIdx.x & 7), lane);
    const float* cw = p.conv_w + layer * 3 * 384;
    for (int idx = blockIdx.x * 512 + tid; idx < M_TOK * 48; idx += gridDim.x * 512) {
        const int row = idx / 48, c0 = (idx - row * 48) * 8;
        int S, seq0; seq_of_row(row, S, seq0); const int pos = row - seq0;
        const bf16_t* base = proj + PB_CV + (size_t)row * DCV + c0;
        const u32x4 gb = *(const u32x4*)base;
        float acc[8];
#pragma unroll
        for (int k = 0; k < 8; ++k) acc[k] = 0.f;
#pragma unroll
        for (int j = 0; j < 3; ++j) {
            const int pp = pos + j - 1;
            if (pp >= 0 && pp < S) {
                const bf16_t* bj = base + (ptrdiff_t)(j - 1) * DCV;
                const u32x4 gc = *(const u32x4*)(bj + 384), hi = *(const u32x4*)(bj + 768);
                const f32x4 w0 = *(const f32x4*)(cw + j * 384 + c0), w1 = *(const f32x4*)(cw + j * 384 + c0 + 4);
                acc[0] += w0[0] * bf_lo(gc.x) * bf_lo(hi.x); acc[1] += w0[1] * bf_hi(gc.x) * bf_hi(hi.x);
                acc[2] += w0[2] * bf_lo(gc.y) * bf_lo(hi.y); acc[3] += w0[3] * bf_hi(gc.y) * bf_hi(hi.y);
                acc[4] += w1[0] * bf_lo(gc.z) * bf_lo(hi.z); acc[5] += w1[1] * bf_hi(gc.z) * bf_hi(hi.z);
                acc[6] += w1[2] * bf_lo(gc.w) * bf_lo(hi.w); acc[7] += w1[3] * bf_hi(gc.w) * bf_hi(hi.w);
            }
        }
        u32x4 w; w.x = pk_bf16(acc[0] * bf_lo(gb.x), acc[1] * bf_hi(gb.x)); w.y = pk_bf16(acc[2] * bf_lo(gb.y), acc[3] * bf_hi(gb.y));
        w.z = pk_bf16(acc[4] * bf_lo(gb.z), acc[5] * bf_hi(gb.z)); w.w = pk_bf16(acc[6] * bf_lo(gb.w), acc[7] * bf_hi(gb.w));
        *(u32x4*)(mixed + (size_t)row * DM + 640 + c0) = w;
    }
}
__device__ __forceinline__ void mix_c(const Params& p, int layer, LAS unsigned char* lds, int lane, int wave) {
    unsigned char* ws = p.ws; const bf16_t* proj = (const bf16_t*)(ws + WS_PROJ); bf16_t* mixed = (bf16_t*)(ws + WS_MIXED);
    LAS unsigned char* vst = lds + wave * 16384;
    const int vcu = (gridDim.x % 8 == 0) ? (int)(blockIdx.x % 8) * (int)(gridDim.x / 8) + (int)(blockIdx.x / 8) : (int)blockIdx.x;
    const int gw = vcu * NWAVES + wave, NGW = gridDim.x * NWAVES;
    dilu_stream<1, DIL_NG, 2, DIL_PF>(proj, mixed, (bf16_t*)(ws + WS_Y), (float*)(ws + WS_Y + 128 * MiB), vst, (unsigned*)(ws + WS_QCTR) + ((layer * 3 + 2) * 8 + (int)(blockIdx.x & 7)) * 64, (int)(blockIdx.x & 7), lane);
}

#define XB_TMO      128
#define XB_XCNT(j)  (256  + 64 * (j))
#define XB_XSUB(j)  (1280 + 64 * (j))
#define XB_XGEN(j)  (2304 + 64 * (j))
#define XB_TOP      3328
#define XB_TOPGEN   3392
#define XCD_BAR_WORDS 3456
#define XB_SPIN_CAP (1u << 18)

__device__ __forceinline__ unsigned xb_ld(unsigned* p)              { return __hip_atomic_load(p, __ATOMIC_RELAXED, __HIP_MEMORY_SCOPE_AGENT); }
__device__ __forceinline__ unsigned xb_add(unsigned* p, unsigned v) { return __hip_atomic_fetch_add(p, v, __ATOMIC_RELAXED, __HIP_MEMORY_SCOPE_AGENT); }
__device__ __forceinline__ unsigned xb_xcc_id() { return (unsigned)__builtin_amdgcn_s_getreg((3 << 11) | 20) & 0xFu; }
#define XB_SPIN(cond, bar) do { unsigned _sp = 0; while (cond) { __builtin_amdgcn_s_sleep(1); \
    if ((++_sp & 255u) == 0u) { if (xb_ld(&(bar)[XB_TMO])) break; if (_sp > XB_SPIN_CAP) { atomicAdd(&(bar)[XB_TMO], 1u); break; } } } } while (0)

struct XcdBarrier {
    unsigned* bar; unsigned x;
    volatile LAS unsigned* st;
};

__device__ __forceinline__ XcdBarrier xcd_barrier_post(unsigned* bar, volatile LAS unsigned* st) {
    XcdBarrier b; b.bar = bar; b.x = xb_xcc_id(); b.st = st;
    if (threadIdx.x == 0) (void)xb_add(&bar[XB_XCNT(b.x)], 1u);
    return b;
}
__device__ __forceinline__ void xcd_barrier_complete(unsigned* bar, unsigned x, unsigned& nloc, unsigned& nx) {
    const unsigned G = gridDim.x * gridDim.y * gridDim.z;
    unsigned sum, cnt, mine, sp = 0u;
    for (;;) {
        sum = 0u; cnt = 0u; mine = 0u;
#pragma unroll
        for (unsigned j = 0; j < 16; ++j) { const unsigned c = xb_ld(&bar[XB_XCNT(j)]); sum += c; cnt += (c > 0u) ? 1u : 0u; mine = (j == x) ? c : mine; }
        if (sum == G) break;
        __builtin_amdgcn_s_sleep(1);
        if ((++sp & 255u) == 0u) { if (xb_ld(&bar[XB_TMO])) break; if (sp > XB_SPIN_CAP) { atomicAdd(&bar[XB_TMO], 1u); break; } }
    }
    nloc = mine > 0u ? mine : 1u; nx = cnt > 0u ? cnt : 1u;
}

__device__ __forceinline__ void xcd_barrier(const XcdBarrier& b) {
    asm volatile("s_waitcnt vmcnt(0)" ::: "memory");
    __syncthreads();
    if (threadIdx.x == 0) {
        unsigned* bar = b.bar;
        __builtin_amdgcn_s_waitcnt(0);
        unsigned nloc = b.st[0], nx = b.st[1];
        if (nloc == 0u) { xcd_barrier_complete(bar, b.x, nloc, nx); b.st[0] = nloc; b.st[1] = nx; }
        const unsigned old = xb_add(&bar[XB_XSUB(b.x)], 1u);
        const unsigned gen = old / nloc;
        if (old + 1u == (gen + 1u) * nloc) {
            __builtin_amdgcn_fence(__ATOMIC_RELEASE, "agent");
            asm volatile("s_waitcnt vmcnt(0)" ::: "memory");
            const unsigned og = xb_add(&bar[XB_TOP], 1u);
            const unsigned tg = og / nx;
            if (og + 1u == (tg + 1u) * nx) xb_add(&bar[XB_TOPGEN], 1u);
            else XB_SPIN(xb_ld(&bar[XB_TOPGEN]) == tg, bar);
            __builtin_amdgcn_fence(__ATOMIC_ACQUIRE, "agent");
            xb_add(&bar[XB_XGEN(b.x)], 1u);
            asm volatile("s_waitcnt vmcnt(0)" ::: "memory");
        } else {
            XB_SPIN(xb_ld(&bar[XB_XGEN(b.x)]) == gen, bar);
            __builtin_amdgcn_fence(__ATOMIC_ACQUIRE, "agent");
            asm volatile("s_waitcnt vmcnt(0)" ::: "memory");
        }
    }
    __syncthreads();
}

__global__ void __launch_bounds__(512) fwd_mega(Params p) {
    extern __shared__ __attribute__((aligned(16))) unsigned char lds_raw[];
    LAS unsigned char* lds = (LAS unsigned char*)lds_raw;
    cg::grid_group grid = cg::this_grid();
    unsigned char* ws = p.ws;
#define FRESH_TID() int tid = threadIdx.x; asm volatile("" : "+v"(tid)); const int lane = tid & 63, wave = __builtin_amdgcn_readfirstlane(tid >> 6)
    bf16_t* xb = (bf16_t*)(ws + WS_XB); bf16_t* proj = (bf16_t*)(ws + WS_PROJ); bf16_t* mixed = (bf16_t*)(ws + WS_MIXED); bf16_t* Y = (bf16_t*)(ws + WS_Y); bf16_t* H = (bf16_t*)(ws + WS_H);
    const unsigned short* rs = (const unsigned short*)(ws + WS_RS);

    if (threadIdx.x < 4) ((volatile LAS unsigned*)(lds + 139264))[threadIdx.x] = 0u;
    __syncthreads();
    const XcdBarrier xbar = xcd_barrier_post((unsigned*)(ws + WS_CTL), (volatile LAS unsigned*)(lds + 139264));
    { FRESH_TID(); prologue(p, lds, tid, lane, wave); }
    grid.sync();
    for (int layer = 0; layer < 2; ++layer) {
        {
            pg8::Gemm g{xb, (const bf16_t*)(ws + WS_WIN) + (size_t)layer * DIN * DM, M_TOK, DIN, DM}; pg8::StaticOrder S; S.init(M_TOK, DIN, (int)gridDim.x, (int)blockIdx.x);
            EpiProj E{proj, rs, (const unsigned*)(ws + WS_COS)};
            pg8::gemm_phase<EpiProj, pg8::StaticOrder>(lds, g, S, E);
        }
        xcd_barrier(xbar);
        { FRESH_TID(); mix_a(p, layer, lds, tid, lane, wave); }
        xcd_barrier(xbar);
        { FRESH_TID(); mix_b(p, layer, lds, tid, lane, wave); }
        xcd_barrier(xbar);
        { FRESH_TID(); (void)tid; mix_c(p, layer, lds, lane, wave); }
        xcd_barrier(xbar);
        {
            pg8::Gemm g{mixed, (const bf16_t*)(ws + WS_WOUT) + (size_t)layer * DM * DM, M_TOK, DM, DM}; pg8::StaticOrder S; S.init(M_TOK, DM, (int)gridDim.x, (int)blockIdx.x);
            EpiPlain E{Y, DM};
            pg8::gemm_phase<EpiPlain, pg8::StaticOrder>(lds, g, S, E);
        }
        xcd_barrier(xbar);
        { FRESH_TID(); (void)tid; ew_phase<false>(p, p.g_post_mix + layer * DM, lane, wave); }
        xcd_barrier(xbar);
        {
            pg8::Gemm g{xb, (const bf16_t*)(ws + WS_WGU) + (size_t)layer * 2 * DFF * DM, M_TOK, 2 * DFF, DM}; pg8::StaticOrder S; S.init(M_TOK, 2 * DFF, (int)gridDim.x, (int)blockIdx.x);
            EpiSwiglu E{H, rs};
            pg8::gemm_phase<EpiSwiglu, pg8::StaticOrder>(lds, g, S, E);
        }
        xcd_barrier(xbar);
        {
            pg8::Gemm g{H, (const bf16_t*)(ws + WS_WDN) + (size_t)layer * DM * DFF, M_TOK, DM, DFF}; pg8::StaticOrder S; S.init(M_TOK, DM, (int)gridDim.x, (int)blockIdx.x);
            EpiPlain E{Y, DM};
            pg8::gemm_phase<EpiPlain, pg8::StaticOrder>(lds, g, S, E);
        }
        xcd_barrier(xbar);
        if (layer == 0) { { FRESH_TID(); (void)tid; ew_phase<false>(p, p.g_post_ffn + layer * DM, lane, wave); } xcd_barrier(xbar); }
        else { FRESH_TID(); (void)tid; ew_phase<true>(p, p.g_post_ffn + layer * DM, lane, wave); }
    }
}

extern "C" void kernel_launch(void* const* d_in, const int* in_sizes, int n_in, void* d_out, int out_size, void* d_ws, size_t ws_size, hipStream_t stream) {
    static int grid_blocks = 0;
    if (!grid_blocks) {
        if (n_in != 13 || out_size != M_TOK * DM || ws_size < WS_END) { fprintf(stderr, "kernel_launch: unexpected sizes (n_in %d out %d ws %zu)\n", n_in, out_size, ws_size); grid_blocks = -1; return; }
        int dev = 0, cus = 0, per_cu = 0;
        hipGetDevice(&dev); hipDeviceGetAttribute(&cus, hipDeviceAttributeMultiprocessorCount, dev);
        hipFuncSetAttribute((const void*)fwd_mega, hipFuncAttributeMaxDynamicSharedMemorySize, LDS_BYTES);
        hipOccupancyMaxActiveBlocksPerMultiprocessor(&per_cu, (const void*)fwd_mega, 512, LDS_BYTES);
        if (per_cu < 1) { fprintf(stderr, "kernel_launch: occupancy query says %d blocks per CU\n", per_cu); per_cu = 1; }
        (void)hipGetLastError();
        grid_blocks = cus * per_cu;
    }
    if (grid_blocks < 0) return;
    Params p{};
    p.x_p = (const float*)d_in[0]; p.x_s = (const float*)d_in[1]; p.g_pre_mix = (const float*)d_in[2]; p.w_in = (const float*)d_in[3]; p.conv_w = (const float*)d_in[4];
    p.rpb = (const float*)d_in[5]; p.w_out = (const float*)d_in[6]; p.g_post_mix = (const float*)d_in[7]; p.g_pre_ffn = (const float*)d_in[8]; p.w_gate = (const float*)d_in[9];
    p.w_up = (const float*)d_in[10]; p.w_down = (const float*)d_in[11]; p.g_post_ffn = (const float*)d_in[12]; p.out = (float*)d_out; p.ws = (unsigned char*)d_ws;
    if (hipMemsetAsync((char*)d_ws + WS_CTL, 0, CTL_BYTES, stream) != hipSuccess) { fprintf(stderr, "kernel_launch: memset of the barrier words failed\n"); return; }
    void* args[] = {&p};
    hipError_t e = hipLaunchCooperativeKernel((const void*)fwd_mega, dim3(grid_blocks), dim3(512), args, LDS_BYTES, stream);
    if (e != hipSuccess) fprintf(stderr, "cooperative launch failed: %s (grid %d)\n", hipGetErrorString(e), grid_blocks);
}
```

```cpp
#include <hip/hip_runtime.h>
#include <hip/hip_cooperative_groups.h>
#include <cstdio>
namespace cg = cooperative_groups;
namespace pg8 {
#define PG8_LAS __attribute__((address_space(3)))
typedef unsigned short bf16_t;
typedef short bf16x8 __attribute__((ext_vector_type(8)));
typedef float f32x4 __attribute__((ext_vector_type(4)));
typedef unsigned u32x4 __attribute__((ext_vector_type(4)));
constexpr int BM = 256, BK = 64, HALF = 128, HTB = HALF * BK * 2  , STAGE_BYTES = 8 * HTB, NXCD = 8, WGM = 8;

__host__ __device__ __forceinline__ int lds_byte(int r, int c) { const int st = (r >> 4) * 2 + (c >> 5), rr = r & 15, cc = c & 31, ob = rr * 64 + cc * 2; return st * 1024 + (ob ^ (((ob >> 9) & 1) << 5)); }
__host__ __device__ __forceinline__ void stage_rc(int b, int& R, int& C) { const int st = b / 1024, sb = b % 1024, swz = sb ^ (((sb >> 9) & 1) << 5); R = (st >> 1) * 16 + swz / 64; C = (st & 1) * 32 + (swz % 64) / 2; }
__host__ __device__ __forceinline__ int perm32(int rho) { const int n = rho >> 4, i = rho & 15; return 8 * (i >> 2) + 4 * n + (i & 3); }

struct Unit { int pm, pn; };
struct Gemm { const bf16_t* A; const bf16_t* Bt; int M, N, K; };

struct StaticOrder {
    int nM, nN, nwg, G, c;
    __host__ __device__ void init(int M, int N, int G_, int c_) { nM = M / BM; nN = N / BM; nwg = nM * nN; G = G_; c = c_; }
    __host__ __device__ bool next(int i, Unit& u) const {
        const long L = (long)i * G + c; if (L >= nwg) return false;
        int wgid = (int)L; { const int q = nwg / NXCD, r = nwg % NXCD, xcd = wgid % NXCD, off = wgid / NXCD; wgid = (xcd < r ? xcd * (q + 1) : r * (q + 1) + (xcd - r) * q) + off; }
        const int nig = WGM * nN, gid = wgid / nig, fm = gid * WGM, gsz = (nM - fm) < WGM ? (nM - fm) : WGM;
        u.pm = fm + ((wgid % nig) % gsz); u.pn = (wgid % nig) / gsz; return true;
    }
    __device__ __forceinline__ void a_ready(const Unit&) const {}
    __device__ __forceinline__ void done(const Unit&) const {}
};
typedef float f32x2 __attribute__((ext_vector_type(2)));
template <class Epi, class Sched, bool ALIGN_EPI = true, bool SP2 = true>
__device__ __forceinline__ void gemm_phase(PG8_LAS unsigned char* lds, const Gemm g, const Sched& S, const Epi& E) {
    int tid_ = threadIdx.x; asm volatile("" : "+v"(tid_));
    const int tid = tid_, wid = __builtin_amdgcn_readfirstlane(tid >> 6), lane = tid & 63, wr = wid >> 2, wc = wid & 3, fr = lane & 15, fq = lane >> 4;
    const int K = g.K, nt = K / BK;
    unsigned voffA[2], voffB[2];
#pragma unroll
    for (int i = 0; i < 2; ++i) { int R, C; stage_rc(tid * 16 + i * 8192, R, C); const int Rb = Epi::PERM ? ((R & ~31) + perm32(R & 31)) : R;
        voffA[i] = (unsigned)(R * K + C) * 2u; voffB[i] = (unsigned)(Rb * K + C) * 2u; }
    const size_t kstep = (size_t)(BK * 2);
    const size_t hstep = (size_t)HALF * K * 2;
    const size_t tstep = 2 * hstep;
    const unsigned ldsw = (unsigned)wid * 1024u;
    const int aoff = lds_byte(wr * 64 + fr, fq * 8), boff = lds_byte(wc * 32 + fr, fq * 8);
#define PG8_SA(b, h) (((b) * 2 + (h)) * HTB)
#define PG8_SB(b, h) ((4 + (b) * 2 + (h)) * HTB)
#define PG8_STAGE(bufoff, gbase, voff) do { _Pragma("unroll") for (int _i = 0; _i < 2; ++_i) \
        __builtin_amdgcn_global_load_lds((const unsigned*)((const char*)(gbase) + (voff)[_i]), (PG8_LAS unsigned*)(lds + (bufoff) + ldsw + _i * 8192), 16, 0, 0); } while (0)
#define PG8_LDA(dst, b, h) do { _Pragma("unroll") for (int m = 0; m < 4; ++m) _Pragma("unroll") for (int k = 0; k < 2; ++k) dst[m][k] = *(const PG8_LAS bf16x8*)(lds + PG8_SA(b, h) + aoff + m * 2048 + k * 1024); } while (0)
#define PG8_LDB(dst, b, h) do { _Pragma("unroll") for (int n = 0; n < 2; ++n) _Pragma("unroll") for (int k = 0; k < 2; ++k) dst[n][k] = *(const PG8_LAS bf16x8*)(lds + PG8_SB(b, h) + boff + n * 2048 + k * 1024); } while (0)
#define PG8_MMA(ai, bj, At, Bt) do { __builtin_amdgcn_s_setprio(1); _Pragma("unroll") for (int m = 0; m < 4; ++m) _Pragma("unroll") for (int n = 0; n < 2; ++n) _Pragma("unroll") for (int k = 0; k < 2; ++k) \
        acc[ai][bj][m][n] = __builtin_amdgcn_mfma_f32_16x16x32_bf16(Bt[n][k], At[m][k], acc[ai][bj][m][n], 0, 0, 0); __builtin_amdgcn_s_setprio(0); } while (0)
#define PG8_WAIT_V(n) asm volatile("s_waitcnt vmcnt(" #n ")" ::: "memory")
#define PG8_WAIT_L(n) asm volatile("s_waitcnt lgkmcnt(" #n ")" ::: "memory")
#define PG8_BAR __builtin_amdgcn_s_barrier()
#define PG8_SCHED __builtin_amdgcn_sched_barrier(0)
    Unit cur, nxt; int ui = 0; unsigned epre[4];
#pragma unroll
    for (int i = 0; i < 4; ++i) epre[i] = 0u;
    if (!S.next(0, cur)) return;
    f32x4 acc[2][2][4][2];
#pragma unroll
    for (int a = 0; a < 2; ++a)
#pragma unroll
        for (int b = 0; b < 2; ++b)
#pragma unroll
            for (int m = 0; m < 4; ++m)
#pragma unroll
                for (int n = 0; n < 2; ++n) acc[a][b][m][n] = (f32x4){0.f, 0.f, 0.f, 0.f};
    bf16x8 At[4][2], B0[2][2], B1[2][2];
    const char* cA = (const char*)g.A + (size_t)cur.pm * tstep; const char* cB = (const char*)g.Bt + (size_t)cur.pn * tstep;
    S.a_ready(cur);
    if constexpr (SP2) {
        PG8_STAGE(PG8_SB(0, 0), cB, voffB); PG8_STAGE(PG8_SB(0, 1), cB + hstep, voffB); PG8_STAGE(PG8_SA(0, 0), cA, voffA); PG8_STAGE(PG8_SA(0, 1), cA + hstep, voffA);
        if (wr == 1) PG8_BAR;
        PG8_WAIT_V(2); PG8_BAR;
        PG8_STAGE(PG8_SB(1, 0), cB + kstep, voffB); PG8_STAGE(PG8_SA(1, 0), cA + kstep, voffA); PG8_STAGE(PG8_SB(1, 1), cB + hstep + kstep, voffB);
        PG8_WAIT_V(6); PG8_BAR;
    } else {
        PG8_STAGE(PG8_SB(0, 0), cB, voffB); PG8_STAGE(PG8_SA(0, 0), cA, voffA); PG8_STAGE(PG8_SB(0, 1), cB + hstep, voffB); PG8_STAGE(PG8_SA(0, 1), cA + hstep, voffA);
        if (wr == 1) PG8_BAR;
        PG8_WAIT_V(4); PG8_BAR;
        PG8_STAGE(PG8_SB(1, 0), cB + kstep, voffB); PG8_STAGE(PG8_SA(1, 0), cA + kstep, voffA); PG8_STAGE(PG8_SB(1, 1), cB + hstep + kstep, voffB);
        PG8_WAIT_V(6); PG8_BAR;
    }
    for (;;) {
        const bool has_next = S.next(ui + 1, nxt);
        const char* nA = has_next ? (const char*)g.A + (size_t)nxt.pm * tstep : cA; const char* nB = has_next ? (const char*)g.Bt + (size_t)nxt.pn * tstep : cB;
        for (int t = 0; t < nt; t += 2) {
            const bool last = (t == nt - 2);
            const char* a1 = cA + (size_t)(t + 1) * kstep;
            const char* a2 = last ? nA : cA + (size_t)(t + 2) * kstep; const char* b2 = last ? nB : cB + (size_t)(t + 2) * kstep;
            const char* a3 = a2 + kstep; const char* b3 = b2 + kstep;
            if (last && has_next) S.a_ready(nxt);
            if (last) E.prefetch(epre, cur, wr, fr);
            if constexpr (SP2) {
            PG8_LDB(B0, 0, 0); PG8_LDB(B1, 0, 1); PG8_SCHED; PG8_LDA(At, 0, 0); PG8_STAGE(PG8_SA(1, 1), a1 + hstep, voffA);
            PG8_WAIT_V(8); PG8_WAIT_L(0); PG8_BAR; PG8_MMA(0, 0, At, B0); PG8_MMA(0, 1, At, B1); PG8_BAR; PG8_SCHED;
            PG8_LDA(At, 0, 1); PG8_STAGE(PG8_SB(0, 0), b2, voffB); PG8_STAGE(PG8_SB(0, 1), b2 + hstep, voffB); PG8_STAGE(PG8_SA(0, 0), a2, voffA);
            PG8_WAIT_V(8); PG8_WAIT_L(0); PG8_BAR; PG8_MMA(1, 0, At, B0); PG8_MMA(1, 1, At, B1); PG8_BAR; PG8_SCHED;
            PG8_LDB(B0, 1, 0); PG8_LDB(B1, 1, 1); PG8_SCHED; PG8_LDA(At, 1, 0); PG8_STAGE(PG8_SA(0, 1), a2 + hstep, voffA);
            PG8_WAIT_V(8); PG8_WAIT_L(0); PG8_BAR; PG8_MMA(0, 0, At, B0); PG8_MMA(0, 1, At, B1); PG8_BAR; PG8_SCHED;
            PG8_LDA(At, 1, 1); PG8_STAGE(PG8_SB(1, 0), b3, voffB); PG8_STAGE(PG8_SB(1, 1), b3 + hstep, voffB); PG8_STAGE(PG8_SA(1, 0), a3, voffA);
            PG8_WAIT_V(8); PG8_WAIT_L(0); PG8_BAR; PG8_MMA(1, 0, At, B0); PG8_MMA(1, 1, At, B1); PG8_BAR; PG8_SCHED;
            } else {
            PG8_LDB(B0, 0, 0); PG8_SCHED; PG8_LDA(At, 0, 0); PG8_STAGE(PG8_SA(1, 1), a1 + hstep, voffA);
            PG8_WAIT_L(8); PG8_BAR; PG8_WAIT_L(0); PG8_MMA(0, 0, At, B0); PG8_BAR; PG8_SCHED;
            PG8_LDB(B1, 0, 1); PG8_STAGE(PG8_SB(0, 0), b2, voffB);
            PG8_BAR; PG8_WAIT_L(0); PG8_MMA(0, 1, At, B1); PG8_BAR;
            PG8_LDA(At, 0, 1); PG8_STAGE(PG8_SA(0, 0), a2, voffA);
            PG8_BAR; PG8_WAIT_L(0); PG8_MMA(1, 0, At, B0); PG8_BAR; PG8_SCHED;
            PG8_STAGE(PG8_SB(0, 1), b2 + hstep, voffB);
            PG8_WAIT_V(6); PG8_BAR; PG8_MMA(1, 1, At, B1); PG8_BAR;
            PG8_LDB(B0, 1, 0); PG8_SCHED; PG8_LDA(At, 1, 0); PG8_STAGE(PG8_SA(0, 1), a2 + hstep, voffA);
            PG8_WAIT_L(8); PG8_BAR; PG8_WAIT_L(0); PG8_MMA(0, 0, At, B0); PG8_BAR; PG8_SCHED;
            PG8_LDB(B1, 1, 1); PG8_STAGE(PG8_SB(1, 0), b3, voffB);
            PG8_BAR; PG8_WAIT_L(0); PG8_MMA(0, 1, At, B1); PG8_BAR;
            PG8_LDA(At, 1, 1); PG8_STAGE(PG8_SA(1, 0), a3, voffA);
            PG8_BAR; PG8_WAIT_L(0); PG8_MMA(1, 0, At, B0); PG8_BAR; PG8_SCHED;
            PG8_STAGE(PG8_SB(1, 1), b3 + hstep, voffB);
            PG8_WAIT_V(6); PG8_BAR; PG8_MMA(1, 1, At, B1); PG8_BAR;
            }
        }
        if constexpr (ALIGN_EPI) { if (wr == 0) PG8_BAR; }
        if constexpr (!Epi::AFTER_DRAIN) { E(acc, cur, wr, wc, fr, fq, epre); S.done(cur); }
        if (!has_next) break;
#pragma unroll
        for (int a = 0; a < 2; ++a)
#pragma unroll
            for (int b = 0; b < 2; ++b)
#pragma unroll
                for (int m = 0; m < 4; ++m)
#pragma unroll
                    for (int n = 0; n < 2; ++n) acc[a][b][m][n] = (f32x4){0.f, 0.f, 0.f, 0.f};
        cur = nxt; cA = nA; cB = nB; ++ui;
        if constexpr (ALIGN_EPI) { if (wr == 1) PG8_BAR; }
    }
    PG8_WAIT_V(0);
    if constexpr (!ALIGN_EPI) { if (wr == 0) PG8_BAR; }
    PG8_BAR;
    if constexpr (Epi::AFTER_DRAIN) { E.fused(acc, cur, wr, wc, fr, fq, lds, wid, lane); S.done(cur); }
#undef PG8_SA
#undef PG8_SB
#undef PG8_STAGE
#undef PG8_LDA
#undef PG8_LDB
#undef PG8_MMA
#undef PG8_WAIT_V
#undef PG8_WAIT_L
#undef PG8_BAR
#undef PG8_SCHED
}
}

using pg8::bf16_t; using pg8::bf16x8; using pg8::f32x4; using pg8::u32x4;
#define LAS __attribute__((address_space(3)))
typedef short s16x4 __attribute__((ext_vector_type(4)));
typedef unsigned u32x2 __attribute__((ext_vector_type(2)));
constexpr int M_TOK = 81920, NP_ROWS = 16384, DM = 1024, DIN = 3072, DFF = 2816;
constexpr float RMS_EPS = 1e-6f, LOG2E = 1.4426950408889634f, QSCALE = 0.125f * 1.4426950408889634f;
constexpr size_t MiB = 1u << 20;
constexpr size_t WS_WIN = 0, WS_WOUT = 12 * MiB, WS_WGU = 16 * MiB, WS_WDN = 38 * MiB, WS_COS = 49 * MiB, WS_SIN = 50 * MiB, WS_RS = 51 * MiB,
                 WS_XB = 52 * MiB, WS_MIXED = 212 * MiB, WS_Y = 372 * MiB, WS_PROJ = 532 * MiB, WS_H = 532 * MiB, WS_CTL = 1012 * MiB, CTL_BYTES = 32768, WS_QCTR = WS_CTL + 16384, WS_END = 1013 * MiB;
constexpr size_t M64 = (size_t)M_TOK * 64;
constexpr size_t PB_QD = 0, PB_KD = 6 * M64, PB_VD = 12 * M64, PB_QN = 18 * M64, PB_KN = 22 * M64, PB_VN = 26 * M64, PB_CV = 30 * M64;
constexpr int DCV = 1152;
constexpr int LDS_BYTES = 147456;
constexpr int NWAVES = 8;

struct Params {
    const float *x_p, *x_s, *g_pre_mix, *w_in, *conv_w, *rpb, *w_out, *g_post_mix, *g_pre_ffn, *w_gate, *w_up, *w_down, *g_post_ffn;
    float* out; unsigned char* ws;
};

typedef float f32x2_t __attribute__((ext_vector_type(2)));
typedef __bf16 bf16x2_t __attribute__((ext_vector_type(2)));
__device__ __forceinline__ unsigned pk_bf16(float lo, float hi) { const f32x2_t v = {lo, hi}; const bf16x2_t b = __builtin_convertvector(v, bf16x2_t); return __builtin_bit_cast(unsigned, b); }
__device__ __forceinline__ float bf_lo(unsigned w) { return __uint_as_float(w << 16); }
__device__ __forceinline__ float bf_hi(unsigned w) { return __uint_as_float(w & 0xffff0000u); }
__device__ __forceinline__ float wave_sum(float v) {
#pragma unroll
    for (int o = 1; o < 64; o <<= 1) v += __shfl_xor(v, o);
    return v;
}
__device__ __forceinline__ void seq_of_row(int row, int& S, int& seq0) {
    if (row < NP_ROWS) { S = 2048; seq0 = row & ~2047; } else { S = 8192; seq0 = NP_ROWS + ((row - NP_ROWS) & ~8191); }
}

__device__ __forceinline__ int rs_idx(int row) { return (row & ~31) | ((row & 15) << 1) | ((row >> 4) & 1); }
__device__ __forceinline__ void rs_store(unsigned short* rsb, int row, float v) { rsb[rs_idx(row)] = (unsigned short)(pk_bf16(v, v) & 0xffffu); }
__device__ __forceinline__ void rs_prefetch(unsigned (&pre)[4], const unsigned short* rsb, int pm, int wr, int fr) {
    const unsigned* r32 = (const unsigned*)rsb;
#pragma unroll
    for (int i = 0; i < 4; ++i) pre[i] = r32[((pm * 256 + wr * 64 + (i >> 1) * 128 + (i & 1) * 32) >> 1) + fr];
}
__device__ __forceinline__ float rs_get(const unsigned (&pre)[4], int ai, int m) { const unsigned w = pre[ai * 2 + (m >> 1)]; return (m & 1) ? bf_hi(w) : bf_lo(w); }
struct EpiProj {
    static constexpr bool PERM = true, AFTER_DRAIN = false;
    bf16_t* O; const unsigned short* rs; const unsigned* cs;
    __device__ __forceinline__ void prefetch(unsigned (&pre)[4], const pg8::Unit& u, int wr, int fr) const { rs_prefetch(pre, rs, u.pm, wr, fr); }
    __device__ __forceinline__ void operator()(const f32x4 (&acc)[2][2][4][2], const pg8::Unit& u, int wr, int wc, int fr, int fq, const unsigned (&pre)[4]) const {
        const int row0 = u.pm * 256 + wr * 64 + fr;
        const int p4 = ((4 * wc + fq) & 7) * 4;
        const unsigned* __restrict__ cs = this->cs; bf16_t* __restrict__ O = this->O;
#pragma unroll
        for (int ai = 0; ai < 2; ++ai)
#pragma unroll
            for (int m = 0; m < 4; ++m) {
                if (m == 0 && ai == 1) asm volatile("" ::: "memory");
                const int row = row0 + ai * 128 + m * 16; const float r = rs_get(pre, ai, m);
                const int pos = row < NP_ROWS ? (row & 2047) : ((row - NP_ROWS) & 8191);
#pragma unroll
                for (int bj = 0; bj < 2; ++bj) {
                    const int cb = 2 * u.pn + bj;
                    bf16_t* dst;
                    if (cb < 15) { const int hl = wc >> 1; size_t tb; int head;
                        if (cb < 3) { tb = PB_QD; head = 2 * cb + hl; } else if (cb < 6) { tb = PB_KD; head = 2 * (cb - 3) + hl; } else if (cb < 9) { tb = PB_VD; head = 2 * (cb - 6) + hl; }
                        else if (cb < 11) { tb = PB_QN; head = 2 * (cb - 9) + hl; } else if (cb < 13) { tb = PB_KN; head = 2 * (cb - 11) + hl; } else { tb = PB_VN; head = 2 * (cb - 13) + hl; }
                        dst = O + tb + ((size_t)head * M_TOK + row) * 64 + 32 * (wc & 1) + 8 * fq;
                    } else dst = O + PB_CV + (size_t)row * DCV + 128 * (cb - 15) + 32 * wc + 8 * fq;
                    f32x4 v0 = acc[ai][bj][m][0] * r, v1 = acc[ai][bj][m][1] * r;
                    if (cb < 6) {
                        const u32x4 t4 = *(const u32x4*)(cs + pos * 32 + p4);
                        const f32x4 c4 = (f32x4){bf_lo(t4.x), bf_lo(t4.y), bf_lo(t4.z), bf_lo(t4.w)}, s4 = (f32x4){bf_hi(t4.x), bf_hi(t4.y), bf_hi(t4.z), bf_hi(t4.w)};
                        const f32x4 n0 = v0 * c4 - v1 * s4, n1 = v0 * s4 + v1 * c4; v0 = n0; v1 = n1;
                    }
                    if (cb < 3 || cb == 9 || cb == 10) { v0 = v0 * QSCALE; v1 = v1 * QSCALE; }
                    u32x4 w; w.x = pk_bf16(v0[0], v0[1]); w.y = pk_bf16(v0[2], v0[3]); w.z = pk_bf16(v1[0], v1[1]); w.w = pk_bf16(v1[2], v1[3]);
                    *(u32x4*)dst = w;
                }
            }
    }
};
struct EpiPlain {
    static constexpr bool PERM = true, AFTER_DRAIN = false;
    bf16_t* O; int ldc;
    __device__ __forceinline__ void prefetch(unsigned (&)[4], const pg8::Unit&, int, int) const {}
    __device__ __forceinline__ void operator()(const f32x4 (&acc)[2][2][4][2], const pg8::Unit& u, int wr, int wc, int fr, int fq, const unsigned (&)[4]) const {
        const int row0 = u.pm * 256 + wr * 64 + fr, col0 = u.pn * 256 + wc * 32 + 8 * fq;
#pragma unroll
        for (int ai = 0; ai < 2; ++ai)
#pragma unroll
            for (int m = 0; m < 4; ++m) {
                bf16_t* rowp = O + (size_t)(row0 + ai * 128 + m * 16) * ldc + col0;
#pragma unroll
                for (int bj = 0; bj < 2; ++bj) {
                    const f32x4 v0 = acc[ai][bj][m][0], v1 = acc[ai][bj][m][1];
                    u32x4 w; w.x = pk_bf16(v0[0], v0[1]); w.y = pk_bf16(v0[2], v0[3]); w.z = pk_bf16(v1[0], v1[1]); w.w = pk_bf16(v1[2], v1[3]);
                    *(u32x4*)(rowp + bj * 128) = w;
                }
            }
    }
};
__device__ __forceinline__ float silu_mul(float g, float u) { return g * __builtin_amdgcn_rcpf(1.0f + __builtin_amdgcn_exp2f(-g * LOG2E)) * u; }
struct EpiSwiglu {
    static constexpr bool PERM = true, AFTER_DRAIN = false;
    bf16_t* O; const unsigned short* rs;
    __device__ __forceinline__ void prefetch(unsigned (&pre)[4], const pg8::Unit& u, int wr, int fr) const { rs_prefetch(pre, rs, u.pm, wr, fr); }
    __device__ __forceinline__ void operator()(const f32x4 (&acc)[2][2][4][2], const pg8::Unit& u, int wr, int wc, int fr, int fq, const unsigned (&pre)[4]) const {
        const int row0 = u.pm * 256 + wr * 64 + fr, col0 = u.pn * 128 + wc * 32 + 8 * fq;
#pragma unroll
        for (int ai = 0; ai < 2; ++ai)
#pragma unroll
            for (int m = 0; m < 4; ++m) {
                const int row = row0 + ai * 128 + m * 16; const float r = rs_get(pre, ai, m);
                const f32x4 g0 = acc[ai][0][m][0] * r, g1 = acc[ai][0][m][1] * r, u0 = acc[ai][1][m][0] * r, u1 = acc[ai][1][m][1] * r;
                u32x4 w; w.x = pk_bf16(silu_mul(g0[0], u0[0]), silu_mul(g0[1], u0[1])); w.y = pk_bf16(silu_mul(g0[2], u0[2]), silu_mul(g0[3], u0[3]));
                w.z = pk_bf16(silu_mul(g1[0], u1[0]), silu_mul(g1[1], u1[1])); w.w = pk_bf16(silu_mul(g1[2], u1[2]), silu_mul(g1[3], u1[3]));
                *(u32x4*)(O + (size_t)row * DFF + col0) = w;
            }
    }
};

__device__ __forceinline__ void wt_item(const float* __restrict__ W, int ldw, int srccol, const float* __restrict__ gain, bf16_t* __restrict__ WT, int K, int n0, int k0, LAS float* scr, int lane) {
#pragma unroll 8
    for (int i = 0; i < 32; ++i) { const int kk = 2 * i + (lane >> 5); float v = W[(size_t)(k0 + kk) * ldw + srccol]; if (gain) v *= gain[k0 + kk]; scr[kk * 33 + (lane & 31)] = v; }
    asm volatile("s_waitcnt lgkmcnt(0)" ::: "memory");
    const int c = lane & 7;
#pragma unroll
    for (int j = 0; j < 4; ++j) { const int n = (lane >> 3) + 8 * j; const LAS float* s = scr + (8 * c) * 33 + n;
        u32x4 o; o.x = pk_bf16(s[0 * 33], s[1 * 33]); o.y = pk_bf16(s[2 * 33], s[3 * 33]); o.z = pk_bf16(s[4 * 33], s[5 * 33]); o.w = pk_bf16(s[6 * 33], s[7 * 33]);
        *(u32x4*)(WT + (size_t)(n0 + n) * K + k0 + 8 * c) = o; }
    asm volatile("s_waitcnt lgkmcnt(0)" ::: "memory");
}
__device__ __forceinline__ void prologue(const Params& p, LAS unsigned char* lds, int tid, int lane, int wave) {
    unsigned char* ws = p.ws;
    LAS float* scr = (LAS float*)(lds + wave * 16384);
    const int gw = blockIdx.x * NWAVES + wave, NGW = gridDim.x * NWAVES;
    constexpr int I_IN = 16 * 96, I_OUT = 16 * 32, I_GU = 16 * 176, I_DN = 44 * 32, I_L = I_IN + I_OUT + I_GU + I_DN;
    for (int it = gw; it < 2 * I_L; it += NGW) {
        const int l = it / I_L; int r = it - l * I_L; const int n = lane & 31;
        if (r < I_IN) { const int kb = r / 96, nb = r % 96, n0 = 32 * nb; const int ph = n0 + n; int src = ph;
            if (ph < 768) { const int fl = ph & 63; src = (ph & ~63) + 32 * ((fl >> 2) & 1) + 4 * (fl >> 3) + (fl & 3); }
            wt_item(p.w_in + (size_t)l * DM * DIN, DIN, src, p.g_pre_mix + l * DM, (bf16_t*)(ws + WS_WIN) + (size_t)l * DIN * DM, DM, n0, 64 * kb, scr, lane); continue; }
        r -= I_IN;
        if (r < I_OUT) { const int kb = r / 32, nb = r % 32, n0 = 32 * nb;
            wt_item(p.w_out + (size_t)l * DM * DM, DM, n0 + n, nullptr, (bf16_t*)(ws + WS_WOUT) + (size_t)l * DM * DM, DM, n0, 64 * kb, scr, lane); continue; }
        r -= I_OUT;
        if (r < I_GU) { const int kb = r / 176, nb = r % 176, n0 = 32 * nb, pn = n0 >> 8, cc = n0 & 255;
            const float* W = (cc < 128 ? p.w_gate : p.w_up) + (size_t)l * DM * DFF;
            wt_item(W, DFF, 128 * pn + (cc & 127) + n, p.g_pre_ffn + l * DM, (bf16_t*)(ws + WS_WGU) + (size_t)l * 2 * DFF * DM, DM, n0, 64 * kb, scr, lane); continue; }
        r -= I_GU;
        { const int kb = r / 32, nb = r % 32, n0 = 32 * nb;
            wt_item(p.w_down + (size_t)l * DFF * DM, DM, n0 + n, nullptr, (bf16_t*)(ws + WS_WDN) + (size_t)l * DM * DFF, DFF, n0, 64 * kb, scr, lane); }
    }
    { unsigned* cs = (unsigned*)(ws + WS_COS);
      for (int idx = blockIdx.x * 512 + tid; idx < 8192 * 32; idx += gridDim.x * 512) {
          const int pos = idx >> 5, i = idx & 31; double inv = 1.0; for (int k = 0; k < i; ++k) inv *= 0.7498942093324559;
          double rev = (double)pos * inv * 0.15915494309189535; rev -= __builtin_rint(rev);
          const float f = (float)rev; cs[idx] = pk_bf16(__builtin_amdgcn_cosf(f), __builtin_amdgcn_sinf(f)); } }
    { bf16_t* xb = (bf16_t*)(ws + WS_XB); unsigned short* rs = (unsigned short*)(ws + WS_RS);
      for (int row = gw; row < M_TOK; row += NGW) {
          const float* xr = row < NP_ROWS ? p.x_p + (size_t)row * DM : p.x_s + (size_t)(row - NP_ROWS) * DM;
          f32x4 v[4]; float ss = 0.f;
#pragma unroll
          for (int j = 0; j < 4; ++j) { v[j] = ((const f32x4*)xr)[64 * j + lane]; ss += (v[j][0] * v[j][0] + v[j][1] * v[j][1]) + (v[j][2] * v[j][2] + v[j][3] * v[j][3]); }
          ss = wave_sum(ss);
          u32x2* o8 = (u32x2*)(xb + (size_t)row * DM);
#pragma unroll
          for (int j = 0; j < 4; ++j) { u32x2 w; w.x = pk_bf16(v[j][0], v[j][1]); w.y = pk_bf16(v[j][2], v[j][3]); o8[64 * j + lane] = w; }
          if (lane == 0) rs_store(rs, row, 1.0f / sqrtf(ss * (1.0f / DM) + RMS_EPS));
      } }
}

template <bool FINAL>
__device__ __forceinline__ void ew_phase(const Params& p, const float* __restrict__ g, int lane, int wave) {
    unsigned char* ws = p.ws; const bf16_t* Y = (const bf16_t*)(ws + WS_Y); bf16_t* xb = (bf16_t*)(ws + WS_XB); unsigned short* rs = (unsigned short*)(ws + WS_RS);
    const int gw = blockIdx.x * NWAVES + wave, NGW = gridDim.x * NWAVES;
    f32x4 gv[4];
#pragma unroll
    for (int j = 0; j < 4; ++j) gv[j] = ((const f32x4*)g)[64 * j + lane];
    u32x2 yq[2][4], xq[2][4];
#pragma unroll
    for (int d = 0; d < 2; ++d) { int r0 = gw + d * NGW; r0 = r0 < M_TOK ? r0 : gw;
#pragma unroll
        for (int j = 0; j < 4; ++j) { yq[d][j] = ((const u32x2*)(Y + (size_t)r0 * DM))[64 * j + lane]; xq[d][j] = ((const u32x2*)(xb + (size_t)r0 * DM))[64 * j + lane]; } }
    for (int row = gw; row < M_TOK; row += NGW) {
        u32x2* xr = (u32x2*)(xb + (size_t)row * DM);
        u32x2 yc[4], xc[4];
#pragma unroll
        for (int j = 0; j < 4; ++j) { yc[j] = yq[0][j]; xc[j] = xq[0][j]; yq[0][j] = yq[1][j]; xq[0][j] = xq[1][j]; }
        { int r2 = row + 2 * NGW; r2 = r2 < M_TOK ? r2 : row;
#pragma unroll
          for (int j = 0; j < 4; ++j) { yq[1][j] = ((const u32x2*)(Y + (size_t)r2 * DM))[64 * j + lane]; xq[1][j] = ((const u32x2*)(xb + (size_t)r2 * DM))[64 * j + lane]; } }
        f32x4 xv[4], yf[4]; float ss = 0.f;
#pragma unroll
        for (int j = 0; j < 4; ++j) { const u32x2 w = yc[j], xw = xc[j];
            xv[j] = (f32x4){bf_lo(xw.x), bf_hi(xw.x), bf_lo(xw.y), bf_hi(xw.y)};
            yf[j] = (f32x4){bf_lo(w.x), bf_hi(w.x), bf_lo(w.y), bf_hi(w.y)}; ss += (yf[j][0] * yf[j][0] + yf[j][1] * yf[j][1]) + (yf[j][2] * yf[j][2] + yf[j][3] * yf[j][3]); }
        ss = wave_sum(ss); const float r = 1.0f / sqrtf(ss * (1.0f / DM) + RMS_EPS);
        float s2 = 0.f;
#pragma unroll
        for (int j = 0; j < 4; ++j) { const f32x4 xn = xv[j] + yf[j] * r * gv[j]; xv[j] = xn; s2 += (xn[0] * xn[0] + xn[1] * xn[1]) + (xn[2] * xn[2] + xn[3] * xn[3]); }
        if (FINAL) { float* orow = p.out + (size_t)row * DM;
#pragma unroll
            for (int j = 0; j < 4; ++j) ((f32x4*)orow)[64 * j + lane] = xv[j];
        } else {
            s2 = wave_sum(s2);
#pragma unroll
            for (int j = 0; j < 4; ++j) { u32x2 w; w.x = pk_bf16(xv[j][0], xv[j][1]); w.y = pk_bf16(xv[j][2], xv[j][3]); xr[64 * j + lane] = w; }
            if (lane == 0) rs_store(rs, row, 1.0f / sqrtf(s2 * (1.0f / DM) + RMS_EPS));
        }
    }
}

__device__ __forceinline__ bf16x8 ld8(const bf16_t* p) { return *(const bf16x8*)p; }
__device__ __forceinline__ void attn_store(bf16_t* orow, const f32x4 (&o)[4], float l, int fq) {
    l += __shfl_xor(l, 16); l += __shfl_xor(l, 32);
    const float inv = 1.0f / l;
#pragma unroll
    for (int c = 0; c < 4; ++c) { u32x2 w; w.x = pk_bf16(o[c][0] * inv, o[c][1] * inv); w.y = pk_bf16(o[c][2] * inv, o[c][3] * inv); *(u32x2*)(orow + 16 * c + 4 * fq) = w; }
}

struct PairRegs { bf16x8 k[2][2]; u32x4 v[2][2]; };

template <int NG> struct DilU { int seq0, L, r, u0, h; };
template <int D, int NG>
__device__ __forceinline__ DilU<NG> dilu_params(int item) {
    constexpr int CH = 16 * NG;
    DilU<NG> P; P.h = item % 6; const int cidx = item / 6, row0g = cidx * CH;
    int S; seq_of_row(row0g, S, P.seq0);
    constexpr int LG_CH = (CH == 16) ? 4 : (CH == 32) ? 5 : 6, LG_D = (D == 1) ? 0 : (D == 4) ? 2 : 4;
    const int lc = (row0g - P.seq0) >> LG_CH, lgLc = ((S == 2048) ? 11 : 13) - LG_D - LG_CH;
    P.L = S >> LG_D; P.r = lc >> lgLc; P.u0 = (lc & ((1 << lgLc) - 1)) << LG_CH;
    return P;
}
template <int D, int NG>
__device__ __forceinline__ void dilu_load(PairRegs& R, int p, const DilU<NG>& P, const bf16_t* proj, unsigned kofs, unsigned vofs) {
    const int rb = P.h * M_TOK + P.seq0 + P.r;
#pragma unroll
    for (int ab = 0; ab < 2; ++ab) {
        int x0 = P.u0 - 64 + 16 * (2 * p + ab); x0 = x0 < 0 ? 0 : (x0 > P.L - 16 ? P.L - 16 : x0);
        const size_t tb = (size_t)(rb + x0 * D) * 128;
        const char* kb = (const char*)(proj + PB_KD) + tb; const char* vb = (const char*)(proj + PB_VD) + tb;
        R.k[ab][0] = *(const bf16x8*)(kb + kofs); R.k[ab][1] = *(const bf16x8*)(kb + kofs + 64);
        R.v[ab][0] = *(const u32x4*)(vb + vofs); R.v[ab][1] = *(const u32x4*)(vb + vofs + 8 * D * 128);
    }
}
template <int D, int NG, int MODE, int PFD>
__device__ __forceinline__ void dilu_stream(const bf16_t* __restrict__ proj, bf16_t* __restrict__ mixed, bf16_t* __restrict__ ACC, float* __restrict__ LACC, LAS unsigned char* vst, unsigned* ctr, int xcd, int lane) {
    constexpr int NP = (NG + 9) / 2, NPV = ((NP + PFD - 1) / PFD) * PFD, CH = 16 * NG, NITEMS = (M_TOK / CH) * 6, PER = NITEMS / 8;
    static_assert(PFD - 1 <= NP, "ring prologue loads real pairs only");
#define DQ_TICKET(v) do { v = 0u; if (lane == 0) v = __hip_atomic_fetch_add(ctr, 1u, __ATOMIC_RELAXED, __HIP_MEMORY_SCOPE_AGENT); } while (0)
    const int base = xcd * PER;
    unsigned tk0, tk1; DQ_TICKET(tk0); DQ_TICKET(tk1);
    const int first = (int)__builtin_amdgcn_readfirstlane(tk0);
    if (first >= PER) return;
    int nxt = (int)__builtin_amdgcn_readfirstlane(tk1);
    const int fr = lane & 15, fq = lane >> 4, vr = lane >> 3, dlt = 4 * fq - fr;
    const unsigned kofs = (unsigned)((fr * D) * 128 + fq * 16), vofs = (unsigned)((vr * D) * 128 + (lane & 7) * 16);
    const unsigned wofs = vr * 160 + (lane & 7) * 16, trofs = (4 * fq + ((lane & 15) >> 2)) * 160 + (lane & 3) * 8;
    int it = base + first, par = 0;
    DilU<NG> P = dilu_params<D, NG>(it);
    PairRegs ring[PFD];
    bf16x8 q[NG][2];
#pragma unroll
    for (int g = 0; g < NG; ++g) { const bf16_t* qp = proj + PB_QD + (size_t)((P.h * M_TOK + P.seq0 + P.r + (P.u0 + 16 * g + fr) * D) * 64 + 8 * fq); q[g][0] = ld8(qp); q[g][1] = ld8(qp + 32); }
#pragma unroll
    for (int s = 0; s < PFD - 1; ++s) dilu_load<D, NG>(ring[s], s, P, proj, kofs, vofs);
    for (;;) {
        const bool has_next = nxt < PER; const int itn = base + nxt;
        unsigned tkn; DQ_TICKET(tkn);
        const DilU<NG> PN = dilu_params<D, NG>(has_next ? itn : it);
        bf16x8 qn[NG][2];
#pragma unroll
        for (int g = 0; g < NG; ++g) { const bf16_t* qp = proj + PB_QD + (size_t)((PN.h * M_TOK + PN.seq0 + PN.r + (PN.u0 + 16 * g + fr) * D) * 64 + 8 * fq); qn[g][0] = ld8(qp); qn[g][1] = ld8(qp + 32); }
        u32x2 pacc[NG][4]; float pl[NG];
        if (MODE != 0) {
#pragma unroll
            for (int g = 0; g < NG; ++g) { const int rowq = P.seq0 + P.r + (P.u0 + 16 * g + fr) * D; const bf16_t* ap = ACC + (size_t)(rowq * 6 + P.h) * 64 + 4 * fq;
#pragma unroll
                for (int c = 0; c < 4; ++c) pacc[g][c] = *(const u32x2*)(ap + 16 * c);
                pl[g] = LACC[rowq * 6 + P.h]; }
        }
        f32x4 o[NG][4]; float l[NG];
#pragma unroll
        for (int g = 0; g < NG; ++g) { l[g] = 0.f;
#pragma unroll
            for (int c = 0; c < 4; ++c) o[g][c] = (f32x4){0.f, 0.f, 0.f, 0.f}; }
#pragma unroll
        for (int p = 0; p < NPV; ++p) {
            const int m = p + PFD - 1;
            if (m < NPV) { if (m < NP) dilu_load<D, NG>(ring[m % PFD], m, P, proj, kofs, vofs); }
            else { if (m - NPV < NP) dilu_load<D, NG>(ring[m % PFD], m - NPV, PN, proj, kofs, vofs); }
            if (p >= NP) continue;
            const PairRegs& R = ring[p % PFD];
            LAS unsigned char* vbuf = vst + (((p & 1) ^ par) * 5120);
#pragma unroll
            for (int ab = 0; ab < 2; ++ab) { *(LAS u32x4*)(vbuf + ab * 2560 + wofs) = R.v[ab][0]; *(LAS u32x4*)(vbuf + ab * 2560 + wofs + 8 * 160) = R.v[ab][1]; }
            asm volatile("s_waitcnt lgkmcnt(0)" ::: "memory");
            bf16x8 vt[4];
#pragma unroll
            for (int c = 0; c < 4; ++c) {
                const s16x4 ta = __builtin_amdgcn_ds_read_tr16_b64_v4i16((LAS s16x4*)(vbuf + trofs + c * 32));
                const s16x4 tb = __builtin_amdgcn_ds_read_tr16_b64_v4i16((LAS s16x4*)(vbuf + 2560 + trofs + c * 32));
                vt[c] = (bf16x8){ta[0], ta[1], ta[2], ta[3], tb[0], tb[1], tb[2], tb[3]};
            }
            bool tok[2];
#pragma unroll
            for (int ab = 0; ab < 2; ++ab) { const int x0 = P.u0 - 64 + 16 * (2 * p + ab); tok[ab] = (x0 >= 0 && x0 < P.L); }
#pragma unroll
            for (int g = 0; g < NG; ++g) {
                const int dja = 2 * p - g, djb = 2 * p + 1 - g;
                const bool acta = dja >= 0 && dja <= 8, actb = djb >= 0 && djb <= 8;
                if (!acta && !actb) continue;
                f32x4 pr[2];
#pragma unroll
                for (int ab = 0; ab < 2; ++ab) {
                    const int dj = ab ? djb : dja; const bool act = ab ? actb : acta;
                    if (!act) { pr[ab] = (f32x4){0.f, 0.f, 0.f, 0.f}; continue; }
                    f32x4 s = {0.f, 0.f, 0.f, 0.f};
                    s = __builtin_amdgcn_mfma_f32_16x16x32_bf16(R.k[ab][0], q[g][0], s, 0, 0, 0);
                    s = __builtin_amdgcn_mfma_f32_16x16x32_bf16(R.k[ab][1], q[g][1], s, 0, 0, 0);
#pragma unroll
                    for (int e = 0; e < 4; ++e) {
                        float ex = __builtin_amdgcn_exp2f(s[e]);
                        bool ok = tok[ab];
                        if (dj == 0) ok = ok && (dlt + e >= 0);
                        if (dj == 8) ok = ok && (dlt + e <= 0);
                        ex = ok ? ex : 0.f;
                        pr[ab][e] = ex; l[g] += ex;
                    }
                }
                union { u32x4 u; bf16x8 h; } pp; pp.u.x = pk_bf16(pr[0][0], pr[0][1]); pp.u.y = pk_bf16(pr[0][2], pr[0][3]); pp.u.z = pk_bf16(pr[1][0], pr[1][1]); pp.u.w = pk_bf16(pr[1][2], pr[1][3]);
#pragma unroll
                for (int c = 0; c < 4; ++c) o[g][c] = __builtin_amdgcn_mfma_f32_16x16x32_bf16(vt[c], pp.h, o[g][c], 0, 0, 0);
            }
        }
#pragma unroll
        for (int g = 0; g < NG; ++g) {
            float lg = l[g]; lg += __shfl_xor(lg, 16); lg += __shfl_xor(lg, 32);
            const int rowq = P.seq0 + P.r + (P.u0 + 16 * g + fr) * D;
            bf16_t* ap = ACC + (size_t)(rowq * 6 + P.h) * 64 + 4 * fq; float* lp = LACC + rowq * 6 + P.h;
            if (MODE == 0) {
#pragma unroll
                for (int c = 0; c < 4; ++c) { u32x2 w; w.x = pk_bf16(o[g][c][0], o[g][c][1]); w.y = pk_bf16(o[g][c][2], o[g][c][3]); *(u32x2*)(ap + 16 * c) = w; }
                if (fq == 0) *lp = lg;
            } else if (MODE == 1) {
#pragma unroll
                for (int c = 0; c < 4; ++c) { const u32x2 pw = pacc[g][c]; const f32x4 t = (f32x4){bf_lo(pw.x), bf_hi(pw.x), bf_lo(pw.y), bf_hi(pw.y)} + o[g][c];
                    u32x2 w; w.x = pk_bf16(t[0], t[1]); w.y = pk_bf16(t[2], t[3]); *(u32x2*)(ap + 16 * c) = w; }
                if (fq == 0) *lp = pl[g] + lg;
            } else {
                const float inv = 1.0f / (pl[g] + lg);
                bf16_t* orow = mixed + (size_t)rowq * DM + P.h * 64 + 4 * fq;
#pragma unroll
                for (int c = 0; c < 4; ++c) { const u32x2 pw = pacc[g][c]; const f32x4 t = ((f32x4){bf_lo(pw.x), bf_hi(pw.x), bf_lo(pw.y), bf_hi(pw.y)} + o[g][c]) * inv; u32x2 w; w.x = pk_bf16(t[0], t[1]); w.y = pk_bf16(t[2], t[3]); *(u32x2*)(orow + 16 * c) = w; }
            }
        }
        if (!has_next) break;
        it = itn; nxt = (int)__builtin_amdgcn_readfirstlane(tkn); P = PN; par ^= (NP & 1);
#pragma unroll
        for (int g = 0; g < NG; ++g) { q[g][0] = qn[g][0]; q[g][1] = qn[g][1]; }
    }
}

#ifndef CFG_NG
#define CFG_NG 2
#define CFG_PF 2
#endif
#undef DQ_TICKET
struct Na2P { int kvrow; const bf16_t* qp; const LAS float* bb; int rs0, rows, kc0, qc, cs, orow, h, d1; };
__device__ __forceinline__ Na2P na2_params(const bf16_t* proj, const LAS float* tbl, int item, int lane) {
    Na2P P; const int fr = lane & 15, fq = lane >> 4;
    int S, t; if (item < 8 * 16 * 16) { S = 2048; t = item; } else { S = 8192; t = item - 8 * 16 * 16; }
    const int rows = S >> 6, per = (rows >> 1) * 16, seq = t / per, u = t - seq * per, rp = u >> 4, cb = u & 3; P.h = (u >> 2) & 3;
    const int seq0 = (S == 2048) ? seq * 2048 : NP_ROWS + seq * 8192, r = 2 * rp;
    int rs0 = r - 4; rs0 = rs0 < 0 ? 0 : (rs0 > rows - 8 ? rows - 8 : rs0);
    int rs1 = r - 3; rs1 = rs1 < 0 ? 0 : (rs1 > rows - 8 ? rows - 8 : rs1);
    P.rs0 = rs0; P.rows = rows; P.d1 = rs1 - rs0;
    int kc0 = 16 * cb - 8; kc0 = kc0 < 0 ? 0 : (kc0 > 32 ? 32 : kc0); P.kc0 = kc0;
    P.qc = 16 * cb + fr; int cs = P.qc - 8; cs = cs < 0 ? 0 : (cs > 48 ? 48 : cs); P.cs = cs;
    P.kvrow = P.h * M_TOK + seq0 + kc0;
    P.orow = seq0 + r * 64 + P.qc;
    P.qp = proj + PB_QN + ((size_t)P.h * M_TOK + P.orow) * 64 + 8 * fq;
    P.bb = tbl + P.h * 465 + (rs0 - r + 7) * 31;
    return P;
}
__device__ __forceinline__ void na2_load(PairRegs& R, int n, const Na2P& P, const bf16_t* proj, unsigned kofs, unsigned vofs) {
    int kr = P.rs0 + n; kr = kr > P.rows - 1 ? P.rows - 1 : kr;
#pragma unroll
    for (int hh = 0; hh < 2; ++hh) {
        const size_t tb = (size_t)(P.kvrow + kr * 64 + 16 * hh) * 128;
        const char* kb = (const char*)(proj + PB_KN) + tb; const char* vb = (const char*)(proj + PB_VN) + tb;
        R.k[hh][0] = *(const bf16x8*)(kb + kofs); R.k[hh][1] = *(const bf16x8*)(kb + kofs + 64);
        R.v[hh][0] = *(const u32x4*)(vb + vofs); R.v[hh][1] = *(const u32x4*)(vb + vofs + 8 * 128);
    }
}
template <int PFD>
__device__ __forceinline__ void na2_stream(const bf16_t* __restrict__ proj, bf16_t* __restrict__ mixed, LAS unsigned char* vst, const LAS float* tbl, int first, int stride, int lane) {
    constexpr int NP = 9, NPV = ((NP + PFD - 1) / PFD) * PFD, NITEMS = (M_TOK / 128) * 16;
    if (first >= NITEMS) return;
    const int fr = lane & 15, fq = lane >> 4, vr = lane >> 3;
    const unsigned kofs = (unsigned)(fr * 128 + fq * 16), vofs = (unsigned)(vr * 128 + (lane & 7) * 16);
    const unsigned wofs = vr * 160 + (lane & 7) * 16, trofs = (4 * fq + ((lane & 15) >> 2)) * 160 + (lane & 3) * 8;
    int it = first;
    Na2P P = na2_params(proj, tbl, it, lane);
    PairRegs ring[PFD];
    bf16x8 q[2][2];
#pragma unroll
    for (int g = 0; g < 2; ++g) { q[g][0] = ld8(P.qp + g * 4096); q[g][1] = ld8(P.qp + g * 4096 + 32); }
#pragma unroll
    for (int s = 0; s < PFD - 1; ++s) na2_load(ring[s], s, P, proj, kofs, vofs);
    for (;;) {
        const int itn = it + stride; const bool has_next = itn < NITEMS;
        const Na2P PN = na2_params(proj, tbl, has_next ? itn : it, lane);
        bf16x8 qn[2][2];
#pragma unroll
        for (int g = 0; g < 2; ++g) { qn[g][0] = ld8(PN.qp + g * 4096); qn[g][1] = ld8(PN.qp + g * 4096 + 32); }
        f32x4 o[2][4]; float l[2];
#pragma unroll
        for (int g = 0; g < 2; ++g) { l[g] = 0.f;
#pragma unroll
            for (int c = 0; c < 4; ++c) o[g][c] = (f32x4){0.f, 0.f, 0.f, 0.f}; }
#pragma unroll
        for (int p = 0; p < NPV; ++p) {
            const int m = p + PFD - 1;
            if (m < NPV) { if (m < NP) na2_load(ring[m % PFD], m, P, proj, kofs, vofs); }
            else { if (m - NPV < NP) na2_load(ring[m % PFD], m - NPV, PN, proj, kofs, vofs); }
            if (p >= NP) continue;
            const PairRegs& R = ring[p % PFD];
            LAS unsigned char* vbuf = vst + (p % 3) * 5120;
#pragma unroll
            for (int ab = 0; ab < 2; ++ab) { *(LAS u32x4*)(vbuf + ab * 2560 + wofs) = R.v[ab][0]; *(LAS u32x4*)(vbuf + ab * 2560 + wofs + 8 * 160) = R.v[ab][1]; }
            asm volatile("s_waitcnt lgkmcnt(0)" ::: "memory");
            bf16x8 vt[4];
#pragma unroll
            for (int c = 0; c < 4; ++c) {
                const s16x4 ta = __builtin_amdgcn_ds_read_tr16_b64_v4i16((LAS s16x4*)(vbuf + trofs + c * 32));
                const s16x4 tb = __builtin_amdgcn_ds_read_tr16_b64_v4i16((LAS s16x4*)(vbuf + 2560 + trofs + c * 32));
                vt[c] = (bf16x8){ta[0], ta[1], ta[2], ta[3], tb[0], tb[1], tb[2], tb[3]};
            }
#pragma unroll
            for (int g = 0; g < 2; ++g) {
                if (g == 0 && p == 8) continue;
                const bool act = (g == 0) ? true : (p == 0 ? P.d1 == 0 : (p == 8 ? P.d1 == 1 : true));
                const LAS float* brow = P.bb + (p - g) * 31;
                f32x4 pr[2];
#pragma unroll
                for (int hh = 0; hh < 2; ++hh) {
                    f32x4 s = {0.f, 0.f, 0.f, 0.f};
                    s = __builtin_amdgcn_mfma_f32_16x16x32_bf16(R.k[hh][0], q[g][0], s, 0, 0, 0);
                    s = __builtin_amdgcn_mfma_f32_16x16x32_bf16(R.k[hh][1], q[g][1], s, 0, 0, 0);
#pragma unroll
                    for (int e = 0; e < 4; ++e) { const int kc = P.kc0 + 16 * hh + 4 * fq + e; const bool valid = act && (kc >= P.cs) && (kc < P.cs + 16);
                        int dc = kc - P.qc + 15; dc = dc < 0 ? 0 : (dc > 30 ? 30 : dc);
                        const float ex = __builtin_amdgcn_exp2f(s[e] + brow[dc]); pr[hh][e] = valid ? ex : 0.f; l[g] += pr[hh][e]; }
                }
                union { u32x4 u; bf16x8 h; } pp; pp.u.x = pk_bf16(pr[0][0], pr[0][1]); pp.u.y = pk_bf16(pr[0][2], pr[0][3]); pp.u.z = pk_bf16(pr[1][0], pr[1][1]); pp.u.w = pk_bf16(pr[1][2], pr[1][3]);
#pragma unroll
                for (int c = 0; c < 4; ++c) o[g][c] = __builtin_amdgcn_mfma_f32_16x16x32_bf16(vt[c], pp.h, o[g][c], 0, 0, 0);
            }
        }
#pragma unroll
        for (int g = 0; g < 2; ++g) attn_store(mixed + (size_t)(P.orow + g * 64) * DM + 384 + P.h * 64, o[g], l[g], fq);
        if (!has_next) break;
        it = itn; P = PN;
#pragma unroll
        for (int g = 0; g < 2; ++g) { q[g][0] = qn[g][0]; q[g][1] = qn[g][1]; }
    }
}

constexpr int DIL_NG = CFG_NG, DIL_PF = CFG_PF;
__device__ __forceinline__ void mix_a(const Params& p, int layer, LAS unsigned char* lds, int tid, int lane, int wave) {
    unsigned char* ws = p.ws; const bf16_t* proj = (const bf16_t*)(ws + WS_PROJ); bf16_t* mixed = (bf16_t*)(ws + WS_MIXED);
    LAS float* tbl = (LAS float*)(lds + 131072);
    for (int i = tid; i < 4 * 465; i += 512) tbl[i] = p.rpb[layer * 4 * 465 + i] * LOG2E;
    __syncthreads();
    LAS unsigned char* vst = lds + wave * 16384;
    const int vcu = (gridDim.x % 8 == 0) ? (int)(blockIdx.x % 8) * (int)(gridDim.x / 8) + (int)(blockIdx.x / 8) : (int)blockIdx.x;
    const int gw = vcu * NWAVES + wave, NGW = gridDim.x * NWAVES;
    na2_stream<2>(proj, mixed, vst, tbl, gw, NGW, lane);
    dilu_stream<16, DIL_NG, 0, DIL_PF>(proj, mixed, (bf16_t*)(ws + WS_Y), (float*)(ws + WS_Y + 128 * MiB), vst, (unsigned*)(ws + WS_QCTR) + ((layer * 3 + 0) * 8 + (int)(blockIdx.x & 7)) * 64, (int)(blockIdx.x & 7), lane);
}
__device__ __forceinline__ void mix_b(const Params& p, int layer, LAS unsigned char* lds, int tid, int lane, int wave) {
    unsigned char* ws = p.ws; const bf16_t* proj = (const bf16_t*)(ws + WS_PROJ); bf16_t* mixed = (bf16_t*)(ws + WS_MIXED);
    LAS unsigned char* vst = lds + wave * 16384;
    const int vcu = (gridDim.x % 8 == 0) ? (int)(blockIdx.x % 8) * (int)(gridDim.x / 8) + (int)(blockIdx.x / 8) : (int)blockIdx.x;
    const int gw = vcu * NWAVES + wave, NGW = gridDim.x * NWAVES;
    const float* cw = p.conv_w + layer * 3 * 384;
    for (int idx = blockIdx.x * 512 + tid; idx < M_TOK * 48; idx += gridDim.x * 512) {
        const int row = idx / 48, c0 = (idx - row * 48) * 8;
        int S, seq0; seq_of_row(row, S, seq0); const int pos = row - seq0;
        const bf16_t* base = proj + PB_CV + (size_t)row * DCV + c0;
        const u32x4 gb = *(const u32x4*)base;
        float acc[8];
#pragma unroll
        for (int k = 0; k < 8; ++k) acc[k] = 0.f;
#pragma unroll
        for (int j = 0; j < 3; ++j) {
            const int pp = pos + j - 1;
            if (pp >= 0 && pp < S) {
                const bf16_t* bj = base + (ptrdiff_t)(j - 1) * DCV;
                const u32x4 gc = *(const u32x4*)(bj + 384), hi = *(const u32x4*)(bj + 768);
                const f32x4 w0 = *(const f32x4*)(cw + j * 384 + c0), w1 = *(const f32x4*)(cw + j * 384 + c0 + 4);
                acc[0] += w0[0] * bf_lo(gc.x) * bf_lo(hi.x); acc[1] += w0[1] * bf_hi(gc.x) * bf_hi(hi.x);
                acc[2] += w0[2] * bf_lo(gc.y) * bf_lo(hi.y); acc[3] += w0[3] * bf_hi(gc.y) * bf_hi(hi.y);
                acc[4] += w1[0] * bf_lo(gc.z) * bf_lo(hi.z); acc[5] += w1[1] * bf_hi(gc.z) * bf_hi(hi.z);
                acc[6] += w1[2] * bf_lo(gc.w) * bf_lo(hi.w); acc[7] += w1[3] * bf_hi(gc.w) * bf_hi(hi.w);
            }
        }
        u32x4 w; w.x = pk_bf16(acc[0] * bf_lo(gb.x), acc[1] * bf_hi(gb.x)); w.y = pk_bf16(acc[2] * bf_lo(gb.y), acc[3] * bf_hi(gb.y));
        w.z = pk_bf16(acc[4] * bf_lo(gb.z), acc[5] * bf_hi(gb.z)); w.w = pk_bf16(acc[6] * bf_lo(gb.w), acc[7] * bf_hi(gb.w));
        *(u32x4*)(mixed + (size_t)row * DM + 640 + c0) = w;
    }
    dilu_stream<4, DIL_NG, 1, DIL_PF>(proj, mixed, (bf16_t*)(ws + WS_Y), (float*)(ws + WS_Y + 128 * MiB), vst, (unsigned*)(ws + WS_QCTR) + ((layer * 3 + 1) * 8 + (int)(blockIdx.x & 7)) * 64, (int)(blockIdx.x & 7), lane);
}
__device__ __forceinline__ void mix_c(const Params& p, int layer, LAS unsigned char* lds, int lane, int wave) {
    unsigned char* ws = p.ws; const bf16_t* proj = (const bf16_t*)(ws + WS_PROJ); bf16_t* mixed = (bf16_t*)(ws + WS_MIXED);
    LAS unsigned char* vst = lds + wave * 16384;
    const int vcu = (gridDim.x % 8 == 0) ? (int)(blockIdx.x % 8) * (int)(gridDim.x / 8) + (int)(blockIdx.x / 8) : (int)blockIdx.x;
    const int gw = vcu * NWAVES + wave, NGW = gridDim.x * NWAVES;
    dilu_stream<1, DIL_NG, 2, DIL_PF>(proj, mixed, (bf16_t*)(ws + WS_Y), (float*)(ws + WS_Y + 128 * MiB), vst, (unsigned*)(ws + WS_QCTR) + ((layer * 3 + 2) * 8 + (int)(blockIdx.x & 7)) * 64, (int)(blockIdx.x & 7), lane);
}

#define XB_TMO      128
#define XB_XCNT(j)  (256  + 64 * (j))
#define XB_XSUB(j)  (1280 + 64 * (j))
#define XB_XGEN(j)  (2304 + 64 * (j))
#define XB_TOP      3328
#define XB_TOPGEN   3392
#define XCD_BAR_WORDS 3456
#define XB_SPIN_CAP (1u << 18)

__device__ __forceinline__ unsigned xb_ld(unsigned* p)              { return __hip_atomic_load(p, __ATOMIC_RELAXED, __HIP_MEMORY_SCOPE_AGENT); }
__device__ __forceinline__ unsigned xb_add(unsigned* p, unsigned v) { return __hip_atomic_fetch_add(p, v, __ATOMIC_RELAXED, __HIP_MEMORY_SCOPE_AGENT); }
__device__ __forceinline__ unsigned xb_xcc_id() { return (unsigned)__builtin_amdgcn_s_getreg((3 << 11) | 20) & 0xFu; }
#define XB_SPIN(cond, bar) do { unsigned _sp = 0; while (cond) { __builtin_amdgcn_s_sleep(1); \
    if ((++_sp & 255u) == 0u) { if (xb_ld(&(bar)[XB_TMO])) break; if (_sp > XB_SPIN_CAP) { atomicAdd(&(bar)[XB_TMO], 1u); break; } } } } while (0)

struct XcdBarrier {
    unsigned* bar; unsigned x;
    volatile LAS unsigned* st;
};

__device__ __forceinline__ XcdBarrier xcd_barrier_post(unsigned* bar, volatile LAS unsigned* st) {
    XcdBarrier b; b.bar = bar; b.x = xb_xcc_id(); b.st = st;
    if (threadIdx.x == 0) (void)xb_add(&bar[XB_XCNT(b.x)], 1u);
    return b;
}
__device__ __forceinline__ void xcd_barrier_complete(unsigned* bar, unsigned x, unsigned& nloc, unsigned& nx) {
    const unsigned G = gridDim.x * gridDim.y * gridDim.z;
    unsigned sum, cnt, mine, sp = 0u;
    for (;;) {
        sum = 0u; cnt = 0u; mine = 0u;
#pragma unroll
        for (unsigned j = 0; j < 16; ++j) { const unsigned c = xb_ld(&bar[XB_XCNT(j)]); sum += c; cnt += (c > 0u) ? 1u : 0u; mine = (j == x) ? c : mine; }
        if (sum == G) break;
        __builtin_amdgcn_s_sleep(1);
        if ((++sp & 255u) == 0u) { if (xb_ld(&bar[XB_TMO])) break; if (sp > XB_SPIN_CAP) { atomicAdd(&bar[XB_TMO], 1u); break; } }
    }
    nloc = mine > 0u ? mine : 1u; nx = cnt > 0u ? cnt : 1u;
}

__device__ __forceinline__ void xcd_barrier(const XcdBarrier& b) {
    asm volatile("s_waitcnt vmcnt(0)" ::: "memory");
    __syncthreads();
    if (threadIdx.x == 0) {
        unsigned* bar = b.bar;
        __builtin_amdgcn_s_waitcnt(0);
        unsigned nloc = b.st[0], nx = b.st[1];
        if (nloc == 0u) { xcd_barrier_complete(bar, b.x, nloc, nx); b.st[0] = nloc; b.st[1] = nx; }
        const unsigned old = xb_add(&bar[XB_XSUB(b.x)], 1u);
        const unsigned gen = old / nloc;
        if (old + 1u == (gen + 1u) * nloc) {
            __builtin_amdgcn_fence(__ATOMIC_RELEASE, "agent");
            asm volatile("s_waitcnt vmcnt(0)" ::: "memory");
            const unsigned og = xb_add(&bar[XB_TOP], 1u);
            const unsigned tg = og / nx;
            if (og + 1u == (tg + 1u) * nx) xb_add(&bar[XB_TOPGEN], 1u);
            else XB_SPIN(xb_ld(&bar[XB_TOPGEN]) == tg, bar);
            __builtin_amdgcn_fence(__ATOMIC_ACQUIRE, "agent");
            xb_add(&bar[XB_XGEN(b.x)], 1u);
            asm volatile("s_waitcnt vmcnt(0)" ::: "memory");
        } else {
            XB_SPIN(xb_ld(&bar[XB_XGEN(b.x)]) == gen, bar);
            __builtin_amdgcn_fence(__ATOMIC_ACQUIRE, "agent");
            asm volatile("s_waitcnt vmcnt(0)" ::: "memory");
        }
    }
    __syncthreads();
}

__global__ void __launch_bounds__(512) fwd_mega(Params p) {
    extern __shared__ __attribute__((aligned(16))) unsigned char lds_raw[];
    LAS unsigned char* lds = (LAS unsigned char*)lds_raw;
    cg::grid_group grid = cg::this_grid();
    unsigned char* ws = p.ws;
#define FRESH_TID() int tid = threadIdx.x; asm volatile("" : "+v"(tid)); const int lane = tid & 63, wave = __builtin_amdgcn_readfirstlane(tid >> 6)
    bf16_t* xb = (bf16_t*)(ws + WS_XB); bf16_t* proj = (bf16_t*)(ws + WS_PROJ); bf16_t* mixed = (bf16_t*)(ws + WS_MIXED); bf16_t* Y = (bf16_t*)(ws + WS_Y); bf16_t* H = (bf16_t*)(ws + WS_H);
    const unsigned short* rs = (const unsigned short*)(ws + WS_RS);

    if (threadIdx.x < 4) ((volatile LAS unsigned*)(lds + 139264))[threadIdx.x] = 0u;
    __syncthreads();
    const XcdBarrier xbar = xcd_barrier_post((unsigned*)(ws + WS_CTL), (volatile LAS unsigned*)(lds + 139264));
    { FRESH_TID(); prologue(p, lds, tid, lane, wave); }
    grid.sync();
    for (int layer = 0; layer < 2; ++layer) {
        {
            pg8::Gemm g{xb, (const bf16_t*)(ws + WS_WIN) + (size_t)layer * DIN * DM, M_TOK, DIN, DM}; pg8::StaticOrder S; S.init(M_TOK, DIN, (int)gridDim.x, (int)blockIdx.x);
            EpiProj E{proj, rs, (const unsigned*)(ws + WS_COS)};
            pg8::gemm_phase<EpiProj, pg8::StaticOrder>(lds, g, S, E);
        }
        xcd_barrier(xbar);
        { FRESH_TID(); mix_a(p, layer, lds, tid, lane, wave); }
        xcd_barrier(xbar);
        { FRESH_TID(); mix_b(p, layer, lds, tid, lane, wave); }
        xcd_barrier(xbar);
        { FRESH_TID(); (void)tid; mix_c(p, layer, lds, lane, wave); }
        xcd_barrier(xbar);
        {
            pg8::Gemm g{mixed, (const bf16_t*)(ws + WS_WOUT) + (size_t)layer * DM * DM, M_TOK, DM, DM}; pg8::StaticOrder S; S.init(M_TOK, DM, (int)gridDim.x, (int)blockIdx.x);
            EpiPlain E{Y, DM};
            pg8::gemm_phase<EpiPlain, pg8::StaticOrder>(lds, g, S, E);
        }
        xcd_barrier(xbar);
        { FRESH_TID(); (void)tid; ew_phase<false>(p, p.g_post_mix + layer * DM, lane, wave); }
        xcd_barrier(xbar);
        {
            pg8::Gemm g{xb, (const bf16_t*)(ws + WS_WGU) + (size_t)layer * 2 * DFF * DM, M_TOK, 2 * DFF, DM}; pg8::StaticOrder S; S.init(M_TOK, 2 * DFF, (int)gridDim.x, (int)blockIdx.x);
            EpiSwiglu E{H, rs};
            pg8::gemm_phase<EpiSwiglu, pg8::StaticOrder>(lds, g, S, E);
        }
        xcd_barrier(xbar);
        {
            pg8::Gemm g{H, (const bf16_t*)(ws + WS_WDN) + (size_t)layer * DM * DFF, M_TOK, DM, DFF}; pg8::StaticOrder S; S.init(M_TOK, DM, (int)gridDim.x, (int)blockIdx.x);
            EpiPlain E{Y, DM};
            pg8::gemm_phase<EpiPlain, pg8::StaticOrder>(lds, g, S, E);
        }
        xcd_barrier(xbar);
        if (layer == 0) { { FRESH_TID(); (void)tid; ew_phase<false>(p, p.g_post_ffn + layer * DM, lane, wave); } xcd_barrier(xbar); }
        else { FRESH_TID(); (void)tid; ew_phase<true>(p, p.g_post_ffn + layer * DM, lane, wave); }
    }
}

extern "C" void kernel_launch(void* const* d_in, const int* in_sizes, int n_in, void* d_out, int out_size, void* d_ws, size_t ws_size, hipStream_t stream) {
    static int grid_blocks = 0;
    if (!grid_blocks) {
        if (n_in != 13 || out_size != M_TOK * DM || ws_size < WS_END) { fprintf(stderr, "kernel_launch: unexpected sizes (n_in %d out %d ws %zu)\n", n_in, out_size, ws_size); grid_blocks = -1; return; }
        int dev = 0, cus = 0, per_cu = 0;
        hipGetDevice(&dev); hipDeviceGetAttribute(&cus, hipDeviceAttributeMultiprocessorCount, dev);
        hipFuncSetAttribute((const void*)fwd_mega, hipFuncAttributeMaxDynamicSharedMemorySize, LDS_BYTES);
        hipOccupancyMaxActiveBlocksPerMultiprocessor(&per_cu, (const void*)fwd_mega, 512, LDS_BYTES);
        if (per_cu < 1) { fprintf(stderr, "kernel_launch: occupancy query says %d blocks per CU\n", per_cu); per_cu = 1; }
        (void)hipGetLastError();
        grid_blocks = cus * per_cu;
    }
    if (grid_blocks < 0) return;
    Params p{};
    p.x_p = (const float*)d_in[0]; p.x_s = (const float*)d_in[1]; p.g_pre_mix = (const float*)d_in[2]; p.w_in = (const float*)d_in[3]; p.conv_w = (const float*)d_in[4];
    p.rpb = (const float*)d_in[5]; p.w_out = (const float*)d_in[6]; p.g_post_mix = (const float*)d_in[7]; p.g_pre_ffn = (const float*)d_in[8]; p.w_gate = (const float*)d_in[9];
    p.w_up = (const float*)d_in[10]; p.w_down = (const float*)d_in[11]; p.g_post_ffn = (const float*)d_in[12]; p.out = (float*)d_out; p.ws = (unsigned char*)d_ws;
    if (hipMemsetAsync((char*)d_ws + WS_CTL, 0, CTL_BYTES, stream) != hipSuccess) { fprintf(stderr, "kernel_launch: memset of the barrier words failed\n"); return; }
    void* args[] = {&p};
    hipError_t e = hipLaunchCooperativeKernel((const void*)fwd_mega, dim3(grid_blocks), dim3(512), args, LDS_BYTES, stream);
    if (e != hipSuccess) fprintf(stderr, "cooperative launch failed: %s (grid %d)\n", hipGetErrorString(e), grid_blocks);
}
```

```cpp
#include <hip/hip_runtime.h>
#include <hip/hip_cooperative_groups.h>
#include <cstdio>
namespace cg = cooperative_groups;
namespace pg8 {
#define PG8_LAS __attribute__((address_space(3)))
typedef unsigned short bf16_t;
typedef short bf16x8 __attribute__((ext_vector_type(8)));
typedef float f32x4 __attribute__((ext_vector_type(4)));
typedef unsigned u32x4 __attribute__((ext_vector_type(4)));
constexpr int BM = 256, BK = 64, HALF = 128, HTB = HALF * BK * 2  , STAGE_BYTES = 8 * HTB, NXCD = 8, WGM = 8;

__host__ __device__ __forceinline__ int lds_byte(int r, int c) { const int st = (r >> 4) * 2 + (c >> 5), rr = r & 15, cc = c & 31, ob = rr * 64 + cc * 2; return st * 1024 + (ob ^ (((ob >> 9) & 1) << 5)); }
__host__ __device__ __forceinline__ void stage_rc(int b, int& R, int& C) { const int st = b / 1024, sb = b % 1024, swz = sb ^ (((sb >> 9) & 1) << 5); R = (st >> 1) * 16 + swz / 64; C = (st & 1) * 32 + (swz % 64) / 2; }
__host__ __device__ __forceinline__ int perm32(int rho) { const int n = rho >> 4, i = rho & 15; return 8 * (i >> 2) + 4 * n + (i & 3); }

struct Unit { int pm, pn; };
struct Gemm { const bf16_t* A; const bf16_t* Bt; int M, N, K; };

struct StaticOrder {
    int nM, nN, nwg, G, c;
    __host__ __device__ void init(int M, int N, int G_, int c_) { nM = M / BM; nN = N / BM; nwg = nM * nN; G = G_; c = c_; }
    __host__ __device__ bool next(int i, Unit& u) const {
        const long L = (long)i * G + c; if (L >= nwg) return false;
        int wgid = (int)L; { const int q = nwg / NXCD, r = nwg % NXCD, xcd = wgid % NXCD, off = wgid / NXCD; wgid = (xcd < r ? xcd * (q + 1) : r * (q + 1) + (xcd - r) * q) + off; }
        const int nig = WGM * nN, gid = wgid / nig, fm = gid * WGM, gsz = (nM - fm) < WGM ? (nM - fm) : WGM;
        u.pm = fm + ((wgid % nig) % gsz); u.pn = (wgid % nig) / gsz; return true;
    }
    __device__ __forceinline__ void a_ready(const Unit&) const {}
    __device__ __forceinline__ void done(const Unit&) const {}
};
typedef float f32x2 __attribute__((ext_vector_type(2)));
template <class Epi, class Sched, bool ALIGN_EPI = true, bool SP2 = true>
__device__ __forceinline__ void gemm_phase(PG8_LAS unsigned char* lds, const Gemm g, const Sched& S, const Epi& E) {
    int tid_ = threadIdx.x; asm volatile("" : "+v"(tid_));
    const int tid = tid_, wid = __builtin_amdgcn_readfirstlane(tid >> 6), lane = tid & 63, wr = wid >> 2, wc = wid & 3, fr = lane & 15, fq = lane >> 4;
    const int K = g.K, nt = K / BK;
    unsigned voffA[2], voffB[2];
#pragma unroll
    for (int i = 0; i < 2; ++i) { int R, C; stage_rc(tid * 16 + i * 8192, R, C); const int Rb = Epi::PERM ? ((R & ~31) + perm32(R & 31)) : R;
        voffA[i] = (unsigned)(R * K + C) * 2u; voffB[i] = (unsigned)(Rb * K + C) * 2u; }
    const size_t kstep = (size_t)(BK * 2);
    const size_t hstep = (size_t)HALF * K * 2;
    const size_t tstep = 2 * hstep;
    const unsigned ldsw = (unsigned)wid * 1024u;
    const int aoff = lds_byte(wr * 64 + fr, fq * 8), boff = lds_byte(wc * 32 + fr, fq * 8);
#define PG8_SA(b, h) (((b) * 2 + (h)) * HTB)
#define PG8_SB(b, h) ((4 + (b) * 2 + (h)) * HTB)
#define PG8_STAGE(bufoff, gbase, voff) do { _Pragma("unroll") for (int _i = 0; _i < 2; ++_i) \
        __builtin_amdgcn_global_load_lds((const unsigned*)((const char*)(gbase) + (voff)[_i]), (PG8_LAS unsigned*)(lds + (bufoff) + ldsw + _i * 8192), 16, 0, 0); } while (0)
#define PG8_LDA(dst, b, h) do { _Pragma("unroll") for (int m = 0; m < 4; ++m) _Pragma("unroll") for (int k = 0; k < 2; ++k) dst[m][k] = *(const PG8_LAS bf16x8*)(lds + PG8_SA(b, h) + aoff + m * 2048 + k * 1024); } while (0)
#define PG8_LDB(dst, b, h) do { _Pragma("unroll") for (int n = 0; n < 2; ++n) _Pragma("unroll") for (int k = 0; k < 2; ++k) dst[n][k] = *(const PG8_LAS bf16x8*)(lds + PG8_SB(b, h) + boff + n * 2048 + k * 1024); } while (0)
#define PG8_MMA(ai, bj, At, Bt) do { __builtin_amdgcn_s_setprio(1); _Pragma("unroll") for (int m = 0; m < 4; ++m) _Pragma("unroll") for (int n = 0; n < 2; ++n) _Pragma("unroll") for (int k = 0; k < 2; ++k) \
        acc[ai][bj][m][n] = __builtin_amdgcn_mfma_f32_16x16x32_bf16(Bt[n][k], At[m][k], acc[ai][bj][m][n], 0, 0, 0); __builtin_amdgcn_s_setprio(0); } while (0)
#define PG8_WAIT_V(n) asm volatile("s_waitcnt vmcnt(" #n ")" ::: "memory")
#define PG8_WAIT_L(n) asm volatile("s_waitcnt lgkmcnt(" #n ")" ::: "memory")
#define PG8_BAR __builtin_amdgcn_s_barrier()
#define PG8_SCHED __builtin_amdgcn_sched_barrier(0)
    Unit cur, nxt; int ui = 0; unsigned epre[4];
#pragma unroll
    for (int i = 0; i < 4; ++i) epre[i] = 0u;
    if (!S.next(0, cur)) return;
    f32x4 acc[2][2][4][2];
#pragma unroll
    for (int a = 0; a < 2; ++a)
#pragma unroll
        for (int b = 0; b < 2; ++b)
#pragma unroll
            for (int m = 0; m < 4; ++m)
#pragma unroll
                for (int n = 0; n < 2; ++n) acc[a][b][m][n] = (f32x4){0.f, 0.f, 0.f, 0.f};
    bf16x8 At[4][2], B0[2][2], B1[2][2];
    const char* cA = (const char*)g.A + (size_t)cur.pm * tstep; const char* cB = (const char*)g.Bt + (size_t)cur.pn * tstep;
    S.a_ready(cur);
    if constexpr (SP2) {
        PG8_STAGE(PG8_SB(0, 0), cB, voffB); PG8_STAGE(PG8_SB(0, 1), cB + hstep, voffB); PG8_STAGE(PG8_SA(0, 0), cA, voffA); PG8_STAGE(PG8_SA(0, 1), cA + hstep, voffA);
        if (wr == 1) PG8_BAR;
        PG8_WAIT_V(2); PG8_BAR;
        PG8_STAGE(PG8_SB(1, 0), cB + kstep, voffB); PG8_STAGE(PG8_SA(1, 0), cA + kstep, voffA); PG8_STAGE(PG8_SB(1, 1), cB + hstep + kstep, voffB);
        PG8_WAIT_V(6); PG8_BAR;
    } else {
        PG8_STAGE(PG8_SB(0, 0), cB, voffB); PG8_STAGE(PG8_SA(0, 0), cA, voffA); PG8_STAGE(PG8_SB(0, 1), cB + hstep, voffB); PG8_STAGE(PG8_SA(0, 1), cA + hstep, voffA);
        if (wr == 1) PG8_BAR;
        PG8_WAIT_V(4); PG8_BAR;
        PG8_STAGE(PG8_SB(1, 0), cB + kstep, voffB); PG8_STAGE(PG8_SA(1, 0), cA + kstep, voffA); PG8_STAGE(PG8_SB(1, 1), cB + hstep + kstep, voffB);
        PG8_WAIT_V(6); PG8_BAR;
    }
    for (;;) {
        const bool has_next = S.next(ui + 1, nxt);
        const char* nA = has_next ? (const char*)g.A + (size_t)nxt.pm * tstep : cA; const char* nB = has_next ? (const char*)g.Bt + (size_t)nxt.pn * tstep : cB;
        for (int t = 0; t < nt; t += 2) {
            const bool last = (t == nt - 2);
            const char* a1 = cA + (size_t)(t + 1) * kstep;
            const char* a2 = last ? nA : cA + (size_t)(t + 2) * kstep; const char* b2 = last ? nB : cB + (size_t)(t + 2) * kstep;
            const char* a3 = a2 + kstep; const char* b3 = b2 + kstep;
            if (last && has_next) S.a_ready(nxt);
            if (last) E.prefetch(epre, cur, wr, fr);
            if constexpr (SP2) {
            PG8_LDB(B0, 0, 0); PG8_LDB(B1, 0, 1); PG8_SCHED; PG8_LDA(At, 0, 0); PG8_STAGE(PG8_SA(1, 1), a1 + hstep, voffA);
            PG8_WAIT_V(8); PG8_WAIT_L(0); PG8_BAR; PG8_MMA(0, 0, At, B0); PG8_MMA(0, 1, At, B1); PG8_BAR; PG8_SCHED;
            PG8_LDA(At, 0, 1); PG8_STAGE(PG8_SB(0, 0), b2, voffB); PG8_STAGE(PG8_SB(0, 1), b2 + hstep, voffB); PG8_STAGE(PG8_SA(0, 0), a2, voffA);
            PG8_WAIT_V(8); PG8_WAIT_L(0); PG8_BAR; PG8_MMA(1, 0, At, B0); PG8_MMA(1, 1, At, B1); PG8_BAR; PG8_SCHED;
            PG8_LDB(B0, 1, 0); PG8_LDB(B1, 1, 1); PG8_SCHED; PG8_LDA(At, 1, 0); PG8_STAGE(PG8_SA(0, 1), a2 + hstep, voffA);
            PG8_WAIT_V(8); PG8_WAIT_L(0); PG8_BAR; PG8_MMA(0, 0, At, B0); PG8_MMA(0, 1, At, B1); PG8_BAR; PG8_SCHED;
            PG8_LDA(At, 1, 1); PG8_STAGE(PG8_SB(1, 0), b3, voffB); PG8_STAGE(PG8_SB(1, 1), b3 + hstep, voffB); PG8_STAGE(PG8_SA(1, 0), a3, voffA);
            PG8_WAIT_V(8); PG8_WAIT_L(0); PG8_BAR; PG8_MMA(1, 0, At, B0); PG8_MMA(1, 1, At, B1); PG8_BAR; PG8_SCHED;
            } else {
            PG8_LDB(B0, 0, 0); PG8_SCHED; PG8_LDA(At, 0, 0); PG8_STAGE(PG8_SA(1, 1), a1 + hstep, voffA);
            PG8_WAIT_L(8); PG8_BAR; PG8_WAIT_L(0); PG8_MMA(0, 0, At, B0); PG8_BAR; PG8_SCHED;
            PG8_LDB(B1, 0, 1); PG8_STAGE(PG8_SB(0, 0), b2, voffB);
            PG8_BAR; PG8_WAIT_L(0); PG8_MMA(0, 1, At, B1); PG8_BAR;
            PG8_LDA(At, 0, 1); PG8_STAGE(PG8_SA(0, 0), a2, voffA);
            PG8_BAR; PG8_WAIT_L(0); PG8_MMA(1, 0, At, B0); PG8_BAR; PG8_SCHED;
            PG8_STAGE(PG8_SB(0, 1), b2 + hstep, voffB);
            PG8_WAIT_V(6); PG8_BAR; PG8_MMA(1, 1, At, B1); PG8_BAR;
            PG8_LDB(B0, 1, 0); PG8_SCHED; PG8_LDA(At, 1, 0); PG8_STAGE(PG8_SA(0, 1), a2 + hstep, voffA);
            PG8_WAIT_L(8); PG8_BAR; PG8_WAIT_L(0); PG8_MMA(0, 0, At, B0); PG8_BAR; PG8_SCHED;
            PG8_LDB(B1, 1, 1); PG8_STAGE(PG8_SB(1, 0), b3, voffB);
            PG8_BAR; PG8_WAIT_L(0); PG8_MMA(0, 1, At, B1); PG8_BAR;
            PG8_LDA(At, 1, 1); PG8_STAGE(PG8_SA(1, 0), a3, voffA);
            PG8_BAR; PG8_WAIT_L(0); PG8_MMA(1, 0, At, B0); PG8_BAR; PG8_SCHED;
            PG8_STAGE(PG8_SB(1, 1), b3 + hstep, voffB);
            PG8_WAIT_V(6); PG8_BAR; PG8_MMA(1, 1, At, B1); PG8_BAR;
            }
        }
        if constexpr (ALIGN_EPI) { if (wr == 0) PG8_BAR; }
        if constexpr (!Epi::AFTER_DRAIN) { E(acc, cur, wr, wc, fr, fq, epre); S.done(cur); }
        if (!has_next) break;
#pragma unroll
        for (int a = 0; a < 2; ++a)
#pragma unroll
            for (int b = 0; b < 2; ++b)
#pragma unroll
                for (int m = 0; m < 4; ++m)
#pragma unroll
                    for (int n = 0; n < 2; ++n) acc[a][b][m][n] = (f32x4){0.f, 0.f, 0.f, 0.f};
        cur = nxt; cA = nA; cB = nB; ++ui;
        if constexpr (ALIGN_EPI) { if (wr == 1) PG8_BAR; }
    }
    PG8_WAIT_V(0);
    if constexpr (!ALIGN_EPI) { if (wr == 0) PG8_BAR; }
    PG8_BAR;
    if constexpr (Epi::AFTER_DRAIN) { E.fused(acc, cur, wr, wc, fr, fq, lds, wid, lane); S.done(cur); }
#undef PG8_SA
#undef PG8_SB
#undef PG8_STAGE
#undef PG8_LDA
#undef PG8_LDB
#undef PG8_MMA
#undef PG8_WAIT_V
#undef PG8_WAIT_L
#undef PG8_BAR
#undef PG8_SCHED
}
}

using pg8::bf16_t; using pg8::bf16x8; using pg8::f32x4; using pg8::u32x4;
#define LAS __attribute__((address_space(3)))
typedef short s16x4 __attribute__((ext_vector_type(4)));
typedef unsigned u32x2 __attribute__((ext_vector_type(2)));
constexpr int M_TOK = 81920, NP_ROWS = 16384, DM = 1024, DIN = 3072, DFF = 2816;
constexpr float RMS_EPS = 1e-6f, LOG2E = 1.4426950408889634f, QSCALE = 0.125f * 1.4426950408889634f;
constexpr size_t MiB = 1u << 20;
constexpr size_t WS_WIN = 0, WS_WOUT = 12 * MiB, WS_WGU = 16 * MiB, WS_WDN = 38 * MiB, WS_COS = 49 * MiB, WS_SIN = 50 * MiB, WS_RS = 51 * MiB,
                 WS_XB = 52 * MiB, WS_MIXED = 212 * MiB, WS_Y = 372 * MiB, WS_PROJ = 532 * MiB, WS_H = 532 * MiB, WS_CTL = 1012 * MiB, CTL_BYTES = 163840, WS_QCTR = WS_CTL + 16384, WS_CNT1 = WS_CTL + 65536, WS_X1 = 1013 * MiB, WS_END = 1015 * MiB;
constexpr size_t M64 = (size_t)M_TOK * 64;
constexpr size_t PB_QD = 0, PB_KD = 6 * M64, PB_VD = 12 * M64, PB_QN = 18 * M64, PB_KN = 22 * M64, PB_VN = 26 * M64, PB_CV = 30 * M64;
constexpr int DCV = 1152;
constexpr int LDS_BYTES = 147456;
constexpr int NWAVES = 8;

struct Params {
    const float *x_p, *x_s, *g_pre_mix, *w_in, *conv_w, *rpb, *w_out, *g_post_mix, *g_pre_ffn, *w_gate, *w_up, *w_down, *g_post_ffn;
    float* out; unsigned char* ws;
};

typedef float f32x2_t __attribute__((ext_vector_type(2)));
typedef __bf16 bf16x2_t __attribute__((ext_vector_type(2)));
__device__ __forceinline__ unsigned pk_bf16(float lo, float hi) { const f32x2_t v = {lo, hi}; const bf16x2_t b = __builtin_convertvector(v, bf16x2_t); return __builtin_bit_cast(unsigned, b); }
__device__ __forceinline__ float bf_lo(unsigned w) { return __uint_as_float(w << 16); }
__device__ __forceinline__ float bf_hi(unsigned w) { return __uint_as_float(w & 0xffff0000u); }
__device__ __forceinline__ float wave_sum(float v) {
#pragma unroll
    for (int o = 1; o < 64; o <<= 1) v += __shfl_xor(v, o);
    return v;
}
__device__ __forceinline__ void seq_of_row(int row, int& S, int& seq0) {
    if (row < NP_ROWS) { S = 2048; seq0 = row & ~2047; } else { S = 8192; seq0 = NP_ROWS + ((row - NP_ROWS) & ~8191); }
}

__device__ __forceinline__ int rs_idx(int row) { return (row & ~31) | ((row & 15) << 1) | ((row >> 4) & 1); }
__device__ __forceinline__ void rs_store(unsigned short* rsb, int row, float v) { rsb[rs_idx(row)] = (unsigned short)(pk_bf16(v, v) & 0xffffu); }
__device__ __forceinline__ void rs_prefetch(unsigned (&pre)[4], const unsigned short* rsb, int pm, int wr, int fr) {
    const unsigned* r32 = (const unsigned*)rsb;
#pragma unroll
    for (int i = 0; i < 4; ++i) pre[i] = r32[((pm * 256 + wr * 64 + (i >> 1) * 128 + (i & 1) * 32) >> 1) + fr];
}
__device__ __forceinline__ float rs_get(const unsigned (&pre)[4], int ai, int m) { const unsigned w = pre[ai * 2 + (m >> 1)]; return (m & 1) ? bf_hi(w) : bf_lo(w); }
struct EpiProj {
    static constexpr bool PERM = true, AFTER_DRAIN = false;
    bf16_t* O; const unsigned short* rs; const unsigned* cs;
    __device__ __forceinline__ void prefetch(unsigned (&pre)[4], const pg8::Unit& u, int wr, int fr) const { rs_prefetch(pre, rs, u.pm, wr, fr); }
    __device__ __forceinline__ void operator()(const f32x4 (&acc)[2][2][4][2], const pg8::Unit& u, int wr, int wc, int fr, int fq, const unsigned (&pre)[4]) const {
        const int row0 = u.pm * 256 + wr * 64 + fr;
        const int p4 = ((4 * wc + fq) & 7) * 4;
        const unsigned* __restrict__ cs = this->cs; bf16_t* __restrict__ O = this->O;
#pragma unroll
        for (int ai = 0; ai < 2; ++ai)
#pragma unroll
            for (int m = 0; m < 4; ++m) {
                if (m == 0 && ai == 1) asm volatile("" ::: "memory");
                const int row = row0 + ai * 128 + m * 16; const float r = rs_get(pre, ai, m);
                const int pos = row < NP_ROWS ? (row & 2047) : ((row - NP_ROWS) & 8191);
#pragma unroll
                for (int bj = 0; bj < 2; ++bj) {
                    const int cb = 2 * u.pn + bj;
                    bf16_t* dst;
                    if (cb < 15) { const int hl = wc >> 1; size_t tb; int head;
                        if (cb < 3) { tb = PB_QD; head = 2 * cb + hl; } else if (cb < 6) { tb = PB_KD; head = 2 * (cb - 3) + hl; } else if (cb < 9) { tb = PB_VD; head = 2 * (cb - 6) + hl; }
                        else if (cb < 11) { tb = PB_QN; head = 2 * (cb - 9) + hl; } else if (cb < 13) { tb = PB_KN; head = 2 * (cb - 11) + hl; } else { tb = PB_VN; head = 2 * (cb - 13) + hl; }
                        dst = O + tb + ((size_t)head * M_TOK + row) * 64 + 32 * (wc & 1) + 8 * fq;
                    } else dst = O + PB_CV + (size_t)row * DCV + 128 * (cb - 15) + 32 * wc + 8 * fq;
                    f32x4 v0 = acc[ai][bj][m][0] * r, v1 = acc[ai][bj][m][1] * r;
                    if (cb < 6) {
                        const u32x4 t4 = *(const u32x4*)(cs + pos * 32 + p4);
                        const f32x4 c4 = (f32x4){bf_lo(t4.x), bf_lo(t4.y), bf_lo(t4.z), bf_lo(t4.w)}, s4 = (f32x4){bf_hi(t4.x), bf_hi(t4.y), bf_hi(t4.z), bf_hi(t4.w)};
                        const f32x4 n0 = v0 * c4 - v1 * s4, n1 = v0 * s4 + v1 * c4; v0 = n0; v1 = n1;
                    }
                    if (cb < 3 || cb == 9 || cb == 10) { v0 = v0 * QSCALE; v1 = v1 * QSCALE; }
                    u32x4 w; w.x = pk_bf16(v0[0], v0[1]); w.y = pk_bf16(v0[2], v0[3]); w.z = pk_bf16(v1[0], v1[1]); w.w = pk_bf16(v1[2], v1[3]);
                    *(u32x4*)dst = w;
                }
            }
    }
};
struct EpiPlain {
    static constexpr bool PERM = true, AFTER_DRAIN = false;
    bf16_t* O; int ldc;
    __device__ __forceinline__ void prefetch(unsigned (&)[4], const pg8::Unit&, int, int) const {}
    __device__ __forceinline__ void operator()(const f32x4 (&acc)[2][2][4][2], const pg8::Unit& u, int wr, int wc, int fr, int fq, const unsigned (&)[4]) const {
        const int row0 = u.pm * 256 + wr * 64 + fr, col0 = u.pn * 256 + wc * 32 + 8 * fq;
#pragma unroll
        for (int ai = 0; ai < 2; ++ai)
#pragma unroll
            for (int m = 0; m < 4; ++m) {
                bf16_t* rowp = O + (size_t)(row0 + ai * 128 + m * 16) * ldc + col0;
#pragma unroll
                for (int bj = 0; bj < 2; ++bj) {
                    const f32x4 v0 = acc[ai][bj][m][0], v1 = acc[ai][bj][m][1];
                    u32x4 w; w.x = pk_bf16(v0[0], v0[1]); w.y = pk_bf16(v0[2], v0[3]); w.z = pk_bf16(v1[0], v1[1]); w.w = pk_bf16(v1[2], v1[3]);
                    *(u32x4*)(rowp + bj * 128) = w;
                }
            }
    }
};
__device__ __forceinline__ void row_exchange(float (&part)[8], float* xslots, unsigned* cnt, unsigned want, LAS unsigned char* lds, int pm, int pn, int wr, int wc, int fr, int fq) {
    LAS float* P = (LAS float*)(lds + 131072); LAS float* S = (LAS float*)(lds + 131072 + 4096);
    const int wid = wr * 4 + wc, lane = fq * 16 + fr;
#pragma unroll
    for (int i = 0; i < 8; ++i) { float s = part[i]; s += __shfl_xor(s, 16); s += __shfl_xor(s, 32); if (fq == 0) P[((i >> 2) * 128 + wr * 64 + (i & 3) * 16 + fr) * 4 + wc] = s; }
    asm volatile("s_waitcnt lgkmcnt(0)" ::: "memory"); __builtin_amdgcn_s_barrier(); asm volatile("" ::: "memory");
    const int row = wid * 32 + (lane & 31);
    if (lane < 32) { const float t = (P[row * 4 + 0] + P[row * 4 + 1]) + (P[row * 4 + 2] + P[row * 4 + 3]);
        __hip_atomic_store((unsigned*)xslots + (size_t)(pm * 256 + row) * 4 + pn, __float_as_uint(t), __ATOMIC_RELAXED, __HIP_MEMORY_SCOPE_AGENT); }
    asm volatile("s_waitcnt vmcnt(0)" ::: "memory");
    if (lane == 0) __hip_atomic_fetch_add(cnt + 64 * pm, 1u, __ATOMIC_RELAXED, __HIP_MEMORY_SCOPE_AGENT);
    if (wid == 0) {
        unsigned sp = 0;
        while ((unsigned)__builtin_amdgcn_readfirstlane(__hip_atomic_load(cnt + 64 * pm, __ATOMIC_RELAXED, __HIP_MEMORY_SCOPE_AGENT)) < want) { __builtin_amdgcn_s_sleep(1); if (++sp > (1u << 20)) break; }
        __builtin_amdgcn_fence(__ATOMIC_ACQUIRE, "agent");
    }
    asm volatile("s_waitcnt vmcnt(0) lgkmcnt(0)" ::: "memory"); __builtin_amdgcn_s_barrier(); asm volatile("" ::: "memory");
    if (lane < 32) { const unsigned* sl = (const unsigned*)xslots + (size_t)(pm * 256 + row) * 4; float tot = 0.f;
#pragma unroll
        for (int t = 0; t < 4; ++t) tot += __uint_as_float(__hip_atomic_load(sl + t, __ATOMIC_RELAXED, __HIP_MEMORY_SCOPE_AGENT));
        S[row] = 1.0f / sqrtf(tot * (1.0f / DM) + RMS_EPS); }
    asm volatile("s_waitcnt lgkmcnt(0)" ::: "memory"); __builtin_amdgcn_s_barrier(); asm volatile("" ::: "memory");
#pragma unroll
    for (int i = 0; i < 8; ++i) part[i] = S[(i >> 2) * 128 + wr * 64 + (i & 3) * 16 + fr];
}
struct EpiNormOut {
    static constexpr bool PERM = true, AFTER_DRAIN = false;
    unsigned char* ws; float* out; const float* g; LAS unsigned char* lds;
    __device__ __forceinline__ void prefetch(unsigned (&)[4], const pg8::Unit&, int, int) const {}
    __device__ __forceinline__ void operator()(f32x4 (&acc)[2][2][4][2], const pg8::Unit& u, int wr, int wc, int fr, int fq, const unsigned (&)[4]) const {
        const int row0 = u.pm * 256 + wr * 64 + fr, col0 = u.pn * 256 + wc * 32 + 8 * fq;
        const bf16_t* xb = (const bf16_t*)(ws + WS_XB);
        float part[8];
#pragma unroll
        for (int i = 0; i < 8; ++i) { float s = 0.f;
#pragma unroll
            for (int bj = 0; bj < 2; ++bj)
#pragma unroll
                for (int n = 0; n < 2; ++n) { const f32x4 v = acc[i >> 2][bj][i & 3][n]; s += (v[0] * v[0] + v[1] * v[1]) + (v[2] * v[2] + v[3] * v[3]); }
            part[i] = s; }
        row_exchange(part, (float*)(ws + WS_X1), (unsigned*)(ws + WS_CNT1), 32u, lds, u.pm, u.pn, wr, wc, fr, fq);
#pragma unroll
        for (int i = 0; i < 8; ++i) { const int ai = i >> 2, m = i & 3; const size_t off = (size_t)(row0 + ai * 128 + m * 16) * DM + col0; const float r = part[i];
#pragma unroll
            for (int bj = 0; bj < 2; ++bj) { const u32x4 xw = *(const u32x4*)(xb + off + bj * 128);
                const f32x4 g0 = *(const f32x4*)(g + col0 + bj * 128), g1 = *(const f32x4*)(g + col0 + bj * 128 + 4);
                const f32x4 v0 = (f32x4){bf_lo(xw.x), bf_hi(xw.x), bf_lo(xw.y), bf_hi(xw.y)} + acc[ai][bj][m][0] * r * g0;
                const f32x4 v1 = (f32x4){bf_lo(xw.z), bf_hi(xw.z), bf_lo(xw.w), bf_hi(xw.w)} + acc[ai][bj][m][1] * r * g1;
                float* orow = out + off + bj * 128; *(f32x4*)orow = v0; *(f32x4*)(orow + 4) = v1; }
            if (i & 1) asm volatile("" ::: "memory"); }
    }
};
__device__ __forceinline__ float silu_mul(float g, float u) { return g * __builtin_amdgcn_rcpf(1.0f + __builtin_amdgcn_exp2f(-g * LOG2E)) * u; }
struct EpiSwiglu {
    static constexpr bool PERM = true, AFTER_DRAIN = false;
    bf16_t* O; const unsigned short* rs;
    __device__ __forceinline__ void prefetch(unsigned (&pre)[4], const pg8::Unit& u, int wr, int fr) const { rs_prefetch(pre, rs, u.pm, wr, fr); }
    __device__ __forceinline__ void operator()(const f32x4 (&acc)[2][2][4][2], const pg8::Unit& u, int wr, int wc, int fr, int fq, const unsigned (&pre)[4]) const {
        const int row0 = u.pm * 256 + wr * 64 + fr, col0 = u.pn * 128 + wc * 32 + 8 * fq;
#pragma unroll
        for (int ai = 0; ai < 2; ++ai)
#pragma unroll
            for (int m = 0; m < 4; ++m) {
                const int row = row0 + ai * 128 + m * 16; const float r = rs_get(pre, ai, m);
                const f32x4 g0 = acc[ai][0][m][0] * r, g1 = acc[ai][0][m][1] * r, u0 = acc[ai][1][m][0] * r, u1 = acc[ai][1][m][1] * r;
                u32x4 w; w.x = pk_bf16(silu_mul(g0[0], u0[0]), silu_mul(g0[1], u0[1])); w.y = pk_bf16(silu_mul(g0[2], u0[2]), silu_mul(g0[3], u0[3]));
                w.z = pk_bf16(silu_mul(g1[0], u1[0]), silu_mul(g1[1], u1[1])); w.w = pk_bf16(silu_mul(g1[2], u1[2]), silu_mul(g1[3], u1[3]));
                *(u32x4*)(O + (size_t)row * DFF + col0) = w;
            }
    }
};

__device__ __forceinline__ void wt_item(const float* __restrict__ W, int ldw, int srccol, const float* __restrict__ gain, bf16_t* __restrict__ WT, int K, int n0, int k0, LAS float* scr, int lane) {
#pragma unroll 8
    for (int i = 0; i < 32; ++i) { const int kk = 2 * i + (lane >> 5); float v = W[(size_t)(k0 + kk) * ldw + srccol]; if (gain) v *= gain[k0 + kk]; scr[kk * 33 + (lane & 31)] = v; }
    asm volatile("s_waitcnt lgkmcnt(0)" ::: "memory");
    const int c = lane & 7;
#pragma unroll
    for (int j = 0; j < 4; ++j) { const int n = (lane >> 3) + 8 * j; const LAS float* s = scr + (8 * c) * 33 + n;
        u32x4 o; o.x = pk_bf16(s[0 * 33], s[1 * 33]); o.y = pk_bf16(s[2 * 33], s[3 * 33]); o.z = pk_bf16(s[4 * 33], s[5 * 33]); o.w = pk_bf16(s[6 * 33], s[7 * 33]);
        *(u32x4*)(WT + (size_t)(n0 + n) * K + k0 + 8 * c) = o; }
    asm volatile("s_waitcnt lgkmcnt(0)" ::: "memory");
}
__device__ __forceinline__ void prologue(const Params& p, LAS unsigned char* lds, int tid, int lane, int wave) {
    unsigned char* ws = p.ws;
    LAS float* scr = (LAS float*)(lds + wave * 16384);
    const int gw = blockIdx.x * NWAVES + wave, NGW = gridDim.x * NWAVES;
    constexpr int I_IN = 16 * 96, I_OUT = 16 * 32, I_GU = 16 * 176, I_DN = 44 * 32, I_L = I_IN + I_OUT + I_GU + I_DN;
    for (int it = gw; it < 2 * I_L; it += NGW) {
        const int l = it / I_L; int r = it - l * I_L; const int n = lane & 31;
        if (r < I_IN) { const int kb = r / 96, nb = r % 96, n0 = 32 * nb; const int ph = n0 + n; int src = ph;
            if (ph < 768) { const int fl = ph & 63; src = (ph & ~63) + 32 * ((fl >> 2) & 1) + 4 * (fl >> 3) + (fl & 3); }
            wt_item(p.w_in + (size_t)l * DM * DIN, DIN, src, p.g_pre_mix + l * DM, (bf16_t*)(ws + WS_WIN) + (size_t)l * DIN * DM, DM, n0, 64 * kb, scr, lane); continue; }
        r -= I_IN;
        if (r < I_OUT) { const int kb = r / 32, nb = r % 32, n0 = 32 * nb;
            wt_item(p.w_out + (size_t)l * DM * DM, DM, n0 + n, nullptr, (bf16_t*)(ws + WS_WOUT) + (size_t)l * DM * DM, DM, n0, 64 * kb, scr, lane); continue; }
        r -= I_OUT;
        if (r < I_GU) { const int kb = r / 176, nb = r % 176, n0 = 32 * nb, pn = n0 >> 8, cc = n0 & 255;
            const float* W = (cc < 128 ? p.w_gate : p.w_up) + (size_t)l * DM * DFF;
            wt_item(W, DFF, 128 * pn + (cc & 127) + n, p.g_pre_ffn + l * DM, (bf16_t*)(ws + WS_WGU) + (size_t)l * 2 * DFF * DM, DM, n0, 64 * kb, scr, lane); continue; }
        r -= I_GU;
        { const int kb = r / 32, nb = r % 32, n0 = 32 * nb;
            wt_item(p.w_down + (size_t)l * DFF * DM, DM, n0 + n, nullptr, (bf16_t*)(ws + WS_WDN) + (size_t)l * DM * DFF, DFF, n0, 64 * kb, scr, lane); }
    }
    { unsigned* cs = (unsigned*)(ws + WS_COS);
      for (int idx = blockIdx.x * 512 + tid; idx < 8192 * 32; idx += gridDim.x * 512) {
          const int pos = idx >> 5, i = idx & 31; double inv = 1.0; for (int k = 0; k < i; ++k) inv *= 0.7498942093324559;
          double rev = (double)pos * inv * 0.15915494309189535; rev -= __builtin_rint(rev);
          const float f = (float)rev; cs[idx] = pk_bf16(__builtin_amdgcn_cosf(f), __builtin_amdgcn_sinf(f)); } }
    { bf16_t* xb = (bf16_t*)(ws + WS_XB); unsigned short* rs = (unsigned short*)(ws + WS_RS);
      for (int row = gw; row < M_TOK; row += NGW) {
          const float* xr = row < NP_ROWS ? p.x_p + (size_t)row * DM : p.x_s + (size_t)(row - NP_ROWS) * DM;
          f32x4 v[4]; float ss = 0.f;
#pragma unroll
          for (int j = 0; j < 4; ++j) { v[j] = ((const f32x4*)xr)[64 * j + lane]; ss += (v[j][0] * v[j][0] + v[j][1] * v[j][1]) + (v[j][2] * v[j][2] + v[j][3] * v[j][3]); }
          ss = wave_sum(ss);
          u32x2* o8 = (u32x2*)(xb + (size_t)row * DM);
#pragma unroll
          for (int j = 0; j < 4; ++j) { u32x2 w; w.x = pk_bf16(v[j][0], v[j][1]); w.y = pk_bf16(v[j][2], v[j][3]); o8[64 * j + lane] = w; }
          if (lane == 0) rs_store(rs, row, 1.0f / sqrtf(ss * (1.0f / DM) + RMS_EPS));
      } }
}

template <bool FINAL>
__device__ __forceinline__ void ew_phase(const Params& p, const float* __restrict__ g, int lane, int wave) {
    unsigned char* ws = p.ws; const bf16_t* Y = (const bf16_t*)(ws + WS_Y); bf16_t* xb = (bf16_t*)(ws + WS_XB); unsigned short* rs = (unsigned short*)(ws + WS_RS);
    const int gw = blockIdx.x * NWAVES + wave, NGW = gridDim.x * NWAVES;
    f32x4 gv[4];
#pragma unroll
    for (int j = 0; j < 4; ++j) gv[j] = ((const f32x4*)g)[64 * j + lane];
    u32x2 yq[2][4], xq[2][4];
#pragma unroll
    for (int d = 0; d < 2; ++d) { int r0 = gw + d * NGW; r0 = r0 < M_TOK ? r0 : gw;
#pragma unroll
        for (int j = 0; j < 4; ++j) { yq[d][j] = ((const u32x2*)(Y + (size_t)r0 * DM))[64 * j + lane]; xq[d][j] = ((const u32x2*)(xb + (size_t)r0 * DM))[64 * j + lane]; } }
    for (int row = gw; row < M_TOK; row += NGW) {
        u32x2* xr = (u32x2*)(xb + (size_t)row * DM);
        u32x2 yc[4], xc[4];
#pragma unroll
        for (int j = 0; j < 4; ++j) { yc[j] = yq[0][j]; xc[j] = xq[0][j]; yq[0][j] = yq[1][j]; xq[0][j] = xq[1][j]; }
        { int r2 = row + 2 * NGW; r2 = r2 < M_TOK ? r2 : row;
#pragma unroll
          for (int j = 0; j < 4; ++j) { yq[1][j] = ((const u32x2*)(Y + (size_t)r2 * DM))[64 * j + lane]; xq[1][j] = ((const u32x2*)(xb + (size_t)r2 * DM))[64 * j + lane]; } }
        f32x4 xv[4], yf[4]; float ss = 0.f;
#pragma unroll
        for (int j = 0; j < 4; ++j) { const u32x2 w = yc[j], xw = xc[j];
            xv[j] = (f32x4){bf_lo(xw.x), bf_hi(xw.x), bf_lo(xw.y), bf_hi(xw.y)};
            yf[j] = (f32x4){bf_lo(w.x), bf_hi(w.x), bf_lo(w.y), bf_hi(w.y)}; ss += (yf[j][0] * yf[j][0] + yf[j][1] * yf[j][1]) + (yf[j][2] * yf[j][2] + yf[j][3] * yf[j][3]); }
        ss = wave_sum(ss); const float r = 1.0f / sqrtf(ss * (1.0f / DM) + RMS_EPS);
        float s2 = 0.f;
#pragma unroll
        for (int j = 0; j < 4; ++j) { const f32x4 xn = xv[j] + yf[j] * r * gv[j]; xv[j] = xn; s2 += (xn[0] * xn[0] + xn[1] * xn[1]) + (xn[2] * xn[2] + xn[3] * xn[3]); }
        if (FINAL) { float* orow = p.out + (size_t)row * DM;
#pragma unroll
            for (int j = 0; j < 4; ++j) ((f32x4*)orow)[64 * j + lane] = xv[j];
        } else {
            s2 = wave_sum(s2);
#pragma unroll
            for (int j = 0; j < 4; ++j) { u32x2 w; w.x = pk_bf16(xv[j][0], xv[j][1]); w.y = pk_bf16(xv[j][2], xv[j][3]); xr[64 * j + lane] = w; }
            if (lane == 0) rs_store(rs, row, 1.0f / sqrtf(s2 * (1.0f / DM) + RMS_EPS));
        }
    }
}

__device__ __forceinline__ bf16x8 ld8(const bf16_t* p) { return *(const bf16x8*)p; }
__device__ __forceinline__ void attn_store(bf16_t* orow, const f32x4 (&o)[4], float l, int fq) {
    l += __shfl_xor(l, 16); l += __shfl_xor(l, 32);
    const float inv = 1.0f / l;
#pragma unroll
    for (int c = 0; c < 4; ++c) { u32x2 w; w.x = pk_bf16(o[c][0] * inv, o[c][1] * inv); w.y = pk_bf16(o[c][2] * inv, o[c][3] * inv); *(u32x2*)(orow + 16 * c + 4 * fq) = w; }
}

struct PairRegs { bf16x8 k[2][2]; u32x4 v[2][2]; };

template <int NG> struct DilU { int seq0, L, r, u0, h; };
template <int D, int NG>
__device__ __forceinline__ DilU<NG> dilu_params(int item) {
    constexpr int CH = 16 * NG;
    DilU<NG> P; P.h = item % 6; const int cidx = item / 6, row0g = cidx * CH;
    int S; seq_of_row(row0g, S, P.seq0);
    constexpr int LG_CH = (CH == 16) ? 4 : (CH == 32) ? 5 : 6, LG_D = (D == 1) ? 0 : (D == 4) ? 2 : 4;
    const int lc = (row0g - P.seq0) >> LG_CH, lgLc = ((S == 2048) ? 11 : 13) - LG_D - LG_CH;
    P.L = S >> LG_D; P.r = lc >> lgLc; P.u0 = (lc & ((1 << lgLc) - 1)) << LG_CH;
    return P;
}
template <int D, int NG>
__device__ __forceinline__ void dilu_load(PairRegs& R, int p, const DilU<NG>& P, const bf16_t* proj, unsigned kofs, unsigned vofs) {
    const int rb = P.h * M_TOK + P.seq0 + P.r;
#pragma unroll
    for (int ab = 0; ab < 2; ++ab) {
        int x0 = P.u0 - 64 + 16 * (2 * p + ab); x0 = x0 < 0 ? 0 : (x0 > P.L - 16 ? P.L - 16 : x0);
        const size_t tb = (size_t)(rb + x0 * D) * 128;
        const char* kb = (const char*)(proj + PB_KD) + tb; const char* vb = (const char*)(proj + PB_VD) + tb;
        R.k[ab][0] = *(const bf16x8*)(kb + kofs); R.k[ab][1] = *(const bf16x8*)(kb + kofs + 64);
        R.v[ab][0] = *(const u32x4*)(vb + vofs); R.v[ab][1] = *(const u32x4*)(vb + vofs + 8 * D * 128);
    }
}
template <int D, int NG, int MODE, int PFD>
__device__ __forceinline__ void dilu_stream(const bf16_t* __restrict__ proj, bf16_t* __restrict__ mixed, bf16_t* __restrict__ ACC, float* __restrict__ LACC, LAS unsigned char* vst, unsigned* ctr, int xcd, int lane) {
    constexpr int NP = (NG + 9) / 2, NPV = ((NP + PFD - 1) / PFD) * PFD, CH = 16 * NG, NITEMS = (M_TOK / CH) * 6, PER = NITEMS / 8;
    static_assert(PFD - 1 <= NP, "ring prologue loads real pairs only");
#define DQ_TICKET(v) do { v = 0u; if (lane == 0) v = __hip_atomic_fetch_add(ctr, 1u, __ATOMIC_RELAXED, __HIP_MEMORY_SCOPE_AGENT); } while (0)
    const int base = xcd * PER;
    unsigned tk0, tk1; DQ_TICKET(tk0); DQ_TICKET(tk1);
    const int first = (int)__builtin_amdgcn_readfirstlane(tk0);
    if (first >= PER) return;
    int nxt = (int)__builtin_amdgcn_readfirstlane(tk1);
    const int fr = lane & 15, fq = lane >> 4, vr = lane >> 3, dlt = 4 * fq - fr;
    const unsigned kofs = (unsigned)((fr * D) * 128 + fq * 16), vofs = (unsigned)((vr * D) * 128 + (lane & 7) * 16);
    const unsigned wofs = vr * 160 + (lane & 7) * 16, trofs = (4 * fq + ((lane & 15) >> 2)) * 160 + (lane & 3) * 8;
    int it = base + first, par = 0;
    DilU<NG> P = dilu_params<D, NG>(it);
    PairRegs ring[PFD];
    bf16x8 q[NG][2];
#pragma unroll
    for (int g = 0; g < NG; ++g) { const bf16_t* qp = proj + PB_QD + (size_t)((P.h * M_TOK + P.seq0 + P.r + (P.u0 + 16 * g + fr) * D) * 64 + 8 * fq); q[g][0] = ld8(qp); q[g][1] = ld8(qp + 32); }
#pragma unroll
    for (int s = 0; s < PFD - 1; ++s) dilu_load<D, NG>(ring[s], s, P, proj, kofs, vofs);
    for (;;) {
        const bool has_next = nxt < PER; const int itn = base + nxt;
        unsigned tkn; DQ_TICKET(tkn);
        const DilU<NG> PN = dilu_params<D, NG>(has_next ? itn : it);
        bf16x8 qn[NG][2];
#pragma unroll
        for (int g = 0; g < NG; ++g) { const bf16_t* qp = proj + PB_QD + (size_t)((PN.h * M_TOK + PN.seq0 + PN.r + (PN.u0 + 16 * g + fr) * D) * 64 + 8 * fq); qn[g][0] = ld8(qp); qn[g][1] = ld8(qp + 32); }
        u32x2 pacc[NG][4]; float pl[NG];
        if (MODE != 0) {
#pragma unroll
            for (int g = 0; g < NG; ++g) { const int rowq = P.seq0 + P.r + (P.u0 + 16 * g + fr) * D; const bf16_t* ap = ACC + (size_t)(rowq * 6 + P.h) * 64 + 4 * fq;
#pragma unroll
                for (int c = 0; c < 4; ++c) pacc[g][c] = *(const u32x2*)(ap + 16 * c);
                pl[g] = LACC[rowq * 6 + P.h]; }
        }
        f32x4 o[NG][4]; float l[NG];
#pragma unroll
        for (int g = 0; g < NG; ++g) { l[g] = 0.f;
#pragma unroll
            for (int c = 0; c < 4; ++c) o[g][c] = (f32x4){0.f, 0.f, 0.f, 0.f}; }
#pragma unroll
        for (int p = 0; p < NPV; ++p) {
            const int m = p + PFD - 1;
            if (m < NPV) { if (m < NP) dilu_load<D, NG>(ring[m % PFD], m, P, proj, kofs, vofs); }
            else { if (m - NPV < NP) dilu_load<D, NG>(ring[m % PFD], m - NPV, PN, proj, kofs, vofs); }
            if (p >= NP) continue;
            const PairRegs& R = ring[p % PFD];
            LAS unsigned char* vbuf = vst + (((p & 1) ^ par) * 5120);
#pragma unroll
            for (int ab = 0; ab < 2; ++ab) { *(LAS u32x4*)(vbuf + ab * 2560 + wofs) = R.v[ab][0]; *(LAS u32x4*)(vbuf + ab * 2560 + wofs + 8 * 160) = R.v[ab][1]; }
            asm volatile("s_waitcnt lgkmcnt(0)" ::: "memory");
            bf16x8 vt[4];
#pragma unroll
            for (int c = 0; c < 4; ++c) {
                const s16x4 ta = __builtin_amdgcn_ds_read_tr16_b64_v4i16((LAS s16x4*)(vbuf + trofs + c * 32));
                const s16x4 tb = __builtin_amdgcn_ds_read_tr16_b64_v4i16((LAS s16x4*)(vbuf + 2560 + trofs + c * 32));
                vt[c] = (bf16x8){ta[0], ta[1], ta[2], ta[3], tb[0], tb[1], tb[2], tb[3]};
            }
            bool tok[2];
#pragma unroll
            for (int ab = 0; ab < 2; ++ab) { const int x0 = P.u0 - 64 + 16 * (2 * p + ab); tok[ab] = (x0 >= 0 && x0 < P.L); }
#pragma unroll
            for (int g = 0; g < NG; ++g) {
                const int dja = 2 * p - g, djb = 2 * p + 1 - g;
                const bool acta = dja >= 0 && dja <= 8, actb = djb >= 0 && djb <= 8;
                if (!acta && !actb) continue;
                f32x4 pr[2];
#pragma unroll
                for (int ab = 0; ab < 2; ++ab) {
                    const int dj = ab ? djb : dja; const bool act = ab ? actb : acta;
                    if (!act) { pr[ab] = (f32x4){0.f, 0.f, 0.f, 0.f}; continue; }
                    f32x4 s = {0.f, 0.f, 0.f, 0.f};
                    s = __builtin_amdgcn_mfma_f32_16x16x32_bf16(R.k[ab][0], q[g][0], s, 0, 0, 0);
                    s = __builtin_amdgcn_mfma_f32_16x16x32_bf16(R.k[ab][1], q[g][1], s, 0, 0, 0);
#pragma unroll
                    for (int e = 0; e < 4; ++e) {
                        float ex = __builtin_amdgcn_exp2f(s[e]);
                        bool ok = tok[ab];
                        if (dj == 0) ok = ok && (dlt + e >= 0);
                        if (dj == 8) ok = ok && (dlt + e <= 0);
                        ex = ok ? ex : 0.f;
                        pr[ab][e] = ex; l[g] += ex;
                    }
                }
                union { u32x4 u; bf16x8 h; } pp; pp.u.x = pk_bf16(pr[0][0], pr[0][1]); pp.u.y = pk_bf16(pr[0][2], pr[0][3]); pp.u.z = pk_bf16(pr[1][0], pr[1][1]); pp.u.w = pk_bf16(pr[1][2], pr[1][3]);
#pragma unroll
                for (int c = 0; c < 4; ++c) o[g][c] = __builtin_amdgcn_mfma_f32_16x16x32_bf16(vt[c], pp.h, o[g][c], 0, 0, 0);
            }
        }
#pragma unroll
        for (int g = 0; g < NG; ++g) {
            float lg = l[g]; lg += __shfl_xor(lg, 16); lg += __shfl_xor(lg, 32);
            const int rowq = P.seq0 + P.r + (P.u0 + 16 * g + fr) * D;
            bf16_t* ap = ACC + (size_t)(rowq * 6 + P.h) * 64 + 4 * fq; float* lp = LACC + rowq * 6 + P.h;
            if (MODE == 0) {
#pragma unroll
                for (int c = 0; c < 4; ++c) { u32x2 w; w.x = pk_bf16(o[g][c][0], o[g][c][1]); w.y = pk_bf16(o[g][c][2], o[g][c][3]); *(u32x2*)(ap + 16 * c) = w; }
                if (fq == 0) *lp = lg;
            } else if (MODE == 1) {
#pragma unroll
                for (int c = 0; c < 4; ++c) { const u32x2 pw = pacc[g][c]; const f32x4 t = (f32x4){bf_lo(pw.x), bf_hi(pw.x), bf_lo(pw.y), bf_hi(pw.y)} + o[g][c];
                    u32x2 w; w.x = pk_bf16(t[0], t[1]); w.y = pk_bf16(t[2], t[3]); *(u32x2*)(ap + 16 * c) = w; }
                if (fq == 0) *lp = pl[g] + lg;
            } else {
                const float inv = 1.0f / (pl[g] + lg);
                bf16_t* orow = mixed + (size_t)rowq * DM + P.h * 64 + 4 * fq;
#pragma unroll
                for (int c = 0; c < 4; ++c) { const u32x2 pw = pacc[g][c]; const f32x4 t = ((f32x4){bf_lo(pw.x), bf_hi(pw.x), bf_lo(pw.y), bf_hi(pw.y)} + o[g][c]) * inv; u32x2 w; w.x = pk_bf16(t[0], t[1]); w.y = pk_bf16(t[2], t[3]); *(u32x2*)(orow + 16 * c) = w; }
            }
        }
        if (!has_next) break;
        it = itn; nxt = (int)__builtin_amdgcn_readfirstlane(tkn); P = PN; par ^= (NP & 1);
#pragma unroll
        for (int g = 0; g < NG; ++g) { q[g][0] = qn[g][0]; q[g][1] = qn[g][1]; }
    }
}

#ifndef CFG_NG
#define CFG_NG 2
#define CFG_PF 2
#endif
#undef DQ_TICKET
struct Na2P { int kvrow; const bf16_t* qp; const LAS float* bb; int rs0, rows, kc0, qc, cs, orow, h, d1; };
__device__ __forceinline__ Na2P na2_params(const bf16_t* proj, const LAS float* tbl, int item, int lane) {
    Na2P P; const int fr = lane & 15, fq = lane >> 4;
    int S, t; if (item < 8 * 16 * 16) { S = 2048; t = item; } else { S = 8192; t = item - 8 * 16 * 16; }
    const int rows = S >> 6, per = (rows >> 1) * 16, seq = t / per, u = t - seq * per, rp = u >> 4, cb = u & 3; P.h = (u >> 2) & 3;
    const int seq0 = (S == 2048) ? seq * 2048 : NP_ROWS + seq * 8192, r = 2 * rp;
    int rs0 = r - 4; rs0 = rs0 < 0 ? 0 : (rs0 > rows - 8 ? rows - 8 : rs0);
    int rs1 = r - 3; rs1 = rs1 < 0 ? 0 : (rs1 > rows - 8 ? rows - 8 : rs1);
    P.rs0 = rs0; P.rows = rows; P.d1 = rs1 - rs0;
    int kc0 = 16 * cb - 8; kc0 = kc0 < 0 ? 0 : (kc0 > 32 ? 32 : kc0); P.kc0 = kc0;
    P.qc = 16 * cb + fr; int cs = P.qc - 8; cs = cs < 0 ? 0 : (cs > 48 ? 48 : cs); P.cs = cs;
    P.kvrow = P.h * M_TOK + seq0 + kc0;
    P.orow = seq0 + r * 64 + P.qc;
    P.qp = proj + PB_QN + ((size_t)P.h * M_TOK + P.orow) * 64 + 8 * fq;
    P.bb = tbl + P.h * 465 + (rs0 - r + 7) * 31;
    return P;
}
__device__ __forceinline__ void na2_load(PairRegs& R, int n, const Na2P& P, const bf16_t* proj, unsigned kofs, unsigned vofs) {
    int kr = P.rs0 + n; kr = kr > P.rows - 1 ? P.rows - 1 : kr;
#pragma unroll
    for (int hh = 0; hh < 2; ++hh) {
        const size_t tb = (size_t)(P.kvrow + kr * 64 + 16 * hh) * 128;
        const char* kb = (const char*)(proj + PB_KN) + tb; const char* vb = (const char*)(proj + PB_VN) + tb;
        R.k[hh][0] = *(const bf16x8*)(kb + kofs); R.k[hh][1] = *(const bf16x8*)(kb + kofs + 64);
        R.v[hh][0] = *(const u32x4*)(vb + vofs); R.v[hh][1] = *(const u32x4*)(vb + vofs + 8 * 128);
    }
}
template <int PFD>
__device__ __forceinline__ void na2_stream(const bf16_t* __restrict__ proj, bf16_t* __restrict__ mixed, LAS unsigned char* vst, const LAS float* tbl, int first, int stride, int lane) {
    constexpr int NP = 9, NPV = ((NP + PFD - 1) / PFD) * PFD, NITEMS = (M_TOK / 128) * 16;
    if (first >= NITEMS) return;
    const int fr = lane & 15, fq = lane >> 4, vr = lane >> 3;
    const unsigned kofs = (unsigned)(fr * 128 + fq * 16), vofs = (unsigned)(vr * 128 + (lane & 7) * 16);
    const unsigned wofs = vr * 160 + (lane & 7) * 16, trofs = (4 * fq + ((lane & 15) >> 2)) * 160 + (lane & 3) * 8;
    int it = first;
    Na2P P = na2_params(proj, tbl, it, lane);
    PairRegs ring[PFD];
    bf16x8 q[2][2];
#pragma unroll
    for (int g = 0; g < 2; ++g) { q[g][0] = ld8(P.qp + g * 4096); q[g][1] = ld8(P.qp + g * 4096 + 32); }
#pragma unroll
    for (int s = 0; s < PFD - 1; ++s) na2_load(ring[s], s, P, proj, kofs, vofs);
    for (;;) {
        const int itn = it + stride; const bool has_next = itn < NITEMS;
        const Na2P PN = na2_params(proj, tbl, has_next ? itn : it, lane);
        bf16x8 qn[2][2];
#pragma unroll
        for (int g = 0; g < 2; ++g) { qn[g][0] = ld8(PN.qp + g * 4096); qn[g][1] = ld8(PN.qp + g * 4096 + 32); }
        f32x4 o[2][4]; float l[2];
#pragma unroll
        for (int g = 0; g < 2; ++g) { l[g] = 0.f;
#pragma unroll
            for (int c = 0; c < 4; ++c) o[g][c] = (f32x4){0.f, 0.f, 0.f, 0.f}; }
#pragma unroll
        for (int p = 0; p < NPV; ++p) {
            const int m = p + PFD - 1;
            if (m < NPV) { if (m < NP) na2_load(ring[m % PFD], m, P, proj, kofs, vofs); }
            else { if (m - NPV < NP) na2_load(ring[m % PFD], m - NPV, PN, proj, kofs, vofs); }
            if (p >= NP) continue;
            const PairRegs& R = ring[p % PFD];
            LAS unsigned char* vbuf = vst + (p % 3) * 5120;
#pragma unroll
            for (int ab = 0; ab < 2; ++ab) { *(LAS u32x4*)(vbuf + ab * 2560 + wofs) = R.v[ab][0]; *(LAS u32x4*)(vbuf + ab * 2560 + wofs + 8 * 160) = R.v[ab][1]; }
            asm volatile("s_waitcnt lgkmcnt(0)" ::: "memory");
            bf16x8 vt[4];
#pragma unroll
            for (int c = 0; c < 4; ++c) {
                const s16x4 ta = __builtin_amdgcn_ds_read_tr16_b64_v4i16((LAS s16x4*)(vbuf + trofs + c * 32));
                const s16x4 tb = __builtin_amdgcn_ds_read_tr16_b64_v4i16((LAS s16x4*)(vbuf + 2560 + trofs + c * 32));
                vt[c] = (bf16x8){ta[0], ta[1], ta[2], ta[3], tb[0], tb[1], tb[2], tb[3]};
            }
#pragma unroll
            for (int g = 0; g < 2; ++g) {
                if (g == 0 && p == 8) continue;
                const bool act = (g == 0) ? true : (p == 0 ? P.d1 == 0 : (p == 8 ? P.d1 == 1 : true));
                const LAS float* brow = P.bb + (p - g) * 31;
                f32x4 pr[2];
#pragma unroll
                for (int hh = 0; hh < 2; ++hh) {
                    f32x4 s = {0.f, 0.f, 0.f, 0.f};
                    s = __builtin_amdgcn_mfma_f32_16x16x32_bf16(R.k[hh][0], q[g][0], s, 0, 0, 0);
                    s = __builtin_amdgcn_mfma_f32_16x16x32_bf16(R.k[hh][1], q[g][1], s, 0, 0, 0);
#pragma unroll
                    for (int e = 0; e < 4; ++e) { const int kc = P.kc0 + 16 * hh + 4 * fq + e; const bool valid = act && (kc >= P.cs) && (kc < P.cs + 16);
                        int dc = kc - P.qc + 15; dc = dc < 0 ? 0 : (dc > 30 ? 30 : dc);
                        const float ex = __builtin_amdgcn_exp2f(s[e] + brow[dc]); pr[hh][e] = valid ? ex : 0.f; l[g] += pr[hh][e]; }
                }
                union { u32x4 u; bf16x8 h; } pp; pp.u.x = pk_bf16(pr[0][0], pr[0][1]); pp.u.y = pk_bf16(pr[0][2], pr[0][3]); pp.u.z = pk_bf16(pr[1][0], pr[1][1]); pp.u.w = pk_bf16(pr[1][2], pr[1][3]);
#pragma unroll
                for (int c = 0; c < 4; ++c) o[g][c] = __builtin_amdgcn_mfma_f32_16x16x32_bf16(vt[c], pp.h, o[g][c], 0, 0, 0);
            }
        }
#pragma unroll
        for (int g = 0; g < 2; ++g) attn_store(mixed + (size_t)(P.orow + g * 64) * DM + 384 + P.h * 64, o[g], l[g], fq);
        if (!has_next) break;
        it = itn; P = PN;
#pragma unroll
        for (int g = 0; g < 2; ++g) { q[g][0] = qn[g][0]; q[g][1] = qn[g][1]; }
    }
}

constexpr int DIL_NG = CFG_NG, DIL_PF = CFG_PF;
__device__ __forceinline__ void mix_a(const Params& p, int layer, LAS unsigned char* lds, int tid, int lane, int wave) {
    unsigned char* ws = p.ws; const bf16_t* proj = (const bf16_t*)(ws + WS_PROJ); bf16_t* mixed = (bf16_t*)(ws + WS_MIXED);
    LAS float* tbl = (LAS float*)(lds + 131072);
    for (int i = tid; i < 4 * 465; i += 512) tbl[i] = p.rpb[layer * 4 * 465 + i] * LOG2E;
    __syncthreads();
    LAS unsigned char* vst = lds + wave * 16384;
    const int vcu = (gridDim.x % 8 == 0) ? (int)(blockIdx.x % 8) * (int)(gridDim.x / 8) + (int)(blockIdx.x / 8) : (int)blockIdx.x;
    const int gw = vcu * NWAVES + wave, NGW = gridDim.x * NWAVES;
    na2_stream<2>(proj, mixed, vst, tbl, gw, NGW, lane);
    dilu_stream<16, DIL_NG, 0, DIL_PF>(proj, mixed, (bf16_t*)(ws + WS_Y), (float*)(ws + WS_Y + 128 * MiB), vst, (unsigned*)(ws + WS_QCTR) + ((layer * 3 + 0) * 8 + (int)(blockIdx.x & 7)) * 64, (int)(blockIdx.x & 7), lane);
}
__device__ __forceinline__ void mix_b(const Params& p, int layer, LAS unsigned char* lds, int tid, int lane, int wave) {
    unsigned char* ws = p.ws; const bf16_t* proj = (const bf16_t*)(ws + WS_PROJ); bf16_t* mixed = (bf16_t*)(ws + WS_MIXED);
    LAS unsigned char* vst = lds + wave * 16384;
    const int vcu = (gridDim.x % 8 == 0) ? (int)(blockIdx.x % 8) * (int)(gridDim.x / 8) + (int)(blockIdx.x / 8) : (int)blockIdx.x;
    const int gw = vcu * NWAVES + wave, NGW = gridDim.x * NWAVES;
    const float* cw = p.conv_w + layer * 3 * 384;
    for (int idx = blockIdx.x * 512 + tid; idx < M_TOK * 48; idx += gridDim.x * 512) {
        const int row = idx / 48, c0 = (idx - row * 48) * 8;
        int S, seq0; seq_of_row(row, S, seq0); const int pos = row - seq0;
        const bf16_t* base = proj + PB_CV + (size_t)row * DCV + c0;
        const u32x4 gb = *(const u32x4*)base;
        float acc[8];
#pragma unroll
        for (int k = 0; k < 8; ++k) acc[k] = 0.f;
#pragma unroll
        for (int j = 0; j < 3; ++j) {
            const int pp = pos + j - 1;
            if (pp >= 0 && pp < S) {
                const bf16_t* bj = base + (ptrdiff_t)(j - 1) * DCV;
                const u32x4 gc = *(const u32x4*)(bj + 384), hi = *(const u32x4*)(bj + 768);
                const f32x4 w0 = *(const f32x4*)(cw + j * 384 + c0), w1 = *(const f32x4*)(cw + j * 384 + c0 + 4);
                acc[0] += w0[0] * bf_lo(gc.x) * bf_lo(hi.x); acc[1] += w0[1] * bf_hi(gc.x) * bf_hi(hi.x);
                acc[2] += w0[2] * bf_lo(gc.y) * bf_lo(hi.y); acc[3] += w0[3] * bf_hi(gc.y) * bf_hi(hi.y);
                acc[4] += w1[0] * bf_lo(gc.z) * bf_lo(hi.z); acc[5] += w1[1] * bf_hi(gc.z) * bf_hi(hi.z);
                acc[6] += w1[2] * bf_lo(gc.w) * bf_lo(hi.w); acc[7] += w1[3] * bf_hi(gc.w) * bf_hi(hi.w);
            }
        }
        u32x4 w; w.x = pk_bf16(acc[0] * bf_lo(gb.x), acc[1] * bf_hi(gb.x)); w.y = pk_bf16(acc[2] * bf_lo(gb.y), acc[3] * bf_hi(gb.y));
        w.z = pk_bf16(acc[4] * bf_lo(gb.z), acc[5] * bf_hi(gb.z)); w.w = pk_bf16(acc[6] * bf_lo(gb.w), acc[7] * bf_hi(gb.w));
        *(u32x4*)(mixed + (size_t)row * DM + 640 + c0) = w;
    }
    dilu_stream<4, DIL_NG, 1, DIL_PF>(proj, mixed, (bf16_t*)(ws + WS_Y), (float*)(ws + WS_Y + 128 * MiB), vst, (unsigned*)(ws + WS_QCTR) + ((layer * 3 + 1) * 8 + (int)(blockIdx.x & 7)) * 64, (int)(blockIdx.x & 7), lane);
}
__device__ __forceinline__ void mix_c(const Params& p, int layer, LAS unsigned char* lds, int lane, int wave) {
    unsigned char* ws = p.ws; const bf16_t* proj = (const bf16_t*)(ws + WS_PROJ); bf16_t* mixed = (bf16_t*)(ws + WS_MIXED);
    LAS unsigned char* vst = lds + wave * 16384;
    const int vcu = (gridDim.x % 8 == 0) ? (int)(blockIdx.x % 8) * (int)(gridDim.x / 8) + (int)(blockIdx.x / 8) : (int)blockIdx.x;
    const int gw = vcu * NWAVES + wave, NGW = gridDim.x * NWAVES;
    dilu_stream<1, DIL_NG, 2, DIL_PF>(proj, mixed, (bf16_t*)(ws + WS_Y), (float*)(ws + WS_Y + 128 * MiB), vst, (unsigned*)(ws + WS_QCTR) + ((layer * 3 + 2) * 8 + (int)(blockIdx.x & 7)) * 64, (int)(blockIdx.x & 7), lane);
}

#define XB_TMO      128
#define XB_XCNT(j)  (256  + 64 * (j))
#define XB_XSUB(j)  (1280 + 64 * (j))
#define XB_XGEN(j)  (2304 + 64 * (j))
#define XB_TOP      3328
#define XB_TOPGEN   3392
#define XCD_BAR_WORDS 3456
#define XB_SPIN_CAP (1u << 18)

__device__ __forceinline__ unsigned xb_ld(unsigned* p)              { return __hip_atomic_load(p, __ATOMIC_RELAXED, __HIP_MEMORY_SCOPE_AGENT); }
__device__ __forceinline__ unsigned xb_add(unsigned* p, unsigned v) { return __hip_atomic_fetch_add(p, v, __ATOMIC_RELAXED, __HIP_MEMORY_SCOPE_AGENT); }
__device__ __forceinline__ unsigned xb_xcc_id() { return (unsigned)__builtin_amdgcn_s_getreg((3 << 11) | 20) & 0xFu; }
#define XB_SPIN(cond, bar) do { unsigned _sp = 0; while (cond) { __builtin_amdgcn_s_sleep(1); \
    if ((++_sp & 255u) == 0u) { if (xb_ld(&(bar)[XB_TMO])) break; if (_sp > XB_SPIN_CAP) { atomicAdd(&(bar)[XB_TMO], 1u); break; } } } } while (0)

struct XcdBarrier {
    unsigned* bar; unsigned x;
    volatile LAS unsigned* st;
};

__device__ __forceinline__ XcdBarrier xcd_barrier_post(unsigned* bar, volatile LAS unsigned* st) {
    XcdBarrier b; b.bar = bar; b.x = xb_xcc_id(); b.st = st;
    if (threadIdx.x == 0) (void)xb_add(&bar[XB_XCNT(b.x)], 1u);
    return b;
}
__device__ __forceinline__ void xcd_barrier_complete(unsigned* bar, unsigned x, unsigned& nloc, unsigned& nx) {
    const unsigned G = gridDim.x * gridDim.y * gridDim.z;
    unsigned sum, cnt, mine, sp = 0u;
    for (;;) {
        sum = 0u; cnt = 0u; mine = 0u;
#pragma unroll
        for (unsigned j = 0; j < 16; ++j) { const unsigned c = xb_ld(&bar[XB_XCNT(j)]); sum += c; cnt += (c > 0u) ? 1u : 0u; mine = (j == x) ? c : mine; }
        if (sum == G) break;
        __builtin_amdgcn_s_sleep(1);
        if ((++sp & 255u) == 0u) { if (xb_ld(&bar[XB_TMO])) break; if (sp > XB_SPIN_CAP) { atomicAdd(&bar[XB_TMO], 1u); break; } }
    }
    nloc = mine > 0u ? mine : 1u; nx = cnt > 0u ? cnt : 1u;
}

__device__ __forceinline__ void xcd_barrier(const XcdBarrier& b) {
    asm volatile("s_waitcnt vmcnt(0)" ::: "memory");
    __syncthreads();
    if (threadIdx.x == 0) {
        unsigned* bar = b.bar;
        __builtin_amdgcn_s_waitcnt(0);
        unsigned nloc = b.st[0], nx = b.st[1];
        if (nloc == 0u) { xcd_barrier_complete(bar, b.x, nloc, nx); b.st[0] = nloc; b.st[1] = nx; }
        const unsigned old = xb_add(&bar[XB_XSUB(b.x)], 1u);
        const unsigned gen = old / nloc;
        if (old + 1u == (gen + 1u) * nloc) {
            __builtin_amdgcn_fence(__ATOMIC_RELEASE, "agent");
            asm volatile("s_waitcnt vmcnt(0)" ::: "memory");
            const unsigned og = xb_add(&bar[XB_TOP], 1u);
            const unsigned tg = og / nx;
            if (og + 1u == (tg + 1u) * nx) xb_add(&bar[XB_TOPGEN], 1u);
            else XB_SPIN(xb_ld(&bar[XB_TOPGEN]) == tg, bar);
            __builtin_amdgcn_fence(__ATOMIC_ACQUIRE, "agent");
            xb_add(&bar[XB_XGEN(b.x)], 1u);
            asm volatile("s_waitcnt vmcnt(0)" ::: "memory");
        } else {
            XB_SPIN(xb_ld(&bar[XB_XGEN(b.x)]) == gen, bar);
            __builtin_amdgcn_fence(__ATOMIC_ACQUIRE, "agent");
            asm volatile("s_waitcnt vmcnt(0)" ::: "memory");
        }
    }
    __syncthreads();
}

__global__ void __launch_bounds__(512) fwd_mega(Params p) {
    extern __shared__ __attribute__((aligned(16))) unsigned char lds_raw[];
    LAS unsigned char* lds = (LAS unsigned char*)lds_raw;
    cg::grid_group grid = cg::this_grid();
    unsigned char* ws = p.ws;
#define FRESH_TID() int tid = threadIdx.x; asm volatile("" : "+v"(tid)); const int lane = tid & 63, wave = __builtin_amdgcn_readfirstlane(tid >> 6)
    bf16_t* xb = (bf16_t*)(ws + WS_XB); bf16_t* proj = (bf16_t*)(ws + WS_PROJ); bf16_t* mixed = (bf16_t*)(ws + WS_MIXED); bf16_t* Y = (bf16_t*)(ws + WS_Y); bf16_t* H = (bf16_t*)(ws + WS_H);
    const unsigned short* rs = (const unsigned short*)(ws + WS_RS);

    if (threadIdx.x < 4) ((volatile LAS unsigned*)(lds + 139264))[threadIdx.x] = 0u;
    __syncthreads();
    const XcdBarrier xbar = xcd_barrier_post((unsigned*)(ws + WS_CTL), (volatile LAS unsigned*)(lds + 139264));
    { FRESH_TID(); prologue(p, lds, tid, lane, wave); }
    grid.sync();
    for (int layer = 0; layer < 2; ++layer) {
        {
            pg8::Gemm g{xb, (const bf16_t*)(ws + WS_WIN) + (size_t)layer * DIN * DM, M_TOK, DIN, DM}; pg8::StaticOrder S; S.init(M_TOK, DIN, (int)gridDim.x, (int)blockIdx.x);
            EpiProj E{proj, rs, (const unsigned*)(ws + WS_COS)};
            pg8::gemm_phase<EpiProj, pg8::StaticOrder>(lds, g, S, E);
        }
        xcd_barrier(xbar);
        { FRESH_TID(); mix_a(p, layer, lds, tid, lane, wave); }
        xcd_barrier(xbar);
        { FRESH_TID(); mix_b(p, layer, lds, tid, lane, wave); }
        xcd_barrier(xbar);
        { FRESH_TID(); (void)tid; mix_c(p, layer, lds, lane, wave); }
        xcd_barrier(xbar);
        {
            pg8::Gemm g{mixed, (const bf16_t*)(ws + WS_WOUT) + (size_t)layer * DM * DM, M_TOK, DM, DM}; pg8::StaticOrder S; S.init(M_TOK, DM, (int)gridDim.x, (int)blockIdx.x);
            EpiPlain E{Y, DM};
            pg8::gemm_phase<EpiPlain, pg8::StaticOrder>(lds, g, S, E);
        }
        xcd_barrier(xbar);
        { FRESH_TID(); (void)tid; ew_phase<false>(p, p.g_post_mix + layer * DM, lane, wave); }
        xcd_barrier(xbar);
        {
            pg8::Gemm g{xb, (const bf16_t*)(ws + WS_WGU) + (size_t)layer * 2 * DFF * DM, M_TOK, 2 * DFF, DM}; pg8::StaticOrder S; S.init(M_TOK, 2 * DFF, (int)gridDim.x, (int)blockIdx.x);
            EpiSwiglu E{H, rs};
            pg8::gemm_phase<EpiSwiglu, pg8::StaticOrder>(lds, g, S, E);
        }
        xcd_barrier(xbar);
        {
            pg8::Gemm g{H, (const bf16_t*)(ws + WS_WDN) + (size_t)layer * DM * DFF, M_TOK, DM, DFF}; pg8::StaticOrder S; S.init(M_TOK, DM, (int)gridDim.x, (int)blockIdx.x);
            if (layer == 0) { EpiPlain E{Y, DM}; pg8::gemm_phase<EpiPlain, pg8::StaticOrder>(lds, g, S, E); }
            else { EpiNormOut E{ws, p.out, p.g_post_ffn + layer * DM, lds}; pg8::gemm_phase<EpiNormOut, pg8::StaticOrder>(lds, g, S, E); }
        }
        if (layer == 0) { xcd_barrier(xbar); { FRESH_TID(); (void)tid; ew_phase<false>(p, p.g_post_ffn + layer * DM, lane, wave); } xcd_barrier(xbar); }
    }
}

extern "C" void kernel_launch(void* const* d_in, const int* in_sizes, int n_in, void* d_out, int out_size, void* d_ws, size_t ws_size, hipStream_t stream) {
    static int grid_blocks = 0;
    if (!grid_blocks) {
        if (n_in != 13 || out_size != M_TOK * DM || ws_size < WS_END) { fprintf(stderr, "kernel_launch: unexpected sizes (n_in %d out %d ws %zu)\n", n_in, out_size, ws_size); grid_blocks = -1; return; }
        int dev = 0, cus = 0, per_cu = 0;
        hipGetDevice(&dev); hipDeviceGetAttribute(&cus, hipDeviceAttributeMultiprocessorCount, dev);
        hipFuncSetAttribute((const void*)fwd_mega, hipFuncAttributeMaxDynamicSharedMemorySize, LDS_BYTES);
        hipOccupancyMaxActiveBlocksPerMultiprocessor(&per_cu, (const void*)fwd_mega, 512, LDS_BYTES);
        if (per_cu < 1) { fprintf(stderr, "kernel_launch: occupancy query says %d blocks per CU\n", per_cu); per_cu = 1; }
        (void)hipGetLastError();
        grid_blocks = cus * per_cu;
    }
    if (grid_blocks < 0) return;
    Params p{};
    p.x_p = (const float*)d_in[0]; p.x_s = (const float*)d_in[1]; p.g_pre_mix = (const float*)d_in[2]; p.w_in = (const float*)d_in[3]; p.conv_w = (const float*)d_in[4];
    p.rpb = (const float*)d_in[5]; p.w_out = (const float*)d_in[6]; p.g_post_mix = (const float*)d_in[7]; p.g_pre_ffn = (const float*)d_in[8]; p.w_gate = (const float*)d_in[9];
    p.w_up = (const float*)d_in[10]; p.w_down = (const float*)d_in[11]; p.g_post_ffn = (const float*)d_in[12]; p.out = (float*)d_out; p.ws = (unsigned char*)d_ws;
    if (hipMemsetAsync((char*)d_ws + WS_CTL, 0, CTL_BYTES, stream) != hipSuccess) { fprintf(stderr, "kernel_launch: memset of the barrier words failed\n"); return; }
    void* args[] = {&p};
    hipError_t e = hipLaunchCooperativeKernel((const void*)fwd_mega, dim3(grid_blocks), dim3(512), args, LDS_BYTES, stream);
    if (e != hipSuccess) fprintf(stderr, "cooperative launch failed: %s (grid %d)\n", hipGetErrorString(e), grid_blocks);
}
```

```cpp
#include <hip/hip_runtime.h>
#include <hip/hip_cooperative_groups.h>
#include <cstdio>
namespace cg = cooperative_groups;
namespace pg8 {
#define PG8_LAS __attribute__((address_space(3)))
typedef unsigned short bf16_t;
typedef short bf16x8 __attribute__((ext_vector_type(8)));
typedef float f32x4 __attribute__((ext_vector_type(4)));
typedef unsigned u32x4 __attribute__((ext_vector_type(4)));
constexpr int BM = 256, BK = 64, HALF = 128, HTB = HALF * BK * 2  , STAGE_BYTES = 8 * HTB, NXCD = 8, WGM = 8;

__host__ __device__ __forceinline__ int lds_byte(int r, int c) { const int st = (r >> 4) * 2 + (c >> 5), rr = r & 15, cc = c & 31, ob = rr * 64 + cc * 2; return st * 1024 + (ob ^ (((ob >> 9) & 1) << 5)); }
__host__ __device__ __forceinline__ void stage_rc(int b, int& R, int& C) { const int st = b / 1024, sb = b % 1024, swz = sb ^ (((sb >> 9) & 1) << 5); R = (st >> 1) * 16 + swz / 64; C = (st & 1) * 32 + (swz % 64) / 2; }
__host__ __device__ __forceinline__ int perm32(int rho) { const int n = rho >> 4, i = rho & 15; return 8 * (i >> 2) + 4 * n + (i & 3); }

struct Unit { int pm, pn; };
struct Gemm { const bf16_t* A; const bf16_t* Bt; int M, N, K; };

struct StaticOrder {
    int nM, nN, nwg, G, c;
    __host__ __device__ void init(int M, int N, int G_, int c_) { nM = M / BM; nN = N / BM; nwg = nM * nN; G = G_; c = c_; }
    __host__ __device__ bool next(int i, Unit& u) const {
        const long L = (long)i * G + c; if (L >= nwg) return false;
        int wgid = (int)L; { const int q = nwg / NXCD, r = nwg % NXCD, xcd = wgid % NXCD, off = wgid / NXCD; wgid = (xcd < r ? xcd * (q + 1) : r * (q + 1) + (xcd - r) * q) + off; }
        const int nig = WGM * nN, gid = wgid / nig, fm = gid * WGM, gsz = (nM - fm) < WGM ? (nM - fm) : WGM;
        u.pm = fm + ((wgid % nig) % gsz); u.pn = (wgid % nig) / gsz; return true;
    }
    __device__ __forceinline__ void a_ready(const Unit&) const {}
    __device__ __forceinline__ void done(const Unit&) const {}
};
typedef float f32x2 __attribute__((ext_vector_type(2)));
template <class Epi, class Sched, bool ALIGN_EPI = true, bool SP2 = true>
__device__ __forceinline__ void gemm_phase(PG8_LAS unsigned char* lds, const Gemm g, const Sched& S, const Epi& E) {
    int tid_ = threadIdx.x; asm volatile("" : "+v"(tid_));
    const int tid = tid_, wid = __builtin_amdgcn_readfirstlane(tid >> 6), lane = tid & 63, wr = wid >> 2, wc = wid & 3, fr = lane & 15, fq = lane >> 4;
    const int K = g.K, nt = K / BK;
    unsigned voffA[2], voffB[2];
#pragma unroll
    for (int i = 0; i < 2; ++i) { int R, C; stage_rc(tid * 16 + i * 8192, R, C); const int Rb = Epi::PERM ? ((R & ~31) + perm32(R & 31)) : R;
        voffA[i] = (unsigned)(R * K + C) * 2u; voffB[i] = (unsigned)(Rb * K + C) * 2u; }
    const size_t kstep = (size_t)(BK * 2);
    const size_t hstep = (size_t)HALF * K * 2;
    const size_t tstep = 2 * hstep;
    const unsigned ldsw = (unsigned)wid * 1024u;
    const int aoff = lds_byte(wr * 64 + fr, fq * 8), boff = lds_byte(wc * 32 + fr, fq * 8);
#define PG8_SA(b, h) (((b) * 2 + (h)) * HTB)
#define PG8_SB(b, h) ((4 + (b) * 2 + (h)) * HTB)
#define PG8_STAGE(bufoff, gbase, voff) do { _Pragma("unroll") for (int _i = 0; _i < 2; ++_i) \
        __builtin_amdgcn_global_load_lds((const unsigned*)((const char*)(gbase) + (voff)[_i]), (PG8_LAS unsigned*)(lds + (bufoff) + ldsw + _i * 8192), 16, 0, 0); } while (0)
#define PG8_LDA(dst, b, h) do { _Pragma("unroll") for (int m = 0; m < 4; ++m) _Pragma("unroll") for (int k = 0; k < 2; ++k) dst[m][k] = *(const PG8_LAS bf16x8*)(lds + PG8_SA(b, h) + aoff + m * 2048 + k * 1024); } while (0)
#define PG8_LDB(dst, b, h) do { _Pragma("unroll") for (int n = 0; n < 2; ++n) _Pragma("unroll") for (int k = 0; k < 2; ++k) dst[n][k] = *(const PG8_LAS bf16x8*)(lds + PG8_SB(b, h) + boff + n * 2048 + k * 1024); } while (0)
#define PG8_MMA(ai, bj, At, Bt) do { __builtin_amdgcn_s_setprio(1); _Pragma("unroll") for (int m = 0; m < 4; ++m) _Pragma("unroll") for (int n = 0; n < 2; ++n) _Pragma("unroll") for (int k = 0; k < 2; ++k) \
        acc[ai][bj][m][n] = __builtin_amdgcn_mfma_f32_16x16x32_bf16(Bt[n][k], At[m][k], acc[ai][bj][m][n], 0, 0, 0); __builtin_amdgcn_s_setprio(0); } while (0)
#define PG8_WAIT_V(n) asm volatile("s_waitcnt vmcnt(" #n ")" ::: "memory")
#define PG8_WAIT_L(n) asm volatile("s_waitcnt lgkmcnt(" #n ")" ::: "memory")
#define PG8_BAR __builtin_amdgcn_s_barrier()
#define PG8_SCHED __builtin_amdgcn_sched_barrier(0)
    Unit cur, nxt; int ui = 0; unsigned epre[4];
#pragma unroll
    for (int i = 0; i < 4; ++i) epre[i] = 0u;
    if (!S.next(0, cur)) return;
    f32x4 acc[2][2][4][2];
#pragma unroll
    for (int a = 0; a < 2; ++a)
#pragma unroll
        for (int b = 0; b < 2; ++b)
#pragma unroll
            for (int m = 0; m < 4; ++m)
#pragma unroll
                for (int n = 0; n < 2; ++n) acc[a][b][m][n] = (f32x4){0.f, 0.f, 0.f, 0.f};
    bf16x8 At[4][2], B0[2][2], B1[2][2];
    const char* cA = (const char*)g.A + (size_t)cur.pm * tstep; const char* cB = (const char*)g.Bt + (size_t)cur.pn * tstep;
    S.a_ready(cur);
    if constexpr (SP2) {
        PG8_STAGE(PG8_SB(0, 0), cB, voffB); PG8_STAGE(PG8_SB(0, 1), cB + hstep, voffB); PG8_STAGE(PG8_SA(0, 0), cA, voffA); PG8_STAGE(PG8_SA(0, 1), cA + hstep, voffA);
        if (wr == 1) PG8_BAR;
        PG8_WAIT_V(2); PG8_BAR;
        PG8_STAGE(PG8_SB(1, 0), cB + kstep, voffB); PG8_STAGE(PG8_SA(1, 0), cA + kstep, voffA); PG8_STAGE(PG8_SB(1, 1), cB + hstep + kstep, voffB);
        PG8_WAIT_V(6); PG8_BAR;
    } else {
        PG8_STAGE(PG8_SB(0, 0), cB, voffB); PG8_STAGE(PG8_SA(0, 0), cA, voffA); PG8_STAGE(PG8_SB(0, 1), cB + hstep, voffB); PG8_STAGE(PG8_SA(0, 1), cA + hstep, voffA);
        if (wr == 1) PG8_BAR;
        PG8_WAIT_V(4); PG8_BAR;
        PG8_STAGE(PG8_SB(1, 0), cB + kstep, voffB); PG8_STAGE(PG8_SA(1, 0), cA + kstep, voffA); PG8_STAGE(PG8_SB(1, 1), cB + hstep + kstep, voffB);
        PG8_WAIT_V(6); PG8_BAR;
    }
    for (;;) {
        const bool has_next = S.next(ui + 1, nxt);
        const char* nA = has_next ? (const char*)g.A + (size_t)nxt.pm * tstep : cA; const char* nB = has_next ? (const char*)g.Bt + (size_t)nxt.pn * tstep : cB;
        for (int t = 0; t < nt; t += 2) {
            const bool last = (t == nt - 2);
            const char* a1 = cA + (size_t)(t + 1) * kstep;
            const char* a2 = last ? nA : cA + (size_t)(t + 2) * kstep; const char* b2 = last ? nB : cB + (size_t)(t + 2) * kstep;
            const char* a3 = a2 + kstep; const char* b3 = b2 + kstep;
            if (last && has_next) S.a_ready(nxt);
            if (last) E.prefetch(epre, cur, wr, fr);
            if constexpr (SP2) {
            PG8_LDB(B0, 0, 0); PG8_LDB(B1, 0, 1); PG8_SCHED; PG8_LDA(At, 0, 0); PG8_STAGE(PG8_SA(1, 1), a1 + hstep, voffA);
            PG8_WAIT_V(8); PG8_WAIT_L(0); PG8_BAR; PG8_MMA(0, 0, At, B0); PG8_MMA(0, 1, At, B1); PG8_BAR; PG8_SCHED;
            PG8_LDA(At, 0, 1); PG8_STAGE(PG8_SB(0, 0), b2, voffB); PG8_STAGE(PG8_SB(0, 1), b2 + hstep, voffB); PG8_STAGE(PG8_SA(0, 0), a2, voffA);
            PG8_WAIT_V(8); PG8_WAIT_L(0); PG8_BAR; PG8_MMA(1, 0, At, B0); PG8_MMA(1, 1, At, B1); PG8_BAR; PG8_SCHED;
            PG8_LDB(B0, 1, 0); PG8_LDB(B1, 1, 1); PG8_SCHED; PG8_LDA(At, 1, 0); PG8_STAGE(PG8_SA(0, 1), a2 + hstep, voffA);
            PG8_WAIT_V(8); PG8_WAIT_L(0); PG8_BAR; PG8_MMA(0, 0, At, B0); PG8_MMA(0, 1, At, B1); PG8_BAR; PG8_SCHED;
            PG8_LDA(At, 1, 1); PG8_STAGE(PG8_SB(1, 0), b3, voffB); PG8_STAGE(PG8_SB(1, 1), b3 + hstep, voffB); PG8_STAGE(PG8_SA(1, 0), a3, voffA);
            PG8_WAIT_V(8); PG8_WAIT_L(0); PG8_BAR; PG8_MMA(1, 0, At, B0); PG8_MMA(1, 1, At, B1); PG8_BAR; PG8_SCHED;
            } else {
            PG8_LDB(B0, 0, 0); PG8_SCHED; PG8_LDA(At, 0, 0); PG8_STAGE(PG8_SA(1, 1), a1 + hstep, voffA);
            PG8_WAIT_L(8); PG8_BAR; PG8_WAIT_L(0); PG8_MMA(0, 0, At, B0); PG8_BAR; PG8_SCHED;
            PG8_LDB(B1, 0, 1); PG8_STAGE(PG8_SB(0, 0), b2, voffB);
            PG8_BAR; PG8_WAIT_L(0); PG8_MMA(0, 1, At, B1); PG8_BAR;
            PG8_LDA(At, 0, 1); PG8_STAGE(PG8_SA(0, 0), a2, voffA);
            PG8_BAR; PG8_WAIT_L(0); PG8_MMA(1, 0, At, B0); PG8_BAR; PG8_SCHED;
            PG8_STAGE(PG8_SB(0, 1), b2 + hstep, voffB);
            PG8_WAIT_V(6); PG8_BAR; PG8_MMA(1, 1, At, B1); PG8_BAR;
            PG8_LDB(B0, 1, 0); PG8_SCHED; PG8_LDA(At, 1, 0); PG8_STAGE(PG8_SA(0, 1), a2 + hstep, voffA);
            PG8_WAIT_L(8); PG8_BAR; PG8_WAIT_L(0); PG8_MMA(0, 0, At, B0); PG8_BAR; PG8_SCHED;
            PG8_LDB(B1, 1, 1); PG8_STAGE(PG8_SB(1, 0), b3, voffB);
            PG8_BAR; PG8_WAIT_L(0); PG8_MMA(0, 1, At, B1); PG8_BAR;
            PG8_LDA(At, 1, 1); PG8_STAGE(PG8_SA(1, 0), a3, voffA);
            PG8_BAR; PG8_WAIT_L(0); PG8_MMA(1, 0, At, B0); PG8_BAR; PG8_SCHED;
            PG8_STAGE(PG8_SB(1, 1), b3 + hstep, voffB);
            PG8_WAIT_V(6); PG8_BAR; PG8_MMA(1, 1, At, B1); PG8_BAR;
            }
        }
        if constexpr (ALIGN_EPI) { if (wr == 0) PG8_BAR; }
        if constexpr (!Epi::AFTER_DRAIN) { E(acc, cur, wr, wc, fr, fq, epre); S.done(cur); }
        if (!has_next) break;
#pragma unroll
        for (int a = 0; a < 2; ++a)
#pragma unroll
            for (int b = 0; b < 2; ++b)
#pragma unroll
                for (int m = 0; m < 4; ++m)
#pragma unroll
                    for (int n = 0; n < 2; ++n) acc[a][b][m][n] = (f32x4){0.f, 0.f, 0.f, 0.f};
        cur = nxt; cA = nA; cB = nB; ++ui;
        if constexpr (ALIGN_EPI) { if (wr == 1) PG8_BAR; }
    }
    PG8_WAIT_V(0);
    if constexpr (!ALIGN_EPI) { if (wr == 0) PG8_BAR; }
    PG8_BAR;
    if constexpr (Epi::AFTER_DRAIN) { E.fused(acc, cur, wr, wc, fr, fq, lds, wid, lane); S.done(cur); }
#undef PG8_SA
#undef PG8_SB
#undef PG8_STAGE
#undef PG8_LDA
#undef PG8_LDB
#undef PG8_MMA
#undef PG8_WAIT_V
#undef PG8_WAIT_L
#undef PG8_BAR
#undef PG8_SCHED
}
}

using pg8::bf16_t; using pg8::bf16x8; using pg8::f32x4; using pg8::u32x4;
#define LAS __attribute__((address_space(3)))
typedef short s16x4 __attribute__((ext_vector_type(4)));
typedef unsigned u32x2 __attribute__((ext_vector_type(2)));
constexpr int M_TOK = 81920, NP_ROWS = 16384, DM = 1024, DIN = 3072, DFF = 2816;
constexpr float RMS_EPS = 1e-6f, LOG2E = 1.4426950408889634f, QSCALE = 0.125f * 1.4426950408889634f;
constexpr size_t MiB = 1u << 20;
constexpr size_t WS_WIN = 0, WS_WOUT = 12 * MiB, WS_WGU = 16 * MiB, WS_WDN = 38 * MiB, WS_COS = 49 * MiB, WS_SIN = 50 * MiB, WS_RS = 51 * MiB,
                 WS_XB = 52 * MiB, WS_MIXED = 212 * MiB, WS_Y = 372 * MiB, WS_PROJ = 532 * MiB, WS_H = 532 * MiB, WS_CTL = 1012 * MiB, CTL_BYTES = 163840, WS_QCTR = WS_CTL + 16384, WS_CNT1 = WS_CTL + 65536, WS_X1 = 1013 * MiB, WS_END = 1015 * MiB;
constexpr size_t M64 = (size_t)M_TOK * 64;
constexpr size_t PB_QD = 0, PB_KD = 6 * M64, PB_VD = 12 * M64, PB_QN = 18 * M64, PB_KN = 22 * M64, PB_VN = 26 * M64, PB_CV = 30 * M64;
constexpr int DCV = 1152;
constexpr int LDS_BYTES = 147456;
constexpr int NWAVES = 8;

struct Params {
    const float *x_p, *x_s, *g_pre_mix, *w_in, *conv_w, *rpb, *w_out, *g_post_mix, *g_pre_ffn, *w_gate, *w_up, *w_down, *g_post_ffn;
    float* out; unsigned char* ws;
};

typedef float f32x2_t __attribute__((ext_vector_type(2)));
typedef __bf16 bf16x2_t __attribute__((ext_vector_type(2)));
__device__ __forceinline__ unsigned pk_bf16(float lo, float hi) { const f32x2_t v = {lo, hi}; const bf16x2_t b = __builtin_convertvector(v, bf16x2_t); return __builtin_bit_cast(unsigned, b); }
__device__ __forceinline__ float bf_lo(unsigned w) { return __uint_as_float(w << 16); }
__device__ __forceinline__ float bf_hi(unsigned w) { return __uint_as_float(w & 0xffff0000u); }
__device__ __forceinline__ float wave_sum(float v) {
#pragma unroll
    for (int o = 1; o < 64; o <<= 1) v += __shfl_xor(v, o);
    return v;
}
__device__ __forceinline__ void seq_of_row(int row, int& S, int& seq0) {
    if (row < NP_ROWS) { S = 2048; seq0 = row & ~2047; } else { S = 8192; seq0 = NP_ROWS + ((row - NP_ROWS) & ~8191); }
}

__device__ __forceinline__ int rs_idx(int row) { return (row & ~31) | ((row & 15) << 1) | ((row >> 4) & 1); }
__device__ __forceinline__ void rs_store(unsigned short* rsb, int row, float v) { rsb[rs_idx(row)] = (unsigned short)(pk_bf16(v, v) & 0xffffu); }
__device__ __forceinline__ void rs_prefetch(unsigned (&pre)[4], const unsigned short* rsb, int pm, int wr, int fr) {
    const unsigned* r32 = (const unsigned*)rsb;
#pragma unroll
    for (int i = 0; i < 4; ++i) pre[i] = r32[((pm * 256 + wr * 64 + (i >> 1) * 128 + (i & 1) * 32) >> 1) + fr];
}
__device__ __forceinline__ float rs_get(const unsigned (&pre)[4], int ai, int m) { const unsigned w = pre[ai * 2 + (m >> 1)]; return (m & 1) ? bf_hi(w) : bf_lo(w); }
struct EpiProj {
    static constexpr bool PERM = true, AFTER_DRAIN = false;
    bf16_t* O; const unsigned short* rs; const unsigned* cs;
    __device__ __forceinline__ void prefetch(unsigned (&pre)[4], const pg8::Unit& u, int wr, int fr) const { rs_prefetch(pre, rs, u.pm, wr, fr); }
    __device__ __forceinline__ void operator()(const f32x4 (&acc)[2][2][4][2], const pg8::Unit& u, int wr, int wc, int fr, int fq, const unsigned (&pre)[4]) const {
        const int row0 = u.pm * 256 + wr * 64 + fr;
        const int p4 = ((4 * wc + fq) & 7) * 4;
        const unsigned* __restrict__ cs = this->cs; bf16_t* __restrict__ O = this->O;
#pragma unroll
        for (int ai = 0; ai < 2; ++ai)
#pragma unroll
            for (int m = 0; m < 4; ++m) {
                if (m == 0 && ai == 1) asm volatile("" ::: "memory");
                const int row = row0 + ai * 128 + m * 16; const float r = rs_get(pre, ai, m);
                const int pos = row < NP_ROWS ? (row & 2047) : ((row - NP_ROWS) & 8191);
#pragma unroll
                for (int bj = 0; bj < 2; ++bj) {
                    const int cb = 2 * u.pn + bj;
                    bf16_t* dst;
                    if (cb < 15) { const int hl = wc >> 1; size_t tb; int head;
                        if (cb < 3) { tb = PB_QD; head = 2 * cb + hl; } else if (cb < 6) { tb = PB_KD; head = 2 * (cb - 3) + hl; } else if (cb < 9) { tb = PB_VD; head = 2 * (cb - 6) + hl; }
                        else if (cb < 11) { tb = PB_QN; head = 2 * (cb - 9) + hl; } else if (cb < 13) { tb = PB_KN; head = 2 * (cb - 11) + hl; } else { tb = PB_VN; head = 2 * (cb - 13) + hl; }
                        dst = O + tb + ((size_t)head * M_TOK + row) * 64 + 32 * (wc & 1) + 8 * fq;
                    } else dst = O + PB_CV + (size_t)row * DCV + 128 * (cb - 15) + 32 * wc + 8 * fq;
                    f32x4 v0 = acc[ai][bj][m][0] * r, v1 = acc[ai][bj][m][1] * r;
                    if (cb < 6) {
                        const u32x4 t4 = *(const u32x4*)(cs + pos * 32 + p4);
                        const f32x4 c4 = (f32x4){bf_lo(t4.x), bf_lo(t4.y), bf_lo(t4.z), bf_lo(t4.w)}, s4 = (f32x4){bf_hi(t4.x), bf_hi(t4.y), bf_hi(t4.z), bf_hi(t4.w)};
                        const f32x4 n0 = v0 * c4 - v1 * s4, n1 = v0 * s4 + v1 * c4; v0 = n0; v1 = n1;
                    }
                    if (cb < 3 || cb == 9 || cb == 10) { v0 = v0 * QSCALE; v1 = v1 * QSCALE; }
                    u32x4 w; w.x = pk_bf16(v0[0], v0[1]); w.y = pk_bf16(v0[2], v0[3]); w.z = pk_bf16(v1[0], v1[1]); w.w = pk_bf16(v1[2], v1[3]);
                    *(u32x4*)dst = w;
                }
            }
    }
};
struct EpiPlain {
    static constexpr bool PERM = true, AFTER_DRAIN = false;
    bf16_t* O; int ldc;
    __device__ __forceinline__ void prefetch(unsigned (&)[4], const pg8::Unit&, int, int) const {}
    __device__ __forceinline__ void operator()(const f32x4 (&acc)[2][2][4][2], const pg8::Unit& u, int wr, int wc, int fr, int fq, const unsigned (&)[4]) const {
        const int row0 = u.pm * 256 + wr * 64 + fr, col0 = u.pn * 256 + wc * 32 + 8 * fq;
#pragma unroll
        for (int ai = 0; ai < 2; ++ai)
#pragma unroll
            for (int m = 0; m < 4; ++m) {
                bf16_t* rowp = O + (size_t)(row0 + ai * 128 + m * 16) * ldc + col0;
#pragma unroll
                for (int bj = 0; bj < 2; ++bj) {
                    const f32x4 v0 = acc[ai][bj][m][0], v1 = acc[ai][bj][m][1];
                    u32x4 w; w.x = pk_bf16(v0[0], v0[1]); w.y = pk_bf16(v0[2], v0[3]); w.z = pk_bf16(v1[0], v1[1]); w.w = pk_bf16(v1[2], v1[3]);
                    *(u32x4*)(rowp + bj * 128) = w;
                }
            }
    }
};
__device__ __forceinline__ void row_exchange(float (&part)[8], float* xslots, unsigned* cnt, unsigned want, LAS unsigned char* lds, int pm, int pn, int wr, int wc, int fr, int fq) {
    LAS float* P = (LAS float*)(lds + 131072); LAS float* S = (LAS float*)(lds + 131072 + 4096);
    const int wid = wr * 4 + wc, lane = fq * 16 + fr;
#pragma unroll
    for (int i = 0; i < 8; ++i) { float s = part[i]; s += __shfl_xor(s, 16); s += __shfl_xor(s, 32); if (fq == 0) P[((i >> 2) * 128 + wr * 64 + (i & 3) * 16 + fr) * 4 + wc] = s; }
    asm volatile("s_waitcnt lgkmcnt(0)" ::: "memory"); __builtin_amdgcn_s_barrier(); asm volatile("" ::: "memory");
    const int row = wid * 32 + (lane & 31);
    if (lane < 32) { const float t = (P[row * 4 + 0] + P[row * 4 + 1]) + (P[row * 4 + 2] + P[row * 4 + 3]);
        __hip_atomic_store((unsigned*)xslots + (size_t)(pm * 256 + row) * 4 + pn, __float_as_uint(t), __ATOMIC_RELAXED, __HIP_MEMORY_SCOPE_AGENT); }
    asm volatile("s_waitcnt vmcnt(0)" ::: "memory");
    if (lane == 0) __hip_atomic_fetch_add(cnt + 64 * pm, 1u, __ATOMIC_RELAXED, __HIP_MEMORY_SCOPE_AGENT);
    if (wid == 0) {
        unsigned sp = 0;
        while ((unsigned)__builtin_amdgcn_readfirstlane(__hip_atomic_load(cnt + 64 * pm, __ATOMIC_RELAXED, __HIP_MEMORY_SCOPE_AGENT)) < want) { __builtin_amdgcn_s_sleep(1); if (++sp > (1u << 20)) break; }
        __builtin_amdgcn_fence(__ATOMIC_ACQUIRE, "agent");
    }
    asm volatile("s_waitcnt vmcnt(0) lgkmcnt(0)" ::: "memory"); __builtin_amdgcn_s_barrier(); asm volatile("" ::: "memory");
    if (lane < 32) { const unsigned* sl = (const unsigned*)xslots + (size_t)(pm * 256 + row) * 4; float tot = 0.f;
#pragma unroll
        for (int t = 0; t < 4; ++t) tot += __uint_as_float(__hip_atomic_load(sl + t, __ATOMIC_RELAXED, __HIP_MEMORY_SCOPE_AGENT));
        S[row] = 1.0f / sqrtf(tot * (1.0f / DM) + RMS_EPS); }
    asm volatile("s_waitcnt lgkmcnt(0)" ::: "memory"); __builtin_amdgcn_s_barrier(); asm volatile("" ::: "memory");
#pragma unroll
    for (int i = 0; i < 8; ++i) part[i] = S[(i >> 2) * 128 + wr * 64 + (i & 3) * 16 + fr];
}
struct EpiNormOut {
    static constexpr bool PERM = true, AFTER_DRAIN = false;
    unsigned char* ws; float* out; const float* g; LAS unsigned char* lds;
    __device__ __forceinline__ void prefetch(unsigned (&)[4], const pg8::Unit&, int, int) const {}
    __device__ __forceinline__ void operator()(f32x4 (&acc)[2][2][4][2], const pg8::Unit& u, int wr, int wc, int fr, int fq, const unsigned (&)[4]) const {
        const int row0 = u.pm * 256 + wr * 64 + fr, col0 = u.pn * 256 + wc * 32 + 8 * fq;
        const bf16_t* xb = (const bf16_t*)(ws + WS_XB);
        float part[8];
#pragma unroll
        for (int i = 0; i < 8; ++i) { float s = 0.f;
#pragma unroll
            for (int bj = 0; bj < 2; ++bj)
#pragma unroll
                for (int n = 0; n < 2; ++n) { const f32x4 v = acc[i >> 2][bj][i & 3][n]; s += (v[0] * v[0] + v[1] * v[1]) + (v[2] * v[2] + v[3] * v[3]); }
            part[i] = s; }
        row_exchange(part, (float*)(ws + WS_X1), (unsigned*)(ws + WS_CNT1), 32u, lds, u.pm, u.pn, wr, wc, fr, fq);
#pragma unroll
        for (int i = 0; i < 8; ++i) { const int ai = i >> 2, m = i & 3; const size_t off = (size_t)(row0 + ai * 128 + m * 16) * DM + col0; const float r = part[i];
#pragma unroll
            for (int bj = 0; bj < 2; ++bj) { const u32x4 xw = *(const u32x4*)(xb + off + bj * 128);
                const f32x4 g0 = *(const f32x4*)(g + col0 + bj * 128), g1 = *(const f32x4*)(g + col0 + bj * 128 + 4);
                const f32x4 v0 = (f32x4){bf_lo(xw.x), bf_hi(xw.x), bf_lo(xw.y), bf_hi(xw.y)} + acc[ai][bj][m][0] * r * g0;
                const f32x4 v1 = (f32x4){bf_lo(xw.z), bf_hi(xw.z), bf_lo(xw.w), bf_hi(xw.w)} + acc[ai][bj][m][1] * r * g1;
                float* orow = out + off + bj * 128; __builtin_nontemporal_store(v0, (f32x4*)orow); __builtin_nontemporal_store(v1, (f32x4*)(orow + 4)); }
            if (i & 1) asm volatile("" ::: "memory"); }
    }
};
__device__ __forceinline__ float silu_mul(float g, float u) { return g * __builtin_amdgcn_rcpf(1.0f + __builtin_amdgcn_exp2f(-g * LOG2E)) * u; }
struct EpiSwiglu {
    static constexpr bool PERM = true, AFTER_DRAIN = false;
    bf16_t* O; const unsigned short* rs;
    __device__ __forceinline__ void prefetch(unsigned (&pre)[4], const pg8::Unit& u, int wr, int fr) const { rs_prefetch(pre, rs, u.pm, wr, fr); }
    __device__ __forceinline__ void operator()(const f32x4 (&acc)[2][2][4][2], const pg8::Unit& u, int wr, int wc, int fr, int fq, const unsigned (&pre)[4]) const {
        const int row0 = u.pm * 256 + wr * 64 + fr, col0 = u.pn * 128 + wc * 32 + 8 * fq;
#pragma unroll
        for (int ai = 0; ai < 2; ++ai)
#pragma unroll
            for (int m = 0; m < 4; ++m) {
                const int row = row0 + ai * 128 + m * 16; const float r = rs_get(pre, ai, m);
                const f32x4 g0 = acc[ai][0][m][0] * r, g1 = acc[ai][0][m][1] * r, u0 = acc[ai][1][m][0] * r, u1 = acc[ai][1][m][1] * r;
                u32x4 w; w.x = pk_bf16(silu_mul(g0[0], u0[0]), silu_mul(g0[1], u0[1])); w.y = pk_bf16(silu_mul(g0[2], u0[2]), silu_mul(g0[3], u0[3]));
                w.z = pk_bf16(silu_mul(g1[0], u1[0]), silu_mul(g1[1], u1[1])); w.w = pk_bf16(silu_mul(g1[2], u1[2]), silu_mul(g1[3], u1[3]));
                *(u32x4*)(O + (size_t)row * DFF + col0) = w;
            }
    }
};

__device__ __forceinline__ void wt_item(const float* __restrict__ W, int ldw, int srccol, const float* __restrict__ gain, bf16_t* __restrict__ WT, int K, int n0, int k0, LAS float* scr, int lane) {
#pragma unroll 8
    for (int i = 0; i < 32; ++i) { const int kk = 2 * i + (lane >> 5); float v = W[(size_t)(k0 + kk) * ldw + srccol]; if (gain) v *= gain[k0 + kk]; scr[kk * 33 + (lane & 31)] = v; }
    asm volatile("s_waitcnt lgkmcnt(0)" ::: "memory");
    const int c = lane & 7;
#pragma unroll
    for (int j = 0; j < 4; ++j) { const int n = (lane >> 3) + 8 * j; const LAS float* s = scr + (8 * c) * 33 + n;
        u32x4 o; o.x = pk_bf16(s[0 * 33], s[1 * 33]); o.y = pk_bf16(s[2 * 33], s[3 * 33]); o.z = pk_bf16(s[4 * 33], s[5 * 33]); o.w = pk_bf16(s[6 * 33], s[7 * 33]);
        *(u32x4*)(WT + (size_t)(n0 + n) * K + k0 + 8 * c) = o; }
    asm volatile("s_waitcnt lgkmcnt(0)" ::: "memory");
}
__device__ __forceinline__ void prologue(const Params& p, LAS unsigned char* lds, int tid, int lane, int wave) {
    unsigned char* ws = p.ws;
    LAS float* scr = (LAS float*)(lds + wave * 16384);
    const int gw = blockIdx.x * NWAVES + wave, NGW = gridDim.x * NWAVES;
    constexpr int I_IN = 16 * 96, I_OUT = 16 * 32, I_GU = 16 * 176, I_DN = 44 * 32, I_L = I_IN + I_OUT + I_GU + I_DN;
    for (int it = gw; it < 2 * I_L; it += NGW) {
        const int l = it / I_L; int r = it - l * I_L; const int n = lane & 31;
        if (r < I_IN) { const int kb = r / 96, nb = r % 96, n0 = 32 * nb; const int ph = n0 + n; int src = ph;
            if (ph < 768) { const int fl = ph & 63; src = (ph & ~63) + 32 * ((fl >> 2) & 1) + 4 * (fl >> 3) + (fl & 3); }
            wt_item(p.w_in + (size_t)l * DM * DIN, DIN, src, p.g_pre_mix + l * DM, (bf16_t*)(ws + WS_WIN) + (size_t)l * DIN * DM, DM, n0, 64 * kb, scr, lane); continue; }
        r -= I_IN;
        if (r < I_OUT) { const int kb = r / 32, nb = r % 32, n0 = 32 * nb;
            wt_item(p.w_out + (size_t)l * DM * DM, DM, n0 + n, nullptr, (bf16_t*)(ws + WS_WOUT) + (size_t)l * DM * DM, DM, n0, 64 * kb, scr, lane); continue; }
        r -= I_OUT;
        if (r < I_GU) { const int kb = r / 176, nb = r % 176, n0 = 32 * nb, pn = n0 >> 8, cc = n0 & 255;
            const float* W = (cc < 128 ? p.w_gate : p.w_up) + (size_t)l * DM * DFF;
            wt_item(W, DFF, 128 * pn + (cc & 127) + n, p.g_pre_ffn + l * DM, (bf16_t*)(ws + WS_WGU) + (size_t)l * 2 * DFF * DM, DM, n0, 64 * kb, scr, lane); continue; }
        r -= I_GU;
        { const int kb = r / 32, nb = r % 32, n0 = 32 * nb;
            wt_item(p.w_down + (size_t)l * DFF * DM, DM, n0 + n, nullptr, (bf16_t*)(ws + WS_WDN) + (size_t)l * DM * DFF, DFF, n0, 64 * kb, scr, lane); }
    }
    { unsigned* cs = (unsigned*)(ws + WS_COS);
      for (int idx = blockIdx.x * 512 + tid; idx < 8192 * 32; idx += gridDim.x * 512) {
          const int pos = idx >> 5, i = idx & 31; double inv = 1.0; for (int k = 0; k < i; ++k) inv *= 0.7498942093324559;
          double rev = (double)pos * inv * 0.15915494309189535; rev -= __builtin_rint(rev);
          const float f = (float)rev; cs[idx] = pk_bf16(__builtin_amdgcn_cosf(f), __builtin_amdgcn_sinf(f)); } }
    { bf16_t* xb = (bf16_t*)(ws + WS_XB); unsigned short* rs = (unsigned short*)(ws + WS_RS);
      for (int row = gw; row < M_TOK; row += NGW) {
          const float* xr = row < NP_ROWS ? p.x_p + (size_t)row * DM : p.x_s + (size_t)(row - NP_ROWS) * DM;
          f32x4 v[4]; float ss = 0.f;
#pragma unroll
          for (int j = 0; j < 4; ++j) { v[j] = ((const f32x4*)xr)[64 * j + lane]; ss += (v[j][0] * v[j][0] + v[j][1] * v[j][1]) + (v[j][2] * v[j][2] + v[j][3] * v[j][3]); }
          ss = wave_sum(ss);
          u32x2* o8 = (u32x2*)(xb + (size_t)row * DM);
#pragma unroll
          for (int j = 0; j < 4; ++j) { u32x2 w; w.x = pk_bf16(v[j][0], v[j][1]); w.y = pk_bf16(v[j][2], v[j][3]); o8[64 * j + lane] = w; }
          if (lane == 0) rs_store(rs, row, 1.0f / sqrtf(ss * (1.0f / DM) + RMS_EPS));
      } }
}

template <bool FINAL>
__device__ __forceinline__ void ew_phase(const Params& p, const float* __restrict__ g, int lane, int wave) {
    unsigned char* ws = p.ws; const bf16_t* Y = (const bf16_t*)(ws + WS_Y); bf16_t* xb = (bf16_t*)(ws + WS_XB); unsigned short* rs = (unsigned short*)(ws + WS_RS);
    const int gw = blockIdx.x * NWAVES + wave, NGW = gridDim.x * NWAVES;
    f32x4 gv[4];
#pragma unroll
    for (int j = 0; j < 4; ++j) gv[j] = ((const f32x4*)g)[64 * j + lane];
    u32x2 yq[2][4], xq[2][4];
#pragma unroll
    for (int d = 0; d < 2; ++d) { int r0 = gw + d * NGW; r0 = r0 < M_TOK ? r0 : gw;
#pragma unroll
        for (int j = 0; j < 4; ++j) { yq[d][j] = ((const u32x2*)(Y + (size_t)r0 * DM))[64 * j + lane]; xq[d][j] = ((const u32x2*)(xb + (size_t)r0 * DM))[64 * j + lane]; } }
    for (int row = gw; row < M_TOK; row += NGW) {
        u32x2* xr = (u32x2*)(xb + (size_t)row * DM);
        u32x2 yc[4], xc[4];
#pragma unroll
        for (int j = 0; j < 4; ++j) { yc[j] = yq[0][j]; xc[j] = xq[0][j]; yq[0][j] = yq[1][j]; xq[0][j] = xq[1][j]; }
        { int r2 = row + 2 * NGW; r2 = r2 < M_TOK ? r2 : row;
#pragma unroll
          for (int j = 0; j < 4; ++j) { yq[1][j] = ((const u32x2*)(Y + (size_t)r2 * DM))[64 * j + lane]; xq[1][j] = ((const u32x2*)(xb + (size_t)r2 * DM))[64 * j + lane]; } }
        f32x4 xv[4], yf[4]; float ss = 0.f;
#pragma unroll
        for (int j = 0; j < 4; ++j) { const u32x2 w = yc[j], xw = xc[j];
            xv[j] = (f32x4){bf_lo(xw.x), bf_hi(xw.x), bf_lo(xw.y), bf_hi(xw.y)};
            yf[j] = (f32x4){bf_lo(w.x), bf_hi(w.x), bf_lo(w.y), bf_hi(w.y)}; ss += (yf[j][0] * yf[j][0] + yf[j][1] * yf[j][1]) + (yf[j][2] * yf[j][2] + yf[j][3] * yf[j][3]); }
        ss = wave_sum(ss); const float r = 1.0f / sqrtf(ss * (1.0f / DM) + RMS_EPS);
        float s2 = 0.f;
#pragma unroll
        for (int j = 0; j < 4; ++j) { const f32x4 xn = xv[j] + yf[j] * r * gv[j]; xv[j] = xn; s2 += (xn[0] * xn[0] + xn[1] * xn[1]) + (xn[2] * xn[2] + xn[3] * xn[3]); }
        if (FINAL) { float* orow = p.out + (size_t)row * DM;
#pragma unroll
            for (int j = 0; j < 4; ++j) ((f32x4*)orow)[64 * j + lane] = xv[j];
        } else {
            s2 = wave_sum(s2);
#pragma unroll
            for (int j = 0; j < 4; ++j) { u32x2 w; w.x = pk_bf16(xv[j][0], xv[j][1]); w.y = pk_bf16(xv[j][2], xv[j][3]); xr[64 * j + lane] = w; }
            if (lane == 0) rs_store(rs, row, 1.0f / sqrtf(s2 * (1.0f / DM) + RMS_EPS));
        }
    }
}

__device__ __forceinline__ bf16x8 ld8(const bf16_t* p) { return *(const bf16x8*)p; }
__device__ __forceinline__ void attn_store(bf16_t* orow, const f32x4 (&o)[4], float l, int fq) {
    l += __shfl_xor(l, 16); l += __shfl_xor(l, 32);
    const float inv = 1.0f / l;
#pragma unroll
    for (int c = 0; c < 4; ++c) { u32x2 w; w.x = pk_bf16(o[c][0] * inv, o[c][1] * inv); w.y = pk_bf16(o[c][2] * inv, o[c][3] * inv); *(u32x2*)(orow + 16 * c + 4 * fq) = w; }
}

struct PairRegs { bf16x8 k[2][2]; u32x4 v[2][2]; };

template <int NG> struct DilU { int seq0, L, r, u0, h; };
template <int D, int NG>
__device__ __forceinline__ DilU<NG> dilu_params(int item) {
    constexpr int CH = 16 * NG;
    DilU<NG> P; P.h = item % 6; const int cidx = item / 6, row0g = cidx * CH;
    int S; seq_of_row(row0g, S, P.seq0);
    constexpr int LG_CH = (CH == 16) ? 4 : (CH == 32) ? 5 : 6, LG_D = (D == 1) ? 0 : (D == 4) ? 2 : 4;
    const int lc = (row0g - P.seq0) >> LG_CH, lgLc = ((S == 2048) ? 11 : 13) - LG_D - LG_CH;
    P.L = S >> LG_D; P.r = lc >> lgLc; P.u0 = (lc & ((1 << lgLc) - 1)) << LG_CH;
    return P;
}
template <int D, int NG>
__device__ __forceinline__ void dilu_load(PairRegs& R, int p, const DilU<NG>& P, const bf16_t* proj, unsigned kofs, unsigned vofs) {
    const int rb = P.h * M_TOK + P.seq0 + P.r;
#pragma unroll
    for (int ab = 0; ab < 2; ++ab) {
        int x0 = P.u0 - 64 + 16 * (2 * p + ab); x0 = x0 < 0 ? 0 : (x0 > P.L - 16 ? P.L - 16 : x0);
        const size_t tb = (size_t)(rb + x0 * D) * 128;
        const char* kb = (const char*)(proj + PB_KD) + tb; const char* vb = (const char*)(proj + PB_VD) + tb;
        R.k[ab][0] = *(const bf16x8*)(kb + kofs); R.k[ab][1] = *(const bf16x8*)(kb + kofs + 64);
        R.v[ab][0] = *(const u32x4*)(vb + vofs); R.v[ab][1] = *(const u32x4*)(vb + vofs + 8 * D * 128);
    }
}
template <int D, int NG, int MODE, int PFD>
__device__ __forceinline__ void dilu_stream(const bf16_t* __restrict__ proj, bf16_t* __restrict__ mixed, bf16_t* __restrict__ ACC, float* __restrict__ LACC, LAS unsigned char* vst, unsigned* ctr, int xcd, int lane) {
    constexpr int NP = (NG + 9) / 2, NPV = ((NP + PFD - 1) / PFD) * PFD, CH = 16 * NG, NITEMS = (M_TOK / CH) * 6, PER = NITEMS / 8;
    static_assert(PFD - 1 <= NP, "ring prologue loads real pairs only");
#define DQ_TICKET(v) do { v = 0u; if (lane == 0) v = __hip_atomic_fetch_add(ctr, 1u, __ATOMIC_RELAXED, __HIP_MEMORY_SCOPE_AGENT); } while (0)
    const int base = xcd * PER;
    unsigned tk0, tk1; DQ_TICKET(tk0); DQ_TICKET(tk1);
    const int first = (int)__builtin_amdgcn_readfirstlane(tk0);
    if (first >= PER) return;
    int nxt = (int)__builtin_amdgcn_readfirstlane(tk1);
    const int fr = lane & 15, fq = lane >> 4, vr = lane >> 3, dlt = 4 * fq - fr;
    const unsigned kofs = (unsigned)((fr * D) * 128 + fq * 16), vofs = (unsigned)((vr * D) * 128 + (lane & 7) * 16);
    const unsigned wofs = vr * 160 + (lane & 7) * 16, trofs = (4 * fq + ((lane & 15) >> 2)) * 160 + (lane & 3) * 8;
    int it = base + first, par = 0;
    DilU<NG> P = dilu_params<D, NG>(it);
    PairRegs ring[PFD];
    bf16x8 q[NG][2];
#pragma unroll
    for (int g = 0; g < NG; ++g) { const bf16_t* qp = proj + PB_QD + (size_t)((P.h * M_TOK + P.seq0 + P.r + (P.u0 + 16 * g + fr) * D) * 64 + 8 * fq); q[g][0] = ld8(qp); q[g][1] = ld8(qp + 32); }
#pragma unroll
    for (int s = 0; s < PFD - 1; ++s) dilu_load<D, NG>(ring[s], s, P, proj, kofs, vofs);
    for (;;) {
        const bool has_next = nxt < PER; const int itn = base + nxt;
        unsigned tkn; DQ_TICKET(tkn);
        const DilU<NG> PN = dilu_params<D, NG>(has_next ? itn : it);
        bf16x8 qn[NG][2];
#pragma unroll
        for (int g = 0; g < NG; ++g) { const bf16_t* qp = proj + PB_QD + (size_t)((PN.h * M_TOK + PN.seq0 + PN.r + (PN.u0 + 16 * g + fr) * D) * 64 + 8 * fq); qn[g][0] = ld8(qp); qn[g][1] = ld8(qp + 32); }
        u32x2 pacc[NG][4]; float pl[NG];
        if (MODE != 0) {
#pragma unroll
            for (int g = 0; g < NG; ++g) { const int rowq = P.seq0 + P.r + (P.u0 + 16 * g + fr) * D; const bf16_t* ap = ACC + (size_t)(rowq * 6 + P.h) * 64 + 4 * fq;
#pragma unroll
                for (int c = 0; c < 4; ++c) pacc[g][c] = *(const u32x2*)(ap + 16 * c);
                pl[g] = LACC[rowq * 6 + P.h]; }
        }
        f32x4 o[NG][4]; float l[NG];
#pragma unroll
        for (int g = 0; g < NG; ++g) { l[g] = 0.f;
#pragma unroll
            for (int c = 0; c < 4; ++c) o[g][c] = (f32x4){0.f, 0.f, 0.f, 0.f}; }
#pragma unroll
        for (int p = 0; p < NPV; ++p) {
            const int m = p + PFD - 1;
            if (m < NPV) { if (m < NP) dilu_load<D, NG>(ring[m % PFD], m, P, proj, kofs, vofs); }
            else { if (m - NPV < NP) dilu_load<D, NG>(ring[m % PFD], m - NPV, PN, proj, kofs, vofs); }
            if (p >= NP) continue;
            const PairRegs& R = ring[p % PFD];
            LAS unsigned char* vbuf = vst + (((p & 1) ^ par) * 5120);
#pragma unroll
            for (int ab = 0; ab < 2; ++ab) { *(LAS u32x4*)(vbuf + ab * 2560 + wofs) = R.v[ab][0]; *(LAS u32x4*)(vbuf + ab * 2560 + wofs + 8 * 160) = R.v[ab][1]; }
            asm volatile("s_waitcnt lgkmcnt(0)" ::: "memory");
            bf16x8 vt[4];
#pragma unroll
            for (int c = 0; c < 4; ++c) {
                const s16x4 ta = __builtin_amdgcn_ds_read_tr16_b64_v4i16((LAS s16x4*)(vbuf + trofs + c * 32));
                const s16x4 tb = __builtin_amdgcn_ds_read_tr16_b64_v4i16((LAS s16x4*)(vbuf + 2560 + trofs + c * 32));
                vt[c] = (bf16x8){ta[0], ta[1], ta[2], ta[3], tb[0], tb[1], tb[2], tb[3]};
            }
            bool tok[2];
#pragma unroll
            for (int ab = 0; ab < 2; ++ab) { const int x0 = P.u0 - 64 + 16 * (2 * p + ab); tok[ab] = (x0 >= 0 && x0 < P.L); }
#pragma unroll
            for (int g = 0; g < NG; ++g) {
                const int dja = 2 * p - g, djb = 2 * p + 1 - g;
                const bool acta = dja >= 0 && dja <= 8, actb = djb >= 0 && djb <= 8;
                if (!acta && !actb) continue;
                f32x4 pr[2];
#pragma unroll
                for (int ab = 0; ab < 2; ++ab) {
                    const int dj = ab ? djb : dja; const bool act = ab ? actb : acta;
                    if (!act) { pr[ab] = (f32x4){0.f, 0.f, 0.f, 0.f}; continue; }
                    f32x4 s = {0.f, 0.f, 0.f, 0.f};
                    s = __builtin_amdgcn_mfma_f32_16x16x32_bf16(R.k[ab][0], q[g][0], s, 0, 0, 0);
                    s = __builtin_amdgcn_mfma_f32_16x16x32_bf16(R.k[ab][1], q[g][1], s, 0, 0, 0);
#pragma unroll
                    for (int e = 0; e < 4; ++e) {
                        float ex = __builtin_amdgcn_exp2f(s[e]);
                        bool ok = tok[ab];
                        if (dj == 0) ok = ok && (dlt + e >= 0);
                        if (dj == 8) ok = ok && (dlt + e <= 0);
                        ex = ok ? ex : 0.f;
                        pr[ab][e] = ex; l[g] += ex;
                    }
                }
                union { u32x4 u; bf16x8 h; } pp; pp.u.x = pk_bf16(pr[0][0], pr[0][1]); pp.u.y = pk_bf16(pr[0][2], pr[0][3]); pp.u.z = pk_bf16(pr[1][0], pr[1][1]); pp.u.w = pk_bf16(pr[1][2], pr[1][3]);
#pragma unroll
                for (int c = 0; c < 4; ++c) o[g][c] = __builtin_amdgcn_mfma_f32_16x16x32_bf16(vt[c], pp.h, o[g][c], 0, 0, 0);
            }
        }
#pragma unroll
        for (int g = 0; g < NG; ++g) {
            float lg = l[g]; lg += __shfl_xor(lg, 16); lg += __shfl_xor(lg, 32);
            const int rowq = P.seq0 + P.r + (P.u0 + 16 * g + fr) * D;
            bf16_t* ap = ACC + (size_t)(rowq * 6 + P.h) * 64 + 4 * fq; float* lp = LACC + rowq * 6 + P.h;
            if (MODE == 0) {
#pragma unroll
                for (int c = 0; c < 4; ++c) { u32x2 w; w.x = pk_bf16(o[g][c][0], o[g][c][1]); w.y = pk_bf16(o[g][c][2], o[g][c][3]); *(u32x2*)(ap + 16 * c) = w; }
                if (fq == 0) *lp = lg;
            } else if (MODE == 1) {
#pragma unroll
                for (int c = 0; c < 4; ++c) { const u32x2 pw = pacc[g][c]; const f32x4 t = (f32x4){bf_lo(pw.x), bf_hi(pw.x), bf_lo(pw.y), bf_hi(pw.y)} + o[g][c];
                    u32x2 w; w.x = pk_bf16(t[0], t[1]); w.y = pk_bf16(t[2], t[3]); *(u32x2*)(ap + 16 * c) = w; }
                if (fq == 0) *lp = pl[g] + lg;
            } else {
                const float inv = 1.0f / (pl[g] + lg);
                bf16_t* orow = mixed + (size_t)rowq * DM + P.h * 64 + 4 * fq;
#pragma unroll
                for (int c = 0; c < 4; ++c) { const u32x2 pw = pacc[g][c]; const f32x4 t = ((f32x4){bf_lo(pw.x), bf_hi(pw.x), bf_lo(pw.y), bf_hi(pw.y)} + o[g][c]) * inv; u32x2 w; w.x = pk_bf16(t[0], t[1]); w.y = pk_bf16(t[2], t[3]); *(u32x2*)(orow + 16 * c) = w; }
            }
        }
        if (!has_next) break;
        it = itn; nxt = (int)__builtin_amdgcn_readfirstlane(tkn); P = PN; par ^= (NP & 1);
#pragma unroll
        for (int g = 0; g < NG; ++g) { q[g][0] = qn[g][0]; q[g][1] = qn[g][1]; }
    }
}

#ifndef CFG_NG
#define CFG_NG 2
#define CFG_PF 2
#endif
#undef DQ_TICKET
struct Na2P { int kvrow; const bf16_t* qp; const LAS float* bb; int rs0, rows, kc0, qc, cs, orow, h, d1; };
__device__ __forceinline__ Na2P na2_params(const bf16_t* proj, const LAS float* tbl, int item, int lane) {
    Na2P P; const int fr = lane & 15, fq = lane >> 4;
    int S, t; if (item < 8 * 16 * 16) { S = 2048; t = item; } else { S = 8192; t = item - 8 * 16 * 16; }
    const int rows = S >> 6, per = (rows >> 1) * 16, seq = t / per, u = t - seq * per, rp = u >> 4, cb = u & 3; P.h = (u >> 2) & 3;
    const int seq0 = (S == 2048) ? seq * 2048 : NP_ROWS + seq * 8192, r = 2 * rp;
    int rs0 = r - 4; rs0 = rs0 < 0 ? 0 : (rs0 > rows - 8 ? rows - 8 : rs0);
    int rs1 = r - 3; rs1 = rs1 < 0 ? 0 : (rs1 > rows - 8 ? rows - 8 : rs1);
    P.rs0 = rs0; P.rows = rows; P.d1 = rs1 - rs0;
    int kc0 = 16 * cb - 8; kc0 = kc0 < 0 ? 0 : (kc0 > 32 ? 32 : kc0); P.kc0 = kc0;
    P.qc = 16 * cb + fr; int cs = P.qc - 8; cs = cs < 0 ? 0 : (cs > 48 ? 48 : cs); P.cs = cs;
    P.kvrow = P.h * M_TOK + seq0 + kc0;
    P.orow = seq0 + r * 64 + P.qc;
    P.qp = proj + PB_QN + ((size_t)P.h * M_TOK + P.orow) * 64 + 8 * fq;
    P.bb = tbl + P.h * 465 + (rs0 - r + 7) * 31;
    return P;
}
__device__ __forceinline__ void na2_load(PairRegs& R, int n, const Na2P& P, const bf16_t* proj, unsigned kofs, unsigned vofs) {
    int kr = P.rs0 + n; kr = kr > P.rows - 1 ? P.rows - 1 : kr;
#pragma unroll
    for (int hh = 0; hh < 2; ++hh) {
        const size_t tb = (size_t)(P.kvrow + kr * 64 + 16 * hh) * 128;
        const char* kb = (const char*)(proj + PB_KN) + tb; const char* vb = (const char*)(proj + PB_VN) + tb;
        R.k[hh][0] = *(const bf16x8*)(kb + kofs); R.k[hh][1] = *(const bf16x8*)(kb + kofs + 64);
        R.v[hh][0] = *(const u32x4*)(vb + vofs); R.v[hh][1] = *(const u32x4*)(vb + vofs + 8 * 128);
    }
}
template <int PFD>
__device__ __forceinline__ void na2_stream(const bf16_t* __restrict__ proj, bf16_t* __restrict__ mixed, LAS unsigned char* vst, const LAS float* tbl, int first, int stride, int lane) {
    constexpr int NP = 9, NPV = ((NP + PFD - 1) / PFD) * PFD, NITEMS = (M_TOK / 128) * 16;
    if (first >= NITEMS) return;
    const int fr = lane & 15, fq = lane >> 4, vr = lane >> 3;
    const unsigned kofs = (unsigned)(fr * 128 + fq * 16), vofs = (unsigned)(vr * 128 + (lane & 7) * 16);
    const unsigned wofs = vr * 160 + (lane & 7) * 16, trofs = (4 * fq + ((lane & 15) >> 2)) * 160 + (lane & 3) * 8;
    int it = first;
    Na2P P = na2_params(proj, tbl, it, lane);
    PairRegs ring[PFD];
    bf16x8 q[2][2];
#pragma unroll
    for (int g = 0; g < 2; ++g) { q[g][0] = ld8(P.qp + g * 4096); q[g][1] = ld8(P.qp + g * 4096 + 32); }
#pragma unroll
    for (int s = 0; s < PFD - 1; ++s) na2_load(ring[s], s, P, proj, kofs, vofs);
    for (;;) {
        const int itn = it + stride; const bool has_next = itn < NITEMS;
        const Na2P PN = na2_params(proj, tbl, has_next ? itn : it, lane);
        bf16x8 qn[2][2];
#pragma unroll
        for (int g = 0; g < 2; ++g) { qn[g][0] = ld8(PN.qp + g * 4096); qn[g][1] = ld8(PN.qp + g * 4096 + 32); }
        f32x4 o[2][4]; float l[2];
#pragma unroll
        for (int g = 0; g < 2; ++g) { l[g] = 0.f;
#pragma unroll
            for (int c = 0; c < 4; ++c) o[g][c] = (f32x4){0.f, 0.f, 0.f, 0.f}; }
#pragma unroll
        for (int p = 0; p < NPV; ++p) {
            const int m = p + PFD - 1;
            if (m < NPV) { if (m < NP) na2_load(ring[m % PFD], m, P, proj, kofs, vofs); }
            else { if (m - NPV < NP) na2_load(ring[m % PFD], m - NPV, PN, proj, kofs, vofs); }
            if (p >= NP) continue;
            const PairRegs& R = ring[p % PFD];
            LAS unsigned char* vbuf = vst + (p % 3) * 5120;
#pragma unroll
            for (int ab = 0; ab < 2; ++ab) { *(LAS u32x4*)(vbuf + ab * 2560 + wofs) = R.v[ab][0]; *(LAS u32x4*)(vbuf + ab * 2560 + wofs + 8 * 160) = R.v[ab][1]; }
            asm volatile("s_waitcnt lgkmcnt(0)" ::: "memory");
            bf16x8 vt[4];
#pragma unroll
            for (int c = 0; c < 4; ++c) {
                const s16x4 ta = __builtin_amdgcn_ds_read_tr16_b64_v4i16((LAS s16x4*)(vbuf + trofs + c * 32));
                const s16x4 tb = __builtin_amdgcn_ds_read_tr16_b64_v4i16((LAS s16x4*)(vbuf + 2560 + trofs + c * 32));
                vt[c] = (bf16x8){ta[0], ta[1], ta[2], ta[3], tb[0], tb[1], tb[2], tb[3]};
            }
#pragma unroll
            for (int g = 0; g < 2; ++g) {
                if (g == 0 && p == 8) continue;
                const bool act = (g == 0) ? true : (p == 0 ? P.d1 == 0 : (p == 8 ? P.d1 == 1 : true));
                const LAS float* brow = P.bb + (p - g) * 31;
                f32x4 pr[2];
#pragma unroll
                for (int hh = 0; hh < 2; ++hh) {
                    f32x4 s = {0.f, 0.f, 0.f, 0.f};
                    s = __builtin_amdgcn_mfma_f32_16x16x32_bf16(R.k[hh][0], q[g][0], s, 0, 0, 0);
                    s = __builtin_amdgcn_mfma_f32_16x16x32_bf16(R.k[hh][1], q[g][1], s, 0, 0, 0);
#pragma unroll
                    for (int e = 0; e < 4; ++e) { const int kc = P.kc0 + 16 * hh + 4 * fq + e; const bool valid = act && (kc >= P.cs) && (kc < P.cs + 16);
                        int dc = kc - P.qc + 15; dc = dc < 0 ? 0 : (dc > 30 ? 30 : dc);
                        const float ex = __builtin_amdgcn_exp2f(s[e] + brow[dc]); pr[hh][e] = valid ? ex : 0.f; l[g] += pr[hh][e]; }
                }
                union { u32x4 u; bf16x8 h; } pp; pp.u.x = pk_bf16(pr[0][0], pr[0][1]); pp.u.y = pk_bf16(pr[0][2], pr[0][3]); pp.u.z = pk_bf16(pr[1][0], pr[1][1]); pp.u.w = pk_bf16(pr[1][2], pr[1][3]);
#pragma unroll
                for (int c = 0; c < 4; ++c) o[g][c] = __builtin_amdgcn_mfma_f32_16x16x32_bf16(vt[c], pp.h, o[g][c], 0, 0, 0);
            }
        }
#pragma unroll
        for (int g = 0; g < 2; ++g) attn_store(mixed + (size_t)(P.orow + g * 64) * DM + 384 + P.h * 64, o[g], l[g], fq);
        if (!has_next) break;
        it = itn; P = PN;
#pragma unroll
        for (int g = 0; g < 2; ++g) { q[g][0] = qn[g][0]; q[g][1] = qn[g][1]; }
    }
}

constexpr int DIL_NG = CFG_NG, DIL_PF = CFG_PF;
__device__ __forceinline__ void mix_a(const Params& p, int layer, LAS unsigned char* lds, int tid, int lane, int wave) {
    unsigned char* ws = p.ws; const bf16_t* proj = (const bf16_t*)(ws + WS_PROJ); bf16_t* mixed = (bf16_t*)(ws + WS_MIXED);
    LAS float* tbl = (LAS float*)(lds + 131072);
    for (int i = tid; i < 4 * 465; i += 512) tbl[i] = p.rpb[layer * 4 * 465 + i] * LOG2E;
    __syncthreads();
    LAS unsigned char* vst = lds + wave * 16384;
    const int vcu = (gridDim.x % 8 == 0) ? (int)(blockIdx.x % 8) * (int)(gridDim.x / 8) + (int)(blockIdx.x / 8) : (int)blockIdx.x;
    const int gw = vcu * NWAVES + wave, NGW = gridDim.x * NWAVES;
    na2_stream<2>(proj, mixed, vst, tbl, gw, NGW, lane);
    dilu_stream<16, DIL_NG, 0, DIL_PF>(proj, mixed, (bf16_t*)(ws + WS_Y), (float*)(ws + WS_Y + 128 * MiB), vst, (unsigned*)(ws + WS_QCTR) + ((layer * 3 + 0) * 8 + (int)(blockIdx.x & 7)) * 64, (int)(blockIdx.x & 7), lane);
}
__device__ __forceinline__ void mix_b(const Params& p, int layer, LAS unsigned char* lds, int tid, int lane, int wave) {
    unsigned char* ws = p.ws; const bf16_t* proj = (const bf16_t*)(ws + WS_PROJ); bf16_t* mixed = (bf16_t*)(ws + WS_MIXED);
    LAS unsigned char* vst = lds + wave * 16384;
    const int vcu = (gridDim.x % 8 == 0) ? (int)(blockIdx.x % 8) * (int)(gridDim.x / 8) + (int)(blockIdx.x / 8) : (int)blockIdx.x;
    const int gw = vcu * NWAVES + wave, NGW = gridDim.x * NWAVES;
    const float* cw = p.conv_w + layer * 3 * 384;
    for (int idx = blockIdx.x * 512 + tid; idx < M_TOK * 48; idx += gridDim.x * 512) {
        const int row = idx / 48, c0 = (idx - row * 48) * 8;
        int S, seq0; seq_of_row(row, S, seq0); const int pos = row - seq0;
        const bf16_t* base = proj + PB_CV + (size_t)row * DCV + c0;
        const u32x4 gb = *(const u32x4*)base;
        float acc[8];
#pragma unroll
        for (int k = 0; k < 8; ++k) acc[k] = 0.f;
#pragma unroll
        for (int j = 0; j < 3; ++j) {
            const int pp = pos + j - 1;
            if (pp >= 0 && pp < S) {
                const bf16_t* bj = base + (ptrdiff_t)(j - 1) * DCV;
                const u32x4 gc = *(const u32x4*)(bj + 384), hi = *(const u32x4*)(bj + 768);
                const f32x4 w0 = *(const f32x4*)(cw + j * 384 + c0), w1 = *(const f32x4*)(cw + j * 384 + c0 + 4);
                acc[0] += w0[0] * bf_lo(gc.x) * bf_lo(hi.x); acc[1] += w0[1] * bf_hi(gc.x) * bf_hi(hi.x);
                acc[2] += w0[2] * bf_lo(gc.y) * bf_lo(hi.y); acc[3] += w0[3] * bf_hi(gc.y) * bf_hi(hi.y);
                acc[4] += w1[0] * bf_lo(gc.z) * bf_lo(hi.z); acc[5] += w1[1] * bf_hi(gc.z) * bf_hi(hi.z);
                acc[6] += w1[2] * bf_lo(gc.w) * bf_lo(hi.w); acc[7] += w1[3] * bf_hi(gc.w) * bf_hi(hi.w);
            }
        }
        u32x4 w; w.x = pk_bf16(acc[0] * bf_lo(gb.x), acc[1] * bf_hi(gb.x)); w.y = pk_bf16(acc[2] * bf_lo(gb.y), acc[3] * bf_hi(gb.y));
        w.z = pk_bf16(acc[4] * bf_lo(gb.z), acc[5] * bf_hi(gb.z)); w.w = pk_bf16(acc[6] * bf_lo(gb.w), acc[7] * bf_hi(gb.w));
        *(u32x4*)(mixed + (size_t)row * DM + 640 + c0) = w;
    }
    dilu_stream<4, DIL_NG, 1, DIL_PF>(proj, mixed, (bf16_t*)(ws + WS_Y), (float*)(ws + WS_Y + 128 * MiB), vst, (unsigned*)(ws + WS_QCTR) + ((layer * 3 + 1) * 8 + (int)(blockIdx.x & 7)) * 64, (int)(blockIdx.x & 7), lane);
}
__device__ __forceinline__ void mix_c(const Params& p, int layer, LAS unsigned char* lds, int lane, int wave) {
    unsigned char* ws = p.ws; const bf16_t* proj = (const bf16_t*)(ws + WS_PROJ); bf16_t* mixed = (bf16_t*)(ws + WS_MIXED);
    LAS unsigned char* vst = lds + wave * 16384;
    const int vcu = (gridDim.x % 8 == 0) ? (int)(blockIdx.x % 8) * (int)(gridDim.x / 8) + (int)(blockIdx.x / 8) : (int)blockIdx.x;
    const int gw = vcu * NWAVES + wave, NGW = gridDim.x * NWAVES;
    dilu_stream<1, DIL_NG, 2, DIL_PF>(proj, mixed, (bf16_t*)(ws + WS_Y), (float*)(ws + WS_Y + 128 * MiB), vst, (unsigned*)(ws + WS_QCTR) + ((layer * 3 + 2) * 8 + (int)(blockIdx.x & 7)) * 64, (int)(blockIdx.x & 7), lane);
}

#define XB_TMO      128
#define XB_XCNT(j)  (256  + 64 * (j))
#define XB_XSUB(j)  (1280 + 64 * (j))
#define XB_XGEN(j)  (2304 + 64 * (j))
#define XB_TOP      3328
#define XB_TOPGEN   3392
#define XCD_BAR_WORDS 3456
#define XB_SPIN_CAP (1u << 18)

__device__ __forceinline__ unsigned xb_ld(unsigned* p)              { return __hip_atomic_load(p, __ATOMIC_RELAXED, __HIP_MEMORY_SCOPE_AGENT); }
__device__ __forceinline__ unsigned xb_add(unsigned* p, unsigned v) { return __hip_atomic_fetch_add(p, v, __ATOMIC_RELAXED, __HIP_MEMORY_SCOPE_AGENT); }
__device__ __forceinline__ unsigned xb_xcc_id() { return (unsigned)__builtin_amdgcn_s_getreg((3 << 11) | 20) & 0xFu; }
#define XB_SPIN(cond, bar) do { unsigned _sp = 0; while (cond) { __builtin_amdgcn_s_sleep(1); \
    if ((++_sp & 255u) == 0u) { if (xb_ld(&(bar)[XB_TMO])) break; if (_sp > XB_SPIN_CAP) { atomicAdd(&(bar)[XB_TMO], 1u); break; } } } } while (0)

struct XcdBarrier {
    unsigned* bar; unsigned x;
    volatile LAS unsigned* st;
};

__device__ __forceinline__ XcdBarrier xcd_barrier_post(unsigned* bar, volatile LAS unsigned* st) {
    XcdBarrier b; b.bar = bar; b.x = xb_xcc_id(); b.st = st;
    if (threadIdx.x == 0) (void)xb_add(&bar[XB_XCNT(b.x)], 1u);
    return b;
}
__device__ __forceinline__ void xcd_barrier_complete(unsigned* bar, unsigned x, unsigned& nloc, unsigned& nx) {
    const unsigned G = gridDim.x * gridDim.y * gridDim.z;
    unsigned sum, cnt, mine, sp = 0u;
    for (;;) {
        sum = 0u; cnt = 0u; mine = 0u;
#pragma unroll
        for (unsigned j = 0; j < 16; ++j) { const unsigned c = xb_ld(&bar[XB_XCNT(j)]); sum += c; cnt += (c > 0u) ? 1u : 0u; mine = (j == x) ? c : mine; }
        if (sum == G) break;
        __builtin_amdgcn_s_sleep(1);
        if ((++sp & 255u) == 0u) { if (xb_ld(&bar[XB_TMO])) break; if (sp > XB_SPIN_CAP) { atomicAdd(&bar[XB_TMO], 1u); break; } }
    }
    nloc = mine > 0u ? mine : 1u; nx = cnt > 0u ? cnt : 1u;
}

__device__ __forceinline__ void xcd_barrier(const XcdBarrier& b) {
    asm volatile("s_waitcnt vmcnt(0)" ::: "memory");
    __syncthreads();
    if (threadIdx.x == 0) {
        unsigned* bar = b.bar;
        __builtin_amdgcn_s_waitcnt(0);
        unsigned nloc = b.st[0], nx = b.st[1];
        if (nloc == 0u) { xcd_barrier_complete(bar, b.x, nloc, nx); b.st[0] = nloc; b.st[1] = nx; }
        const unsigned old = xb_add(&bar[XB_XSUB(b.x)], 1u);
        const unsigned gen = old / nloc;
        if (old + 1u == (gen + 1u) * nloc) {
            __builtin_amdgcn_fence(__ATOMIC_RELEASE, "agent");
            asm volatile("s_waitcnt vmcnt(0)" ::: "memory");
            const unsigned og = xb_add(&bar[XB_TOP], 1u);
            const unsigned tg = og / nx;
            if (og + 1u == (tg + 1u) * nx) xb_add(&bar[XB_TOPGEN], 1u);
            else XB_SPIN(xb_ld(&bar[XB_TOPGEN]) == tg, bar);
            __builtin_amdgcn_fence(__ATOMIC_ACQUIRE, "agent");
            xb_add(&bar[XB_XGEN(b.x)], 1u);
            asm volatile("s_waitcnt vmcnt(0)" ::: "memory");
        } else {
            XB_SPIN(xb_ld(&bar[XB_XGEN(b.x)]) == gen, bar);
            __builtin_amdgcn_fence(__ATOMIC_ACQUIRE, "agent");
            asm volatile("s_waitcnt vmcnt(0)" ::: "memory");
        }
    }
    __syncthreads();
}

__global__ void __launch_bounds__(512) fwd_mega(Params p) {
    extern __shared__ __attribute__((aligned(16))) unsigned char lds_raw[];
    LAS unsigned char* lds = (LAS unsigned char*)lds_raw;
    cg::grid_group grid = cg::this_grid();
    unsigned char* ws = p.ws;
#define FRESH_TID() int tid = threadIdx.x; asm volatile("" : "+v"(tid)); const int lane = tid & 63, wave = __builtin_amdgcn_readfirstlane(tid >> 6)
    bf16_t* xb = (bf16_t*)(ws + WS_XB); bf16_t* proj = (bf16_t*)(ws + WS_PROJ); bf16_t* mixed = (bf16_t*)(ws + WS_MIXED); bf16_t* Y = (bf16_t*)(ws + WS_Y); bf16_t* H = (bf16_t*)(ws + WS_H);
    const unsigned short* rs = (const unsigned short*)(ws + WS_RS);

    if (threadIdx.x < 4) ((volatile LAS unsigned*)(lds + 139264))[threadIdx.x] = 0u;
    __syncthreads();
    const XcdBarrier xbar = xcd_barrier_post((unsigned*)(ws + WS_CTL), (volatile LAS unsigned*)(lds + 139264));
    { FRESH_TID(); prologue(p, lds, tid, lane, wave); }
    grid.sync();
    for (int layer = 0; layer < 2; ++layer) {
        {
            pg8::Gemm g{xb, (const bf16_t*)(ws + WS_WIN) + (size_t)layer * DIN * DM, M_TOK, DIN, DM}; pg8::StaticOrder S; S.init(M_TOK, DIN, (int)gridDim.x, (int)blockIdx.x);
            EpiProj E{proj, rs, (const unsigned*)(ws + WS_COS)};
            pg8::gemm_phase<EpiProj, pg8::StaticOrder>(lds, g, S, E);
        }
        xcd_barrier(xbar);
        { FRESH_TID(); mix_a(p, layer, lds, tid, lane, wave); }
        xcd_barrier(xbar);
        { FRESH_TID(); mix_b(p, layer, lds, tid, lane, wave); }
        xcd_barrier(xbar);
        { FRESH_TID(); (void)tid; mix_c(p, layer, lds, lane, wave); }
        xcd_barrier(xbar);
        {
            pg8::Gemm g{mixed, (const bf16_t*)(ws + WS_WOUT) + (size_t)layer * DM * DM, M_TOK, DM, DM}; pg8::StaticOrder S; S.init(M_TOK, DM, (int)gridDim.x, (int)blockIdx.x);
            EpiPlain E{Y, DM};
            pg8::gemm_phase<EpiPlain, pg8::StaticOrder>(lds, g, S, E);
        }
        xcd_barrier(xbar);
        { FRESH_TID(); (void)tid; ew_phase<false>(p, p.g_post_mix + layer * DM, lane, wave); }
        xcd_barrier(xbar);
        {
            pg8::Gemm g{xb, (const bf16_t*)(ws + WS_WGU) + (size_t)layer * 2 * DFF * DM, M_TOK, 2 * DFF, DM}; pg8::StaticOrder S; S.init(M_TOK, 2 * DFF, (int)gridDim.x, (int)blockIdx.x);
            EpiSwiglu E{H, rs};
            pg8::gemm_phase<EpiSwiglu, pg8::StaticOrder>(lds, g, S, E);
        }
        xcd_barrier(xbar);
        {
            pg8::Gemm g{H, (const bf16_t*)(ws + WS_WDN) + (size_t)layer * DM * DFF, M_TOK, DM, DFF}; pg8::StaticOrder S; S.init(M_TOK, DM, (int)gridDim.x, (int)blockIdx.x);
            if (layer == 0) { EpiPlain E{Y, DM}; pg8::gemm_phase<EpiPlain, pg8::StaticOrder>(lds, g, S, E); }
            else { EpiNormOut E{ws, p.out, p.g_post_ffn + layer * DM, lds}; pg8::gemm_phase<EpiNormOut, pg8::StaticOrder>(lds, g, S, E); }
        }
        if (layer == 0) { xcd_barrier(xbar); { FRESH_TID(); (void)tid; ew_phase<false>(p, p.g_post_ffn + layer * DM, lane, wave); } xcd_barrier(xbar); }
    }
}

extern "C" void kernel_launch(void* const* d_in, const int* in_sizes, int n_in, void* d_out, int out_size, void* d_ws, size_t ws_size, hipStream_t stream) {
    static int grid_blocks = 0;
    if (!grid_blocks) {
        if (n_in != 13 || out_size != M_TOK * DM || ws_size < WS_END) { fprintf(stderr, "kernel_launch: unexpected sizes (n_in %d out %d ws %zu)\n", n_in, out_size, ws_size); grid_blocks = -1; return; }
        int dev = 0, cus = 0, per_cu = 0;
        hipGetDevice(&dev); hipDeviceGetAttribute(&cus, hipDeviceAttributeMultiprocessorCount, dev);
        hipFuncSetAttribute((const void*)fwd_mega, hipFuncAttributeMaxDynamicSharedMemorySize, LDS_BYTES);
        hipOccupancyMaxActiveBlocksPerMultiprocessor(&per_cu, (const void*)fwd_mega, 512, LDS_BYTES);
        if (per_cu < 1) { fprintf(stderr, "kernel_launch: occupancy query says %d blocks per CU\n", per_cu); per_cu = 1; }
        (void)hipGetLastError();
        grid_blocks = cus * per_cu;
    }
    if (grid_blocks < 0) return;
    Params p{};
    p.x_p = (const float*)d_in[0]; p.x_s = (const float*)d_in[1]; p.g_pre_mix = (const float*)d_in[2]; p.w_in = (const float*)d_in[3]; p.conv_w = (const float*)d_in[4];
    p.rpb = (const float*)d_in[5]; p.w_out = (const float*)d_in[6]; p.g_post_mix = (const float*)d_in[7]; p.g_pre_ffn = (const float*)d_in[8]; p.w_gate = (const float*)d_in[9];
    p.w_up = (const float*)d_in[10]; p.w_down = (const float*)d_in[11]; p.g_post_ffn = (const float*)d_in[12]; p.out = (float*)d_out; p.ws = (unsigned char*)d_ws;
    if (hipMemsetAsync((char*)d_ws + WS_CTL, 0, CTL_BYTES, stream) != hipSuccess) { fprintf(stderr, "kernel_launch: memset of the barrier words failed\n"); return; }
    void* args[] = {&p};
    hipError_t e = hipLaunchCooperativeKernel((const void*)fwd_mega, dim3(grid_blocks), dim3(512), args, LDS_BYTES, stream);
    if (e != hipSuccess) fprintf(stderr, "cooperative launch failed: %s (grid %d)\n", hipGetErrorString(e), grid_blocks);
}
```

```cpp
#include <hip/hip_runtime.h>
#include <hip/hip_cooperative_groups.h>
#include <cstdio>
namespace cg = cooperative_groups;
namespace pg8 {
#define PG8_LAS __attribute__((address_space(3)))
typedef unsigned short bf16_t;
typedef short bf16x8 __attribute__((ext_vector_type(8)));
typedef float f32x4 __attribute__((ext_vector_type(4)));
typedef unsigned u32x4 __attribute__((ext_vector_type(4)));
constexpr int BM = 256, BK = 64, HALF = 128, HTB = HALF * BK * 2  , STAGE_BYTES = 8 * HTB, NXCD = 8, WGM = 8;

__host__ __device__ __forceinline__ int lds_byte(int r, int c) { const int st = (r >> 4) * 2 + (c >> 5), rr = r & 15, cc = c & 31, ob = rr * 64 + cc * 2; return st * 1024 + (ob ^ (((ob >> 9) & 1) << 5)); }
__host__ __device__ __forceinline__ void stage_rc(int b, int& R, int& C) { const int st = b / 1024, sb = b % 1024, swz = sb ^ (((sb >> 9) & 1) << 5); R = (st >> 1) * 16 + swz / 64; C = (st & 1) * 32 + (swz % 64) / 2; }
__host__ __device__ __forceinline__ int perm32(int rho) { const int n = rho >> 4, i = rho & 15; return 8 * (i >> 2) + 4 * n + (i & 3); }

struct Unit { int pm, pn; };
struct Gemm { const bf16_t* A; const bf16_t* Bt; int M, N, K; };

struct StaticOrder {
    int nM, nN, nwg, G, c;
    __host__ __device__ void init(int M, int N, int G_, int c_) { nM = M / BM; nN = N / BM; nwg = nM * nN; G = G_; c = c_; }
    __host__ __device__ bool next(int i, Unit& u) const {
        const long L = (long)i * G + c; if (L >= nwg) return false;
        int wgid = (int)L; { const int q = nwg / NXCD, r = nwg % NXCD, xcd = wgid % NXCD, off = wgid / NXCD; wgid = (xcd < r ? xcd * (q + 1) : r * (q + 1) + (xcd - r) * q) + off; }
        const int nig = WGM * nN, gid = wgid / nig, fm = gid * WGM, gsz = (nM - fm) < WGM ? (nM - fm) : WGM;
        u.pm = fm + ((wgid % nig) % gsz); u.pn = (wgid % nig) / gsz; return true;
    }
    __device__ __forceinline__ void a_ready(const Unit&) const {}
    __device__ __forceinline__ void done(const Unit&) const {}
};
typedef float f32x2 __attribute__((ext_vector_type(2)));
template <class Epi, class Sched, bool ALIGN_EPI = true, bool SP2 = true>
__device__ __forceinline__ void gemm_phase(PG8_LAS unsigned char* lds, const Gemm g, const Sched& S, const Epi& E) {
    int tid_ = threadIdx.x; asm volatile("" : "+v"(tid_));
    const int tid = tid_, wid = __builtin_amdgcn_readfirstlane(tid >> 6), lane = tid & 63, wr = wid >> 2, wc = wid & 3, fr = lane & 15, fq = lane >> 4;
    const int K = g.K, nt = K / BK;
    unsigned voffA[2], voffB[2];
#pragma unroll
    for (int i = 0; i < 2; ++i) { int R, C; stage_rc(tid * 16 + i * 8192, R, C); const int Rb = Epi::PERM ? ((R & ~31) + perm32(R & 31)) : R;
        voffA[i] = (unsigned)(R * K + C) * 2u; voffB[i] = (unsigned)(Rb * K + C) * 2u; }
    const size_t kstep = (size_t)(BK * 2);
    const size_t hstep = (size_t)HALF * K * 2;
    const size_t tstep = 2 * hstep;
    const unsigned ldsw = (unsigned)wid * 1024u;
    const int aoff = lds_byte(wr * 64 + fr, fq * 8), boff = lds_byte(wc * 32 + fr, fq * 8);
#define PG8_SA(b, h) (((b) * 2 + (h)) * HTB)
#define PG8_SB(b, h) ((4 + (b) * 2 + (h)) * HTB)
#define PG8_STAGE(bufoff, gbase, voff) do { _Pragma("unroll") for (int _i = 0; _i < 2; ++_i) \
        __builtin_amdgcn_global_load_lds((const unsigned*)((const char*)(gbase) + (voff)[_i]), (PG8_LAS unsigned*)(lds + (bufoff) + ldsw + _i * 8192), 16, 0, 0); } while (0)
#define PG8_LDA(dst, b, h) do { _Pragma("unroll") for (int m = 0; m < 4; ++m) _Pragma("unroll") for (int k = 0; k < 2; ++k) dst[m][k] = *(const PG8_LAS bf16x8*)(lds + PG8_SA(b, h) + aoff + m * 2048 + k * 1024); } while (0)
#define PG8_LDB(dst, b, h) do { _Pragma("unroll") for (int n = 0; n < 2; ++n) _Pragma("unroll") for (int k = 0; k < 2; ++k) dst[n][k] = *(const PG8_LAS bf16x8*)(lds + PG8_SB(b, h) + boff + n * 2048 + k * 1024); } while (0)
#define PG8_MMA(ai, bj, At, Bt) do { __builtin_amdgcn_s_setprio(1); _Pragma("unroll") for (int m = 0; m < 4; ++m) _Pragma("unroll") for (int n = 0; n < 2; ++n) _Pragma("unroll") for (int k = 0; k < 2; ++k) \
        acc[ai][bj][m][n] = __builtin_amdgcn_mfma_f32_16x16x32_bf16(Bt[n][k], At[m][k], acc[ai][bj][m][n], 0, 0, 0); __builtin_amdgcn_s_setprio(0); } while (0)
#define PG8_WAIT_V(n) asm volatile("s_waitcnt vmcnt(" #n ")" ::: "memory")
#define PG8_WAIT_L(n) asm volatile("s_waitcnt lgkmcnt(" #n ")" ::: "memory")
#define PG8_BAR __builtin_amdgcn_s_barrier()
#define PG8_SCHED __builtin_amdgcn_sched_barrier(0)
    Unit cur, nxt; int ui = 0; unsigned epre[4];
#pragma unroll
    for (int i = 0; i < 4; ++i) epre[i] = 0u;
    if (!S.next(0, cur)) return;
    f32x4 acc[2][2][4][2];
#pragma unroll
    for (int a = 0; a < 2; ++a)
#pragma unroll
        for (int b = 0; b < 2; ++b)
#pragma unroll
            for (int m = 0; m < 4; ++m)
#pragma unroll
                for (int n = 0; n < 2; ++n) acc[a][b][m][n] = (f32x4){0.f, 0.f, 0.f, 0.f};
    bf16x8 At[4][2], B0[2][2], B1[2][2];
    const char* cA = (const char*)g.A + (size_t)cur.pm * tstep; const char* cB = (const char*)g.Bt + (size_t)cur.pn * tstep;
    S.a_ready(cur);
    if constexpr (SP2) {
        PG8_STAGE(PG8_SB(0, 0), cB, voffB); PG8_STAGE(PG8_SB(0, 1), cB + hstep, voffB); PG8_STAGE(PG8_SA(0, 0), cA, voffA); PG8_STAGE(PG8_SA(0, 1), cA + hstep, voffA);
        if (wr == 1) PG8_BAR;
        PG8_WAIT_V(2); PG8_BAR;
        PG8_STAGE(PG8_SB(1, 0), cB + kstep, voffB); PG8_STAGE(PG8_SA(1, 0), cA + kstep, voffA); PG8_STAGE(PG8_SB(1, 1), cB + hstep + kstep, voffB);
        PG8_WAIT_V(6); PG8_BAR;
    } else {
        PG8_STAGE(PG8_SB(0, 0), cB, voffB); PG8_STAGE(PG8_SA(0, 0), cA, voffA); PG8_STAGE(PG8_SB(0, 1), cB + hstep, voffB); PG8_STAGE(PG8_SA(0, 1), cA + hstep, voffA);
        if (wr == 1) PG8_BAR;
        PG8_WAIT_V(4); PG8_BAR;
        PG8_STAGE(PG8_SB(1, 0), cB + kstep, voffB); PG8_STAGE(PG8_SA(1, 0), cA + kstep, voffA); PG8_STAGE(PG8_SB(1, 1), cB + hstep + kstep, voffB);
        PG8_WAIT_V(6); PG8_BAR;
    }
    for (;;) {
        const bool has_next = S.next(ui + 1, nxt);
        const char* nA = has_next ? (const char*)g.A + (size_t)nxt.pm * tstep : cA; const char* nB = has_next ? (const char*)g.Bt + (size_t)nxt.pn * tstep : cB;
        for (int t = 0; t < nt; t += 2) {
            const bool last = (t == nt - 2);
            const char* a1 = cA + (size_t)(t + 1) * kstep;
            const char* a2 = last ? nA : cA + (size_t)(t + 2) * kstep; const char* b2 = last ? nB : cB + (size_t)(t + 2) * kstep;
            const char* a3 = a2 + kstep; const char* b3 = b2 + kstep;
            if (last && has_next) S.a_ready(nxt);
            if (last) E.prefetch(epre, cur, wr, fr);
            if constexpr (SP2) {
            PG8_LDB(B0, 0, 0); PG8_LDB(B1, 0, 1); PG8_SCHED; PG8_LDA(At, 0, 0); PG8_STAGE(PG8_SA(1, 1), a1 + hstep, voffA);
            PG8_WAIT_V(8); PG8_WAIT_L(0); PG8_BAR; PG8_MMA(0, 0, At, B0); PG8_MMA(0, 1, At, B1); PG8_BAR; PG8_SCHED;
            PG8_LDA(At, 0, 1); PG8_STAGE(PG8_SB(0, 0), b2, voffB); PG8_STAGE(PG8_SB(0, 1), b2 + hstep, voffB); PG8_STAGE(PG8_SA(0, 0), a2, voffA);
            PG8_WAIT_V(8); PG8_WAIT_L(0); PG8_BAR; PG8_MMA(1, 0, At, B0); PG8_MMA(1, 1, At, B1); PG8_BAR; PG8_SCHED;
            PG8_LDB(B0, 1, 0); PG8_LDB(B1, 1, 1); PG8_SCHED; PG8_LDA(At, 1, 0); PG8_STAGE(PG8_SA(0, 1), a2 + hstep, voffA);
            PG8_WAIT_V(8); PG8_WAIT_L(0); PG8_BAR; PG8_MMA(0, 0, At, B0); PG8_MMA(0, 1, At, B1); PG8_BAR; PG8_SCHED;
            PG8_LDA(At, 1, 1); PG8_STAGE(PG8_SB(1, 0), b3, voffB); PG8_STAGE(PG8_SB(1, 1), b3 + hstep, voffB); PG8_STAGE(PG8_SA(1, 0), a3, voffA);
            PG8_WAIT_V(8); PG8_WAIT_L(0); PG8_BAR; PG8_MMA(1, 0, At, B0); PG8_MMA(1, 1, At, B1); PG8_BAR; PG8_SCHED;
            } else {
            PG8_LDB(B0, 0, 0); PG8_SCHED; PG8_LDA(At, 0, 0); PG8_STAGE(PG8_SA(1, 1), a1 + hstep, voffA);
            PG8_WAIT_L(8); PG8_BAR; PG8_WAIT_L(0); PG8_MMA(0, 0, At, B0); PG8_BAR; PG8_SCHED;
            PG8_LDB(B1, 0, 1); PG8_STAGE(PG8_SB(0, 0), b2, voffB);
            PG8_BAR; PG8_WAIT_L(0); PG8_MMA(0, 1, At, B1); PG8_BAR;
            PG8_LDA(At, 0, 1); PG8_STAGE(PG8_SA(0, 0), a2, voffA);
            PG8_BAR; PG8_WAIT_L(0); PG8_MMA(1, 0, At, B0); PG8_BAR; PG8_SCHED;
            PG8_STAGE(PG8_SB(0, 1), b2 + hstep, voffB);
            PG8_WAIT_V(6); PG8_BAR; PG8_MMA(1, 1, At, B1); PG8_BAR;
            PG8_LDB(B0, 1, 0); PG8_SCHED; PG8_LDA(At, 1, 0); PG8_STAGE(PG8_SA(0, 1), a2 + hstep, voffA);
            PG8_WAIT_L(8); PG8_BAR; PG8_WAIT_L(0); PG8_MMA(0, 0, At, B0); PG8_BAR; PG8_SCHED;
            PG8_LDB(B1, 1, 1); PG8_STAGE(PG8_SB(1, 0), b3, voffB);
            PG8_BAR; PG8_WAIT_L(0); PG8_MMA(0, 1, At, B1); PG8_BAR;
            PG8_LDA(At, 1, 1); PG8_STAGE(PG8_SA(1, 0), a3, voffA);
            PG8_BAR; PG8_WAIT_L(0); PG8_MMA(1, 0, At, B0); PG8_BAR; PG8_SCHED;
            PG8_STAGE(PG8_SB(1, 1), b3 + hstep, voffB);
            PG8_WAIT_V(6); PG8_BAR; PG8_MMA(1, 1, At, B1); PG8_BAR;
            }
        }
        if constexpr (ALIGN_EPI) { if (wr == 0) PG8_BAR; }
        if constexpr (!Epi::AFTER_DRAIN) { E(acc, cur, wr, wc, fr, fq, epre); S.done(cur); }
        if (!has_next) break;
#pragma unroll
        for (int a = 0; a < 2; ++a)
#pragma unroll
            for (int b = 0; b < 2; ++b)
#pragma unroll
                for (int m = 0; m < 4; ++m)
#pragma unroll
                    for (int n = 0; n < 2; ++n) acc[a][b][m][n] = (f32x4){0.f, 0.f, 0.f, 0.f};
        cur = nxt; cA = nA; cB = nB; ++ui;
        if constexpr (ALIGN_EPI) { if (wr == 1) PG8_BAR; }
    }
    PG8_WAIT_V(0);
    if constexpr (!ALIGN_EPI) { if (wr == 0) PG8_BAR; }
    PG8_BAR;
    if constexpr (Epi::AFTER_DRAIN) { E.fused(acc, cur, wr, wc, fr, fq, lds, wid, lane); S.done(cur); }
#undef PG8_SA
#undef PG8_SB
#undef PG8_STAGE
#undef PG8_LDA
#undef PG8_LDB
#undef PG8_MMA
#undef PG8_WAIT_V
#undef PG8_WAIT_L
#undef PG8_BAR
#undef PG8_SCHED
}
}

using pg8::bf16_t; using pg8::bf16x8; using pg8::f32x4; using pg8::u32x4;
#define LAS __attribute__((address_space(3)))
typedef short s16x4 __attribute__((ext_vector_type(4)));
typedef unsigned u32x2 __attribute__((ext_vector_type(2)));
constexpr int M_TOK = 81920, NP_ROWS = 16384, DM = 1024, DIN = 3072, DFF = 2816;
constexpr float RMS_EPS = 1e-6f, LOG2E = 1.4426950408889634f, QSCALE = 0.125f * 1.4426950408889634f;
constexpr size_t MiB = 1u << 20;
constexpr size_t WS_WIN = 0, WS_WOUT = 12 * MiB, WS_WGU = 16 * MiB, WS_WDN = 38 * MiB, WS_COS = 49 * MiB, WS_SIN = 50 * MiB, WS_RS = 51 * MiB,
                 WS_XB = 52 * MiB, WS_MIXED = 212 * MiB, WS_Y = 372 * MiB, WS_PROJ = 532 * MiB, WS_H = 532 * MiB, WS_CTL = 1012 * MiB, CTL_BYTES = 163840, WS_QCTR = WS_CTL + 16384, WS_CNT1 = WS_CTL + 65536, WS_X1 = 1013 * MiB, WS_END = 1015 * MiB;
constexpr size_t M64 = (size_t)M_TOK * 64;
constexpr size_t PB_QD = 0, PB_KD = 6 * M64, PB_VD = 12 * M64, PB_QN = 18 * M64, PB_KN = 22 * M64, PB_VN = 26 * M64, PB_CV = 30 * M64;
constexpr int DCV = 1152;
constexpr int LDS_BYTES = 147456;
constexpr int NWAVES = 8;

struct Params {
    const float *x_p, *x_s, *g_pre_mix, *w_in, *conv_w, *rpb, *w_out, *g_post_mix, *g_pre_ffn, *w_gate, *w_up, *w_down, *g_post_ffn;
    float* out; unsigned char* ws;
};

typedef float f32x2_t __attribute__((ext_vector_type(2)));
typedef __bf16 bf16x2_t __attribute__((ext_vector_type(2)));
__device__ __forceinline__ unsigned pk_bf16(float lo, float hi) { const f32x2_t v = {lo, hi}; const bf16x2_t b = __builtin_convertvector(v, bf16x2_t); return __builtin_bit_cast(unsigned, b); }
__device__ __forceinline__ float bf_lo(unsigned w) { return __uint_as_float(w << 16); }
__device__ __forceinline__ float bf_hi(unsigned w) { return __uint_as_float(w & 0xffff0000u); }
__device__ __forceinline__ float wave_sum(float v) {
#pragma unroll
    for (int o = 1; o < 64; o <<= 1) v += __shfl_xor(v, o);
    return v;
}
__device__ __forceinline__ void seq_of_row(int row, int& S, int& seq0) {
    if (row < NP_ROWS) { S = 2048; seq0 = row & ~2047; } else { S = 8192; seq0 = NP_ROWS + ((row - NP_ROWS) & ~8191); }
}

__device__ __forceinline__ int rs_idx(int row) { return (row & ~31) | ((row & 15) << 1) | ((row >> 4) & 1); }
__device__ __forceinline__ void rs_store(unsigned short* rsb, int row, float v) { rsb[rs_idx(row)] = (unsigned short)(pk_bf16(v, v) & 0xffffu); }
__device__ __forceinline__ void rs_prefetch(unsigned (&pre)[4], const unsigned short* rsb, int pm, int wr, int fr) {
    const unsigned* r32 = (const unsigned*)rsb;
#pragma unroll
    for (int i = 0; i < 4; ++i) pre[i] = r32[((pm * 256 + wr * 64 + (i >> 1) * 128 + (i & 1) * 32) >> 1) + fr];
}
__device__ __forceinline__ float rs_get(const unsigned (&pre)[4], int ai, int m) { const unsigned w = pre[ai * 2 + (m >> 1)]; return (m & 1) ? bf_hi(w) : bf_lo(w); }
struct EpiProj {
    static constexpr bool PERM = true, AFTER_DRAIN = false;
    bf16_t* O; const unsigned short* rs; const unsigned* cs;
    __device__ __forceinline__ void prefetch(unsigned (&pre)[4], const pg8::Unit& u, int wr, int fr) const { rs_prefetch(pre, rs, u.pm, wr, fr); }
    __device__ __forceinline__ void operator()(const f32x4 (&acc)[2][2][4][2], const pg8::Unit& u, int wr, int wc, int fr, int fq, const unsigned (&pre)[4]) const {
        const int row0 = u.pm * 256 + wr * 64 + fr;
        const int p4 = ((4 * wc + fq) & 7) * 4;
        const unsigned* __restrict__ cs = this->cs; bf16_t* __restrict__ O = this->O;
#pragma unroll
        for (int ai = 0; ai < 2; ++ai)
#pragma unroll
            for (int m = 0; m < 4; ++m) {
                if (m == 0 && ai == 1) asm volatile("" ::: "memory");
                const int row = row0 + ai * 128 + m * 16; const float r = rs_get(pre, ai, m);
                const int pos = row < NP_ROWS ? (row & 2047) : ((row - NP_ROWS) & 8191);
#pragma unroll
                for (int bj = 0; bj < 2; ++bj) {
                    const int cb = 2 * u.pn + bj;
                    bf16_t* dst;
                    if (cb < 15) { const int hl = wc >> 1; size_t tb; int head;
                        if (cb < 3) { tb = PB_QD; head = 2 * cb + hl; } else if (cb < 6) { tb = PB_KD; head = 2 * (cb - 3) + hl; } else if (cb < 9) { tb = PB_VD; head = 2 * (cb - 6) + hl; }
                        else if (cb < 11) { tb = PB_QN; head = 2 * (cb - 9) + hl; } else if (cb < 13) { tb = PB_KN; head = 2 * (cb - 11) + hl; } else { tb = PB_VN; head = 2 * (cb - 13) + hl; }
                        dst = O + tb + ((size_t)head * M_TOK + row) * 64 + 32 * (wc & 1) + 8 * fq;
                    } else dst = O + PB_CV + (size_t)row * DCV + 128 * (cb - 15) + 32 * wc + 8 * fq;
                    f32x4 v0 = acc[ai][bj][m][0] * r, v1 = acc[ai][bj][m][1] * r;
                    if (cb < 6) {
                        const u32x4 t4 = *(const u32x4*)(cs + pos * 32 + p4);
                        const f32x4 c4 = (f32x4){bf_lo(t4.x), bf_lo(t4.y), bf_lo(t4.z), bf_lo(t4.w)}, s4 = (f32x4){bf_hi(t4.x), bf_hi(t4.y), bf_hi(t4.z), bf_hi(t4.w)};
                        const f32x4 n0 = v0 * c4 - v1 * s4, n1 = v0 * s4 + v1 * c4; v0 = n0; v1 = n1;
                    }
                    if (cb < 3 || cb == 9 || cb == 10) { v0 = v0 * QSCALE; v1 = v1 * QSCALE; }
                    u32x4 w; w.x = pk_bf16(v0[0], v0[1]); w.y = pk_bf16(v0[2], v0[3]); w.z = pk_bf16(v1[0], v1[1]); w.w = pk_bf16(v1[2], v1[3]);
                    *(u32x4*)dst = w;
                }
            }
    }
};
struct EpiPlain {
    static constexpr bool PERM = true, AFTER_DRAIN = false;
    bf16_t* O; int ldc;
    __device__ __forceinline__ void prefetch(unsigned (&)[4], const pg8::Unit&, int, int) const {}
    __device__ __forceinline__ void operator()(const f32x4 (&acc)[2][2][4][2], const pg8::Unit& u, int wr, int wc, int fr, int fq, const unsigned (&)[4]) const {
        const int row0 = u.pm * 256 + wr * 64 + fr, col0 = u.pn * 256 + wc * 32 + 8 * fq;
#pragma unroll
        for (int ai = 0; ai < 2; ++ai)
#pragma unroll
            for (int m = 0; m < 4; ++m) {
                bf16_t* rowp = O + (size_t)(row0 + ai * 128 + m * 16) * ldc + col0;
#pragma unroll
                for (int bj = 0; bj < 2; ++bj) {
                    const f32x4 v0 = acc[ai][bj][m][0], v1 = acc[ai][bj][m][1];
                    u32x4 w; w.x = pk_bf16(v0[0], v0[1]); w.y = pk_bf16(v0[2], v0[3]); w.z = pk_bf16(v1[0], v1[1]); w.w = pk_bf16(v1[2], v1[3]);
                    *(u32x4*)(rowp + bj * 128) = w;
                }
            }
    }
};
__device__ __forceinline__ void row_exchange(float (&part)[8], float* xslots, unsigned* cnt, unsigned want, LAS unsigned char* lds, int pm, int pn, int wr, int wc, int fr, int fq) {
    LAS float* P = (LAS float*)(lds + 131072); LAS float* S = (LAS float*)(lds + 131072 + 4096);
    const int wid = wr * 4 + wc, lane = fq * 16 + fr;
#pragma unroll
    for (int i = 0; i < 8; ++i) { float s = part[i]; s += __shfl_xor(s, 16); s += __shfl_xor(s, 32); if (fq == 0) P[((i >> 2) * 128 + wr * 64 + (i & 3) * 16 + fr) * 4 + wc] = s; }
    asm volatile("s_waitcnt lgkmcnt(0)" ::: "memory"); __builtin_amdgcn_s_barrier(); asm volatile("" ::: "memory");
    const int row = wid * 32 + (lane & 31);
    if (lane < 32) { const float t = (P[row * 4 + 0] + P[row * 4 + 1]) + (P[row * 4 + 2] + P[row * 4 + 3]);
        __hip_atomic_store((unsigned*)xslots + (size_t)(pm * 256 + row) * 4 + pn, __float_as_uint(t), __ATOMIC_RELAXED, __HIP_MEMORY_SCOPE_AGENT); }
    asm volatile("s_waitcnt vmcnt(0)" ::: "memory");
    if (lane == 0) __hip_atomic_fetch_add(cnt + 64 * pm, 1u, __ATOMIC_RELAXED, __HIP_MEMORY_SCOPE_AGENT);
    if (wid == 0) {
        unsigned sp = 0;
        while ((unsigned)__builtin_amdgcn_readfirstlane(__hip_atomic_load(cnt + 64 * pm, __ATOMIC_RELAXED, __HIP_MEMORY_SCOPE_AGENT)) < want) { __builtin_amdgcn_s_sleep(1); if (++sp > (1u << 20)) break; }
        __builtin_amdgcn_fence(__ATOMIC_ACQUIRE, "agent");
    }
    asm volatile("s_waitcnt vmcnt(0) lgkmcnt(0)" ::: "memory"); __builtin_amdgcn_s_barrier(); asm volatile("" ::: "memory");
    if (lane < 32) { const unsigned* sl = (const unsigned*)xslots + (size_t)(pm * 256 + row) * 4; float tot = 0.f;
#pragma unroll
        for (int t = 0; t < 4; ++t) tot += __uint_as_float(__hip_atomic_load(sl + t, __ATOMIC_RELAXED, __HIP_MEMORY_SCOPE_AGENT));
        S[row] = 1.0f / sqrtf(tot * (1.0f / DM) + RMS_EPS); }
    asm volatile("s_waitcnt lgkmcnt(0)" ::: "memory"); __builtin_amdgcn_s_barrier(); asm volatile("" ::: "memory");
#pragma unroll
    for (int i = 0; i < 8; ++i) part[i] = S[(i >> 2) * 128 + wr * 64 + (i & 3) * 16 + fr];
}
struct EpiNormOut {
    static constexpr bool PERM = true, AFTER_DRAIN = false;
    unsigned char* ws; float* out; const float* g; LAS unsigned char* lds;
    __device__ __forceinline__ void prefetch(unsigned (&)[4], const pg8::Unit&, int, int) const {}
    __device__ __forceinline__ void operator()(f32x4 (&acc)[2][2][4][2], const pg8::Unit& u, int wr, int wc, int fr, int fq, const unsigned (&)[4]) const {
        const int row0 = u.pm * 256 + wr * 64 + fr, col0 = u.pn * 256 + wc * 32 + 8 * fq;
        const bf16_t* xb = (const bf16_t*)(ws + WS_XB);
        float part[8];
#pragma unroll
        for (int i = 0; i < 8; ++i) { float s = 0.f;
#pragma unroll
            for (int bj = 0; bj < 2; ++bj)
#pragma unroll
                for (int n = 0; n < 2; ++n) { const f32x4 v = acc[i >> 2][bj][i & 3][n]; s += (v[0] * v[0] + v[1] * v[1]) + (v[2] * v[2] + v[3] * v[3]); }
            part[i] = s; }
        row_exchange(part, (float*)(ws + WS_X1), (unsigned*)(ws + WS_CNT1), 32u, lds, u.pm, u.pn, wr, wc, fr, fq);
#pragma unroll
        for (int i = 0; i < 8; ++i) { const int ai = i >> 2, m = i & 3; const size_t off = (size_t)(row0 + ai * 128 + m * 16) * DM + col0; const float r = part[i];
#pragma unroll
            for (int bj = 0; bj < 2; ++bj) { const u32x4 xw = *(const u32x4*)(xb + off + bj * 128);
                const f32x4 g0 = *(const f32x4*)(g + col0 + bj * 128), g1 = *(const f32x4*)(g + col0 + bj * 128 + 4);
                const f32x4 v0 = (f32x4){bf_lo(xw.x), bf_hi(xw.x), bf_lo(xw.y), bf_hi(xw.y)} + acc[ai][bj][m][0] * r * g0;
                const f32x4 v1 = (f32x4){bf_lo(xw.z), bf_hi(xw.z), bf_lo(xw.w), bf_hi(xw.w)} + acc[ai][bj][m][1] * r * g1;
                float* orow = out + off + bj * 128; __builtin_nontemporal_store(v0, (f32x4*)orow); __builtin_nontemporal_store(v1, (f32x4*)(orow + 4)); }
            if ((i & 3) == 3) asm volatile("" ::: "memory"); }
    }
};
__device__ __forceinline__ float silu_mul(float g, float u) { return g * __builtin_amdgcn_rcpf(1.0f + __builtin_amdgcn_exp2f(-g * LOG2E)) * u; }
struct EpiSwiglu {
    static constexpr bool PERM = true, AFTER_DRAIN = false;
    bf16_t* O; const unsigned short* rs;
    __device__ __forceinline__ void prefetch(unsigned (&pre)[4], const pg8::Unit& u, int wr, int fr) const { rs_prefetch(pre, rs, u.pm, wr, fr); }
    __device__ __forceinline__ void operator()(const f32x4 (&acc)[2][2][4][2], const pg8::Unit& u, int wr, int wc, int fr, int fq, const unsigned (&pre)[4]) const {
        const int row0 = u.pm * 256 + wr * 64 + fr, col0 = u.pn * 128 + wc * 32 + 8 * fq;
#pragma unroll
        for (int ai = 0; ai < 2; ++ai)
#pragma unroll
            for (int m = 0; m < 4; ++m) {
                const int row = row0 + ai * 128 + m * 16; const float r = rs_get(pre, ai, m);
                const f32x4 g0 = acc[ai][0][m][0] * r, g1 = acc[ai][0][m][1] * r, u0 = acc[ai][1][m][0] * r, u1 = acc[ai][1][m][1] * r;
                u32x4 w; w.x = pk_bf16(silu_mul(g0[0], u0[0]), silu_mul(g0[1], u0[1])); w.y = pk_bf16(silu_mul(g0[2], u0[2]), silu_mul(g0[3], u0[3]));
                w.z = pk_bf16(silu_mul(g1[0], u1[0]), silu_mul(g1[1], u1[1])); w.w = pk_bf16(silu_mul(g1[2], u1[2]), silu_mul(g1[3], u1[3]));
                *(u32x4*)(O + (size_t)row * DFF + col0) = w;
            }
    }
};

__device__ __forceinline__ void wt_item(const float* __restrict__ W, int ldw, int srccol, const float* __restrict__ gain, bf16_t* __restrict__ WT, int K, int n0, int k0, LAS float* scr, int lane) {
#pragma unroll 8
    for (int i = 0; i < 32; ++i) { const int kk = 2 * i + (lane >> 5); float v = W[(size_t)(k0 + kk) * ldw + srccol]; if (gain) v *= gain[k0 + kk]; scr[kk * 33 + (lane & 31)] = v; }
    asm volatile("s_waitcnt lgkmcnt(0)" ::: "memory");
    const int c = lane & 7;
#pragma unroll
    for (int j = 0; j < 4; ++j) { const int n = (lane >> 3) + 8 * j; const LAS float* s = scr + (8 * c) * 33 + n;
        u32x4 o; o.x = pk_bf16(s[0 * 33], s[1 * 33]); o.y = pk_bf16(s[2 * 33], s[3 * 33]); o.z = pk_bf16(s[4 * 33], s[5 * 33]); o.w = pk_bf16(s[6 * 33], s[7 * 33]);
        *(u32x4*)(WT + (size_t)(n0 + n) * K + k0 + 8 * c) = o; }
    asm volatile("s_waitcnt lgkmcnt(0)" ::: "memory");
}
__device__ __forceinline__ void prologue(const Params& p, LAS unsigned char* lds, int tid, int lane, int wave) {
    unsigned char* ws = p.ws;
    LAS float* scr = (LAS float*)(lds + wave * 16384);
    const int gw = blockIdx.x * NWAVES + wave, NGW = gridDim.x * NWAVES;
    constexpr int I_IN = 16 * 96, I_OUT = 16 * 32, I_GU = 16 * 176, I_DN = 44 * 32, I_L = I_IN + I_OUT + I_GU + I_DN;
    for (int it = gw; it < 2 * I_L; it += NGW) {
        const int l = it / I_L; int r = it - l * I_L; const int n = lane & 31;
        if (r < I_IN) { const int kb = r / 96, nb = r % 96, n0 = 32 * nb; const int ph = n0 + n; int src = ph;
            if (ph < 768) { const int fl = ph & 63; src = (ph & ~63) + 32 * ((fl >> 2) & 1) + 4 * (fl >> 3) + (fl & 3); }
            wt_item(p.w_in + (size_t)l * DM * DIN, DIN, src, p.g_pre_mix + l * DM, (bf16_t*)(ws + WS_WIN) + (size_t)l * DIN * DM, DM, n0, 64 * kb, scr, lane); continue; }
        r -= I_IN;
        if (r < I_OUT) { const int kb = r / 32, nb = r % 32, n0 = 32 * nb;
            wt_item(p.w_out + (size_t)l * DM * DM, DM, n0 + n, nullptr, (bf16_t*)(ws + WS_WOUT) + (size_t)l * DM * DM, DM, n0, 64 * kb, scr, lane); continue; }
        r -= I_OUT;
        if (r < I_GU) { const int kb = r / 176, nb = r % 176, n0 = 32 * nb, pn = n0 >> 8, cc = n0 & 255;
            const float* W = (cc < 128 ? p.w_gate : p.w_up) + (size_t)l * DM * DFF;
            wt_item(W, DFF, 128 * pn + (cc & 127) + n, p.g_pre_ffn + l * DM, (bf16_t*)(ws + WS_WGU) + (size_t)l * 2 * DFF * DM, DM, n0, 64 * kb, scr, lane); continue; }
        r -= I_GU;
        { const int kb = r / 32, nb = r % 32, n0 = 32 * nb;
            wt_item(p.w_down + (size_t)l * DFF * DM, DM, n0 + n, nullptr, (bf16_t*)(ws + WS_WDN) + (size_t)l * DM * DFF, DFF, n0, 64 * kb, scr, lane); }
    }
    { unsigned* cs = (unsigned*)(ws + WS_COS);
      for (int idx = blockIdx.x * 512 + tid; idx < 8192 * 32; idx += gridDim.x * 512) {
          const int pos = idx >> 5, i = idx & 31; double inv = 1.0; for (int k = 0; k < i; ++k) inv *= 0.7498942093324559;
          double rev = (double)pos * inv * 0.15915494309189535; rev -= __builtin_rint(rev);
          const float f = (float)rev; cs[idx] = pk_bf16(__builtin_amdgcn_cosf(f), __builtin_amdgcn_sinf(f)); } }
    { bf16_t* xb = (bf16_t*)(ws + WS_XB); unsigned short* rs = (unsigned short*)(ws + WS_RS);
      for (int row = gw; row < M_TOK; row += NGW) {
          const float* xr = row < NP_ROWS ? p.x_p + (size_t)row * DM : p.x_s + (size_t)(row - NP_ROWS) * DM;
          f32x4 v[4]; float ss = 0.f;
#pragma unroll
          for (int j = 0; j < 4; ++j) { v[j] = ((const f32x4*)xr)[64 * j + lane]; ss += (v[j][0] * v[j][0] + v[j][1] * v[j][1]) + (v[j][2] * v[j][2] + v[j][3] * v[j][3]); }
          ss = wave_sum(ss);
          u32x2* o8 = (u32x2*)(xb + (size_t)row * DM);
#pragma unroll
          for (int j = 0; j < 4; ++j) { u32x2 w; w.x = pk_bf16(v[j][0], v[j][1]); w.y = pk_bf16(v[j][2], v[j][3]); o8[64 * j + lane] = w; }
          if (lane == 0) rs_store(rs, row, 1.0f / sqrtf(ss * (1.0f / DM) + RMS_EPS));
      } }
}

template <bool FINAL>
__device__ __forceinline__ void ew_phase(const Params& p, const float* __restrict__ g, int lane, int wave) {
    unsigned char* ws = p.ws; const bf16_t* Y = (const bf16_t*)(ws + WS_Y); bf16_t* xb = (bf16_t*)(ws + WS_XB); unsigned short* rs = (unsigned short*)(ws + WS_RS);
    const int gw = blockIdx.x * NWAVES + wave, NGW = gridDim.x * NWAVES;
    f32x4 gv[4];
#pragma unroll
    for (int j = 0; j < 4; ++j) gv[j] = ((const f32x4*)g)[64 * j + lane];
    u32x2 yq[2][4], xq[2][4];
#pragma unroll
    for (int d = 0; d < 2; ++d) { int r0 = gw + d * NGW; r0 = r0 < M_TOK ? r0 : gw;
#pragma unroll
        for (int j = 0; j < 4; ++j) { yq[d][j] = ((const u32x2*)(Y + (size_t)r0 * DM))[64 * j + lane]; xq[d][j] = ((const u32x2*)(xb + (size_t)r0 * DM))[64 * j + lane]; } }
    for (int row = gw; row < M_TOK; row += NGW) {
        u32x2* xr = (u32x2*)(xb + (size_t)row * DM);
        u32x2 yc[4], xc[4];
#pragma unroll
        for (int j = 0; j < 4; ++j) { yc[j] = yq[0][j]; xc[j] = xq[0][j]; yq[0][j] = yq[1][j]; xq[0][j] = xq[1][j]; }
        { int r2 = row + 2 * NGW; r2 = r2 < M_TOK ? r2 : row;
#pragma unroll
          for (int j = 0; j < 4; ++j) { yq[1][j] = ((const u32x2*)(Y + (size_t)r2 * DM))[64 * j + lane]; xq[1][j] = ((const u32x2*)(xb + (size_t)r2 * DM))[64 * j + lane]; } }
        f32x4 xv[4], yf[4]; float ss = 0.f;
#pragma unroll
        for (int j = 0; j < 4; ++j) { const u32x2 w = yc[j], xw = xc[j];
            xv[j] = (f32x4){bf_lo(xw.x), bf_hi(xw.x), bf_lo(xw.y), bf_hi(xw.y)};
            yf[j] = (f32x4){bf_lo(w.x), bf_hi(w.x), bf_lo(w.y), bf_hi(w.y)}; ss += (yf[j][0] * yf[j][0] + yf[j][1] * yf[j][1]) + (yf[j][2] * yf[j][2] + yf[j][3] * yf[j][3]); }
        ss = wave_sum(ss); const float r = 1.0f / sqrtf(ss * (1.0f / DM) + RMS_EPS);
        float s2 = 0.f;
#pragma unroll
        for (int j = 0; j < 4; ++j) { const f32x4 xn = xv[j] + yf[j] * r * gv[j]; xv[j] = xn; s2 += (xn[0] * xn[0] + xn[1] * xn[1]) + (xn[2] * xn[2] + xn[3] * xn[3]); }
        if (FINAL) { float* orow = p.out + (size_t)row * DM;
#pragma unroll
            for (int j = 0; j < 4; ++j) ((f32x4*)orow)[64 * j + lane] = xv[j];
        } else {
            s2 = wave_sum(s2);
#pragma unroll
            for (int j = 0; j < 4; ++j) { u32x2 w; w.x = pk_bf16(xv[j][0], xv[j][1]); w.y = pk_bf16(xv[j][2], xv[j][3]); xr[64 * j + lane] = w; }
            if (lane == 0) rs_store(rs, row, 1.0f / sqrtf(s2 * (1.0f / DM) + RMS_EPS));
        }
    }
}

__device__ __forceinline__ bf16x8 ld8(const bf16_t* p) { return *(const bf16x8*)p; }
__device__ __forceinline__ void attn_store(bf16_t* orow, const f32x4 (&o)[4], float l, int fq) {
    l += __shfl_xor(l, 16); l += __shfl_xor(l, 32);
    const float inv = 1.0f / l;
#pragma unroll
    for (int c = 0; c < 4; ++c) { u32x2 w; w.x = pk_bf16(o[c][0] * inv, o[c][1] * inv); w.y = pk_bf16(o[c][2] * inv, o[c][3] * inv); *(u32x2*)(orow + 16 * c + 4 * fq) = w; }
}

struct PairRegs { bf16x8 k[2][2]; u32x4 v[2][2]; };

template <int NG> struct DilU { int seq0, L, r, u0, h; };
template <int D, int NG>
__device__ __forceinline__ DilU<NG> dilu_params(int item) {
    constexpr int CH = 16 * NG;
    DilU<NG> P; P.h = item % 6; const int cidx = item / 6, row0g = cidx * CH;
    int S; seq_of_row(row0g, S, P.seq0);
    constexpr int LG_CH = (CH == 16) ? 4 : (CH == 32) ? 5 : 6, LG_D = (D == 1) ? 0 : (D == 4) ? 2 : 4;
    const int lc = (row0g - P.seq0) >> LG_CH, lgLc = ((S == 2048) ? 11 : 13) - LG_D - LG_CH;
    P.L = S >> LG_D; P.r = lc >> lgLc; P.u0 = (lc & ((1 << lgLc) - 1)) << LG_CH;
    return P;
}
template <int D, int NG>
__device__ __forceinline__ void dilu_load(PairRegs& R, int p, const DilU<NG>& P, const bf16_t* proj, unsigned kofs, unsigned vofs) {
    const int rb = P.h * M_TOK + P.seq0 + P.r;
#pragma unroll
    for (int ab = 0; ab < 2; ++ab) {
        int x0 = P.u0 - 64 + 16 * (2 * p + ab); x0 = x0 < 0 ? 0 : (x0 > P.L - 16 ? P.L - 16 : x0);
        const size_t tb = (size_t)(rb + x0 * D) * 128;
        const char* kb = (const char*)(proj + PB_KD) + tb; const char* vb = (const char*)(proj + PB_VD) + tb;
        R.k[ab][0] = *(const bf16x8*)(kb + kofs); R.k[ab][1] = *(const bf16x8*)(kb + kofs + 64);
        R.v[ab][0] = *(const u32x4*)(vb + vofs); R.v[ab][1] = *(const u32x4*)(vb + vofs + 8 * D * 128);
    }
}
template <int D, int NG, int MODE, int PFD>
__device__ __forceinline__ void dilu_stream(const bf16_t* __restrict__ proj, bf16_t* __restrict__ mixed, bf16_t* __restrict__ ACC, float* __restrict__ LACC, LAS unsigned char* vst, unsigned* ctr, int xcd, int lane) {
    constexpr int NP = (NG + 9) / 2, NPV = ((NP + PFD - 1) / PFD) * PFD, CH = 16 * NG, NITEMS = (M_TOK / CH) * 6, PER = NITEMS / 8;
    static_assert(PFD - 1 <= NP, "ring prologue loads real pairs only");
#define DQ_TICKET(v) do { v = 0u; if (lane == 0) v = __hip_atomic_fetch_add(ctr, 1u, __ATOMIC_RELAXED, __HIP_MEMORY_SCOPE_AGENT); } while (0)
    const int base = xcd * PER;
    unsigned tk0, tk1; DQ_TICKET(tk0); DQ_TICKET(tk1);
    const int first = (int)__builtin_amdgcn_readfirstlane(tk0);
    if (first >= PER) return;
    int nxt = (int)__builtin_amdgcn_readfirstlane(tk1);
    const int fr = lane & 15, fq = lane >> 4, vr = lane >> 3, dlt = 4 * fq - fr;
    const unsigned kofs = (unsigned)((fr * D) * 128 + fq * 16), vofs = (unsigned)((vr * D) * 128 + (lane & 7) * 16);
    const unsigned wofs = vr * 160 + (lane & 7) * 16, trofs = (4 * fq + ((lane & 15) >> 2)) * 160 + (lane & 3) * 8;
    int it = base + first, par = 0;
    DilU<NG> P = dilu_params<D, NG>(it);
    PairRegs ring[PFD];
    bf16x8 q[NG][2];
#pragma unroll
    for (int g = 0; g < NG; ++g) { const bf16_t* qp = proj + PB_QD + (size_t)((P.h * M_TOK + P.seq0 + P.r + (P.u0 + 16 * g + fr) * D) * 64 + 8 * fq); q[g][0] = ld8(qp); q[g][1] = ld8(qp + 32); }
#pragma unroll
    for (int s = 0; s < PFD - 1; ++s) dilu_load<D, NG>(ring[s], s, P, proj, kofs, vofs);
    for (;;) {
        const bool has_next = nxt < PER; const int itn = base + nxt;
        unsigned tkn; DQ_TICKET(tkn);
        const DilU<NG> PN = dilu_params<D, NG>(has_next ? itn : it);
        bf16x8 qn[NG][2];
#pragma unroll
        for (int g = 0; g < NG; ++g) { const bf16_t* qp = proj + PB_QD + (size_t)((PN.h * M_TOK + PN.seq0 + PN.r + (PN.u0 + 16 * g + fr) * D) * 64 + 8 * fq); qn[g][0] = ld8(qp); qn[g][1] = ld8(qp + 32); }
        u32x2 pacc[NG][4]; float pl[NG];
        if (MODE != 0) {
#pragma unroll
            for (int g = 0; g < NG; ++g) { const int rowq = P.seq0 + P.r + (P.u0 + 16 * g + fr) * D; const bf16_t* ap = ACC + (size_t)(rowq * 6 + P.h) * 64 + 4 * fq;
#pragma unroll
                for (int c = 0; c < 4; ++c) pacc[g][c] = *(const u32x2*)(ap + 16 * c);
                pl[g] = LACC[rowq * 6 + P.h]; }
        }
        f32x4 o[NG][4]; float l[NG];
#pragma unroll
        for (int g = 0; g < NG; ++g) { l[g] = 0.f;
#pragma unroll
            for (int c = 0; c < 4; ++c) o[g][c] = (f32x4){0.f, 0.f, 0.f, 0.f}; }
#pragma unroll
        for (int p = 0; p < NPV; ++p) {
            const int m = p + PFD - 1;
            if (m < NPV) { if (m < NP) dilu_load<D, NG>(ring[m % PFD], m, P, proj, kofs, vofs); }
            else { if (m - NPV < NP) dilu_load<D, NG>(ring[m % PFD], m - NPV, PN, proj, kofs, vofs); }
            if (p >= NP) continue;
            const PairRegs& R = ring[p % PFD];
            LAS unsigned char* vbuf = vst + (((p & 1) ^ par) * 5120);
#pragma unroll
            for (int ab = 0; ab < 2; ++ab) { *(LAS u32x4*)(vbuf + ab * 2560 + wofs) = R.v[ab][0]; *(LAS u32x4*)(vbuf + ab * 2560 + wofs + 8 * 160) = R.v[ab][1]; }
            asm volatile("s_waitcnt lgkmcnt(0)" ::: "memory");
            bf16x8 vt[4];
#pragma unroll
            for (int c = 0; c < 4; ++c) {
                const s16x4 ta = __builtin_amdgcn_ds_read_tr16_b64_v4i16((LAS s16x4*)(vbuf + trofs + c * 32));
                const s16x4 tb = __builtin_amdgcn_ds_read_tr16_b64_v4i16((LAS s16x4*)(vbuf + 2560 + trofs + c * 32));
                vt[c] = (bf16x8){ta[0], ta[1], ta[2], ta[3], tb[0], tb[1], tb[2], tb[3]};
            }
            bool tok[2];
#pragma unroll
            for (int ab = 0; ab < 2; ++ab) { const int x0 = P.u0 - 64 + 16 * (2 * p + ab); tok[ab] = (x0 >= 0 && x0 < P.L); }
#pragma unroll
            for (int g = 0; g < NG; ++g) {
                const int dja = 2 * p - g, djb = 2 * p + 1 - g;
                const bool acta = dja >= 0 && dja <= 8, actb = djb >= 0 && djb <= 8;
                if (!acta && !actb) continue;
                f32x4 pr[2];
#pragma unroll
                for (int ab = 0; ab < 2; ++ab) {
                    const int dj = ab ? djb : dja; const bool act = ab ? actb : acta;
                    if (!act) { pr[ab] = (f32x4){0.f, 0.f, 0.f, 0.f}; continue; }
                    f32x4 s = {0.f, 0.f, 0.f, 0.f};
                    s = __builtin_amdgcn_mfma_f32_16x16x32_bf16(R.k[ab][0], q[g][0], s, 0, 0, 0);
                    s = __builtin_amdgcn_mfma_f32_16x16x32_bf16(R.k[ab][1], q[g][1], s, 0, 0, 0);
#pragma unroll
                    for (int e = 0; e < 4; ++e) {
                        float ex = __builtin_amdgcn_exp2f(s[e]);
                        bool ok = tok[ab];
                        if (dj == 0) ok = ok && (dlt + e >= 0);
                        if (dj == 8) ok = ok && (dlt + e <= 0);
                        ex = ok ? ex : 0.f;
                        pr[ab][e] = ex; l[g] += ex;
                    }
                }
                union { u32x4 u; bf16x8 h; } pp; pp.u.x = pk_bf16(pr[0][0], pr[0][1]); pp.u.y = pk_bf16(pr[0][2], pr[0][3]); pp.u.z = pk_bf16(pr[1][0], pr[1][1]); pp.u.w = pk_bf16(pr[1][2], pr[1][3]);
#pragma unroll
                for (int c = 0; c < 4; ++c) o[g][c] = __builtin_amdgcn_mfma_f32_16x16x32_bf16(vt[c], pp.h, o[g][c], 0, 0, 0);
            }
        }
#pragma unroll
        for (int g = 0; g < NG; ++g) {
            float lg = l[g]; lg += __shfl_xor(lg, 16); lg += __shfl_xor(lg, 32);
            const int rowq = P.seq0 + P.r + (P.u0 + 16 * g + fr) * D;
            bf16_t* ap = ACC + (size_t)(rowq * 6 + P.h) * 64 + 4 * fq; float* lp = LACC + rowq * 6 + P.h;
            if (MODE == 0) {
#pragma unroll
                for (int c = 0; c < 4; ++c) { u32x2 w; w.x = pk_bf16(o[g][c][0], o[g][c][1]); w.y = pk_bf16(o[g][c][2], o[g][c][3]); *(u32x2*)(ap + 16 * c) = w; }
                if (fq == 0) *lp = lg;
            } else if (MODE == 1) {
#pragma unroll
                for (int c = 0; c < 4; ++c) { const u32x2 pw = pacc[g][c]; const f32x4 t = (f32x4){bf_lo(pw.x), bf_hi(pw.x), bf_lo(pw.y), bf_hi(pw.y)} + o[g][c];
                    u32x2 w; w.x = pk_bf16(t[0], t[1]); w.y = pk_bf16(t[2], t[3]); *(u32x2*)(ap + 16 * c) = w; }
                if (fq == 0) *lp = pl[g] + lg;
            } else {
                const float inv = 1.0f / (pl[g] + lg);
                bf16_t* orow = mixed + (size_t)rowq * DM + P.h * 64 + 4 * fq;
#pragma unroll
                for (int c = 0; c < 4; ++c) { const u32x2 pw = pacc[g][c]; const f32x4 t = ((f32x4){bf_lo(pw.x), bf_hi(pw.x), bf_lo(pw.y), bf_hi(pw.y)} + o[g][c]) * inv; u32x2 w; w.x = pk_bf16(t[0], t[1]); w.y = pk_bf16(t[2], t[3]); *(u32x2*)(orow + 16 * c) = w; }
            }
        }
        if (!has_next) break;
        it = itn; nxt = (int)__builtin_amdgcn_readfirstlane(tkn); P = PN; par ^= (NP & 1);
#pragma unroll
        for (int g = 0; g < NG; ++g) { q[g][0] = qn[g][0]; q[g][1] = qn[g][1]; }
    }
}

#ifndef CFG_NG
#define CFG_NG 2
#define CFG_PF 2
#endif
#undef DQ_TICKET
struct Na2P { int kvrow; const bf16_t* qp; const LAS float* bb; int rs0, rows, kc0, qc, cs, orow, h, d1; };
__device__ __forceinline__ Na2P na2_params(const bf16_t* proj, const LAS float* tbl, int item, int lane) {
    Na2P P; const int fr = lane & 15, fq = lane >> 4;
    int S, t; if (item < 8 * 16 * 16) { S = 2048; t = item; } else { S = 8192; t = item - 8 * 16 * 16; }
    const int rows = S >> 6, per = (rows >> 1) * 16, seq = t / per, u = t - seq * per, rp = u >> 4, cb = u & 3; P.h = (u >> 2) & 3;
    const int seq0 = (S == 2048) ? seq * 2048 : NP_ROWS + seq * 8192, r = 2 * rp;
    int rs0 = r - 4; rs0 = rs0 < 0 ? 0 : (rs0 > rows - 8 ? rows - 8 : rs0);
    int rs1 = r - 3; rs1 = rs1 < 0 ? 0 : (rs1 > rows - 8 ? rows - 8 : rs1);
    P.rs0 = rs0; P.rows = rows; P.d1 = rs1 - rs0;
    int kc0 = 16 * cb - 8; kc0 = kc0 < 0 ? 0 : (kc0 > 32 ? 32 : kc0); P.kc0 = kc0;
    P.qc = 16 * cb + fr; int cs = P.qc - 8; cs = cs < 0 ? 0 : (cs > 48 ? 48 : cs); P.cs = cs;
    P.kvrow = P.h * M_TOK + seq0 + kc0;
    P.orow = seq0 + r * 64 + P.qc;
    P.qp = proj + PB_QN + ((size_t)P.h * M_TOK + P.orow) * 64 + 8 * fq;
    P.bb = tbl + P.h * 465 + (rs0 - r + 7) * 31;
    return P;
}
__device__ __forceinline__ void na2_load(PairRegs& R, int n, const Na2P& P, const bf16_t* proj, unsigned kofs, unsigned vofs) {
    int kr = P.rs0 + n; kr = kr > P.rows - 1 ? P.rows - 1 : kr;
#pragma unroll
    for (int hh = 0; hh < 2; ++hh) {
        const size_t tb = (size_t)(P.kvrow + kr * 64 + 16 * hh) * 128;
        const char* kb = (const char*)(proj + PB_KN) + tb; const char* vb = (const char*)(proj + PB_VN) + tb;
        R.k[hh][0] = *(const bf16x8*)(kb + kofs); R.k[hh][1] = *(const bf16x8*)(kb + kofs + 64);
        R.v[hh][0] = *(const u32x4*)(vb + vofs); R.v[hh][1] = *(const u32x4*)(vb + vofs + 8 * 128);
    }
}
template <int PFD>
__device__ __forceinline__ void na2_stream(const bf16_t* __restrict__ proj, bf16_t* __restrict__ mixed, LAS unsigned char* vst, const LAS float* tbl, int first, int stride, int lane) {
    constexpr int NP = 9, NPV = ((NP + PFD - 1) / PFD) * PFD, NITEMS = (M_TOK / 128) * 16;
    if (first >= NITEMS) return;
    const int fr = lane & 15, fq = lane >> 4, vr = lane >> 3;
    const unsigned kofs = (unsigned)(fr * 128 + fq * 16), vofs = (unsigned)(vr * 128 + (lane & 7) * 16);
    const unsigned wofs = vr * 160 + (lane & 7) * 16, trofs = (4 * fq + ((lane & 15) >> 2)) * 160 + (lane & 3) * 8;
    int it = first;
    Na2P P = na2_params(proj, tbl, it, lane);
    PairRegs ring[PFD];
    bf16x8 q[2][2];
#pragma unroll
    for (int g = 0; g < 2; ++g) { q[g][0] = ld8(P.qp + g * 4096); q[g][1] = ld8(P.qp + g * 4096 + 32); }
#pragma unroll
    for (int s = 0; s < PFD - 1; ++s) na2_load(ring[s], s, P, proj, kofs, vofs);
    for (;;) {
        const int itn = it + stride; const bool has_next = itn < NITEMS;
        const Na2P PN = na2_params(proj, tbl, has_next ? itn : it, lane);
        bf16x8 qn[2][2];
#pragma unroll
        for (int g = 0; g < 2; ++g) { qn[g][0] = ld8(PN.qp + g * 4096); qn[g][1] = ld8(PN.qp + g * 4096 + 32); }
        f32x4 o[2][4]; float l[2];
#pragma unroll
        for (int g = 0; g < 2; ++g) { l[g] = 0.f;
#pragma unroll
            for (int c = 0; c < 4; ++c) o[g][c] = (f32x4){0.f, 0.f, 0.f, 0.f}; }
#pragma unroll
        for (int p = 0; p < NPV; ++p) {
            const int m = p + PFD - 1;
            if (m < NPV) { if (m < NP) na2_load(ring[m % PFD], m, P, proj, kofs, vofs); }
            else { if (m - NPV < NP) na2_load(ring[m % PFD], m - NPV, PN, proj, kofs, vofs); }
            if (p >= NP) continue;
            const PairRegs& R = ring[p % PFD];
            LAS unsigned char* vbuf = vst + (p % 3) * 5120;
#pragma unroll
            for (int ab = 0; ab < 2; ++ab) { *(LAS u32x4*)(vbuf + ab * 2560 + wofs) = R.v[ab][0]; *(LAS u32x4*)(vbuf + ab * 2560 + wofs + 8 * 160) = R.v[ab][1]; }
            asm volatile("s_waitcnt lgkmcnt(0)" ::: "memory");
            bf16x8 vt[4];
#pragma unroll
            for (int c = 0; c < 4; ++c) {
                const s16x4 ta = __builtin_amdgcn_ds_read_tr16_b64_v4i16((LAS s16x4*)(vbuf + trofs + c * 32));
                const s16x4 tb = __builtin_amdgcn_ds_read_tr16_b64_v4i16((LAS s16x4*)(vbuf + 2560 + trofs + c * 32));
                vt[c] = (bf16x8){ta[0], ta[1], ta[2], ta[3], tb[0], tb[1], tb[2], tb[3]};
            }
#pragma unroll
            for (int g = 0; g < 2; ++g) {
                if (g == 0 && p == 8) continue;
                const bool act = (g == 0) ? true : (p == 0 ? P.d1 == 0 : (p == 8 ? P.d1 == 1 : true));
                const LAS float* brow = P.bb + (p - g) * 31;
                f32x4 pr[2];
#pragma unroll
                for (int hh = 0; hh < 2; ++hh) {
                    f32x4 s = {0.f, 0.f, 0.f, 0.f};
                    s = __builtin_amdgcn_mfma_f32_16x16x32_bf16(R.k[hh][0], q[g][0], s, 0, 0, 0);
                    s = __builtin_amdgcn_mfma_f32_16x16x32_bf16(R.k[hh][1], q[g][1], s, 0, 0, 0);
#pragma unroll
                    for (int e = 0; e < 4; ++e) { const int kc = P.kc0 + 16 * hh + 4 * fq + e; const bool valid = act && (kc >= P.cs) && (kc < P.cs + 16);
                        int dc = kc - P.qc + 15; dc = dc < 0 ? 0 : (dc > 30 ? 30 : dc);
                        const float ex = __builtin_amdgcn_exp2f(s[e] + brow[dc]); pr[hh][e] = valid ? ex : 0.f; l[g] += pr[hh][e]; }
                }
                union { u32x4 u; bf16x8 h; } pp; pp.u.x = pk_bf16(pr[0][0], pr[0][1]); pp.u.y = pk_bf16(pr[0][2], pr[0][3]); pp.u.z = pk_bf16(pr[1][0], pr[1][1]); pp.u.w = pk_bf16(pr[1][2], pr[1][3]);
#pragma unroll
                for (int c = 0; c < 4; ++c) o[g][c] = __builtin_amdgcn_mfma_f32_16x16x32_bf16(vt[c], pp.h, o[g][c], 0, 0, 0);
            }
        }
#pragma unroll
        for (int g = 0; g < 2; ++g) attn_store(mixed + (size_t)(P.orow + g * 64) * DM + 384 + P.h * 64, o[g], l[g], fq);
        if (!has_next) break;
        it = itn; P = PN;
#pragma unroll
        for (int g = 0; g < 2; ++g) { q[g][0] = qn[g][0]; q[g][1] = qn[g][1]; }
    }
}

constexpr int DIL_NG = CFG_NG, DIL_PF = CFG_PF;
__device__ __forceinline__ void mix_a(const Params& p, int layer, LAS unsigned char* lds, int tid, int lane, int wave) {
    unsigned char* ws = p.ws; const bf16_t* proj = (const bf16_t*)(ws + WS_PROJ); bf16_t* mixed = (bf16_t*)(ws + WS_MIXED);
    LAS float* tbl = (LAS float*)(lds + 131072);
    for (int i = tid; i < 4 * 465; i += 512) tbl[i] = p.rpb[layer * 4 * 465 + i] * LOG2E;
    __syncthreads();
    LAS unsigned char* vst = lds + wave * 16384;
    const int vcu = (gridDim.x % 8 == 0) ? (int)(blockIdx.x % 8) * (int)(gridDim.x / 8) + (int)(blockIdx.x / 8) : (int)blockIdx.x;
    const int gw = vcu * NWAVES + wave, NGW = gridDim.x * NWAVES;
    na2_stream<2>(proj, mixed, vst, tbl, gw, NGW, lane);
    dilu_stream<16, DIL_NG, 0, DIL_PF>(proj, mixed, (bf16_t*)(ws + WS_Y), (float*)(ws + WS_Y + 128 * MiB), vst, (unsigned*)(ws + WS_QCTR) + ((layer * 3 + 0) * 8 + (int)(blockIdx.x & 7)) * 64, (int)(blockIdx.x & 7), lane);
}
__device__ __forceinline__ void mix_b(const Params& p, int layer, LAS unsigned char* lds, int tid, int lane, int wave) {
    unsigned char* ws = p.ws; const bf16_t* proj = (const bf16_t*)(ws + WS_PROJ); bf16_t* mixed = (bf16_t*)(ws + WS_MIXED);
    LAS unsigned char* vst = lds + wave * 16384;
    const int vcu = (gridDim.x % 8 == 0) ? (int)(blockIdx.x % 8) * (int)(gridDim.x / 8) + (int)(blockIdx.x / 8) : (int)blockIdx.x;
    const int gw = vcu * NWAVES + wave, NGW = gridDim.x * NWAVES;
    const float* cw = p.conv_w + layer * 3 * 384;
    for (int idx = blockIdx.x * 512 + tid; idx < M_TOK * 48; idx += gridDim.x * 512) {
        const int row = idx / 48, c0 = (idx - row * 48) * 8;
        int S, seq0; seq_of_row(row, S, seq0); const int pos = row - seq0;
        const bf16_t* base = proj + PB_CV + (size_t)row * DCV + c0;
        const u32x4 gb = *(const u32x4*)base;
        float acc[8];
#pragma unroll
        for (int k = 0; k < 8; ++k) acc[k] = 0.f;
#pragma unroll
        for (int j = 0; j < 3; ++j) {
            const int pp = pos + j - 1;
            if (pp >= 0 && pp < S) {
                const bf16_t* bj = base + (ptrdiff_t)(j - 1) * DCV;
                const u32x4 gc = *(const u32x4*)(bj + 384), hi = *(const u32x4*)(bj + 768);
                const f32x4 w0 = *(const f32x4*)(cw + j * 384 + c0), w1 = *(const f32x4*)(cw + j * 384 + c0 + 4);
                acc[0] += w0[0] * bf_lo(gc.x) * bf_lo(hi.x); acc[1] += w0[1] * bf_hi(gc.x) * bf_hi(hi.x);
                acc[2] += w0[2] * bf_lo(gc.y) * bf_lo(hi.y); acc[3] += w0[3] * bf_hi(gc.y) * bf_hi(hi.y);
                acc[4] += w1[0] * bf_lo(gc.z) * bf_lo(hi.z); acc[5] += w1[1] * bf_hi(gc.z) * bf_hi(hi.z);
                acc[6] += w1[2] * bf_lo(gc.w) * bf_lo(hi.w); acc[7] += w1[3] * bf_hi(gc.w) * bf_hi(hi.w);
            }
        }
        u32x4 w; w.x = pk_bf16(acc[0] * bf_lo(gb.x), acc[1] * bf_hi(gb.x)); w.y = pk_bf16(acc[2] * bf_lo(gb.y), acc[3] * bf_hi(gb.y));
        w.z = pk_bf16(acc[4] * bf_lo(gb.z), acc[5] * bf_hi(gb.z)); w.w = pk_bf16(acc[6] * bf_lo(gb.w), acc[7] * bf_hi(gb.w));
        *(u32x4*)(mixed + (size_t)row * DM + 640 + c0) = w;
    }
    dilu_stream<4, DIL_NG, 1, DIL_PF>(proj, mixed, (bf16_t*)(ws + WS_Y), (float*)(ws + WS_Y + 128 * MiB), vst, (unsigned*)(ws + WS_QCTR) + ((layer * 3 + 1) * 8 + (int)(blockIdx.x & 7)) * 64, (int)(blockIdx.x & 7), lane);
}
__device__ __forceinline__ void mix_c(const Params& p, int layer, LAS unsigned char* lds, int lane, int wave) {
    unsigned char* ws = p.ws; const bf16_t* proj = (const bf16_t*)(ws + WS_PROJ); bf16_t* mixed = (bf16_t*)(ws + WS_MIXED);
    LAS unsigned char* vst = lds + wave * 16384;
    const int vcu = (gridDim.x % 8 == 0) ? (int)(blockIdx.x % 8) * (int)(gridDim.x / 8) + (int)(blockIdx.x / 8) : (int)blockIdx.x;
    const int gw = vcu * NWAVES + wave, NGW = gridDim.x * NWAVES;
    dilu_stream<1, DIL_NG, 2, DIL_PF>(proj, mixed, (bf16_t*)(ws + WS_Y), (float*)(ws + WS_Y + 128 * MiB), vst, (unsigned*)(ws + WS_QCTR) + ((layer * 3 + 2) * 8 + (int)(blockIdx.x & 7)) * 64, (int)(blockIdx.x & 7), lane);
}

#define XB_TMO      128
#define XB_XCNT(j)  (256  + 64 * (j))
#define XB_XSUB(j)  (1280 + 64 * (j))
#define XB_XGEN(j)  (2304 + 64 * (j))
#define XB_TOP      3328
#define XB_TOPGEN   3392
#define XCD_BAR_WORDS 3456
#define XB_SPIN_CAP (1u << 18)

__device__ __forceinline__ unsigned xb_ld(unsigned* p)              { return __hip_atomic_load(p, __ATOMIC_RELAXED, __HIP_MEMORY_SCOPE_AGENT); }
__device__ __forceinline__ unsigned xb_add(unsigned* p, unsigned v) { return __hip_atomic_fetch_add(p, v, __ATOMIC_RELAXED, __HIP_MEMORY_SCOPE_AGENT); }
__device__ __forceinline__ unsigned xb_xcc_id() { return (unsigned)__builtin_amdgcn_s_getreg((3 << 11) | 20) & 0xFu; }
#define XB_SPIN(cond, bar) do { unsigned _sp = 0; while (cond) { __builtin_amdgcn_s_sleep(1); \
    if ((++_sp & 255u) == 0u) { if (xb_ld(&(bar)[XB_TMO])) break; if (_sp > XB_SPIN_CAP) { atomicAdd(&(bar)[XB_TMO], 1u); break; } } } } while (0)

struct XcdBarrier {
    unsigned* bar; unsigned x;
    volatile LAS unsigned* st;
};

__device__ __forceinline__ XcdBarrier xcd_barrier_post(unsigned* bar, volatile LAS unsigned* st) {
    XcdBarrier b; b.bar = bar; b.x = xb_xcc_id(); b.st = st;
    if (threadIdx.x == 0) (void)xb_add(&bar[XB_XCNT(b.x)], 1u);
    return b;
}
__device__ __forceinline__ void xcd_barrier_complete(unsigned* bar, unsigned x, unsigned& nloc, unsigned& nx) {
    const unsigned G = gridDim.x * gridDim.y * gridDim.z;
    unsigned sum, cnt, mine, sp = 0u;
    for (;;) {
        sum = 0u; cnt = 0u; mine = 0u;
#pragma unroll
        for (unsigned j = 0; j < 16; ++j) { const unsigned c = xb_ld(&bar[XB_XCNT(j)]); sum += c; cnt += (c > 0u) ? 1u : 0u; mine = (j == x) ? c : mine; }
        if (sum == G) break;
        __builtin_amdgcn_s_sleep(1);
        if ((++sp & 255u) == 0u) { if (xb_ld(&bar[XB_TMO])) break; if (sp > XB_SPIN_CAP) { atomicAdd(&bar[XB_TMO], 1u); break; } }
    }
    nloc = mine > 0u ? mine : 1u; nx = cnt > 0u ? cnt : 1u;
}

__device__ __forceinline__ void xcd_barrier(const XcdBarrier& b) {
    asm volatile("s_waitcnt vmcnt(0)" ::: "memory");
    __syncthreads();
    if (threadIdx.x == 0) {
        unsigned* bar = b.bar;
        __builtin_amdgcn_s_waitcnt(0);
        unsigned nloc = b.st[0], nx = b.st[1];
        if (nloc == 0u) { xcd_barrier_complete(bar, b.x, nloc, nx); b.st[0] = nloc; b.st[1] = nx; }
        const unsigned old = xb_add(&bar[XB_XSUB(b.x)], 1u);
        const unsigned gen = old / nloc;
        if (old + 1u == (gen + 1u) * nloc) {
            __builtin_amdgcn_fence(__ATOMIC_RELEASE, "agent");
            asm volatile("s_waitcnt vmcnt(0)" ::: "memory");
            const unsigned og = xb_add(&bar[XB_TOP], 1u);
            const unsigned tg = og / nx;
            if (og + 1u == (tg + 1u) * nx) xb_add(&bar[XB_TOPGEN], 1u);
            else XB_SPIN(xb_ld(&bar[XB_TOPGEN]) == tg, bar);
            __builtin_amdgcn_fence(__ATOMIC_ACQUIRE, "agent");
            xb_add(&bar[XB_XGEN(b.x)], 1u);
            asm volatile("s_waitcnt vmcnt(0)" ::: "memory");
        } else {
            XB_SPIN(xb_ld(&bar[XB_XGEN(b.x)]) == gen, bar);
            __builtin_amdgcn_fence(__ATOMIC_ACQUIRE, "agent");
            asm volatile("s_waitcnt vmcnt(0)" ::: "memory");
        }
    }
    __syncthreads();
}

__global__ void __launch_bounds__(512) fwd_mega(Params p) {
    extern __shared__ __attribute__((aligned(16))) unsigned char lds_raw[];
    LAS unsigned char* lds = (LAS unsigned char*)lds_raw;
    cg::grid_group grid = cg::this_grid();
    unsigned char* ws = p.ws;
#define FRESH_TID() int tid = threadIdx.x; asm volatile("" : "+v"(tid)); const int lane = tid & 63, wave = __builtin_amdgcn_readfirstlane(tid >> 6)
    bf16_t* xb = (bf16_t*)(ws + WS_XB); bf16_t* proj = (bf16_t*)(ws + WS_PROJ); bf16_t* mixed = (bf16_t*)(ws + WS_MIXED); bf16_t* Y = (bf16_t*)(ws + WS_Y); bf16_t* H = (bf16_t*)(ws + WS_H);
    const unsigned short* rs = (const unsigned short*)(ws + WS_RS);

    if (threadIdx.x < 4) ((volatile LAS unsigned*)(lds + 139264))[threadIdx.x] = 0u;
    __syncthreads();
    const XcdBarrier xbar = xcd_barrier_post((unsigned*)(ws + WS_CTL), (volatile LAS unsigned*)(lds + 139264));
    { FRESH_TID(); prologue(p, lds, tid, lane, wave); }
    grid.sync();
    for (int layer = 0; layer < 2; ++layer) {
        {
            pg8::Gemm g{xb, (const bf16_t*)(ws + WS_WIN) + (size_t)layer * DIN * DM, M_TOK, DIN, DM}; pg8::StaticOrder S; S.init(M_TOK, DIN, (int)gridDim.x, (int)blockIdx.x);
            EpiProj E{proj, rs, (const unsigned*)(ws + WS_COS)};
            pg8::gemm_phase<EpiProj, pg8::StaticOrder>(lds, g, S, E);
        }
        xcd_barrier(xbar);
        { FRESH_TID(); mix_a(p, layer, lds, tid, lane, wave); }
        xcd_barrier(xbar);
        { FRESH_TID(); mix_b(p, layer, lds, tid, lane, wave); }
        xcd_barrier(xbar);
        { FRESH_TID(); (void)tid; mix_c(p, layer, lds, lane, wave); }
        xcd_barrier(xbar);
        {
            pg8::Gemm g{mixed, (const bf16_t*)(ws + WS_WOUT) + (size_t)layer * DM * DM, M_TOK, DM, DM}; pg8::StaticOrder S; S.init(M_TOK, DM, (int)gridDim.x, (int)blockIdx.x);
            EpiPlain E{Y, DM};
            pg8::gemm_phase<EpiPlain, pg8::StaticOrder>(lds, g, S, E);
        }
        xcd_barrier(xbar);
        { FRESH_TID(); (void)tid; ew_phase<false>(p, p.g_post_mix + layer * DM, lane, wave); }
        xcd_barrier(xbar);
        {
            pg8::Gemm g{xb, (const bf16_t*)(ws + WS_WGU) + (size_t)layer * 2 * DFF * DM, M_TOK, 2 * DFF, DM}; pg8::StaticOrder S; S.init(M_TOK, 2 * DFF, (int)gridDim.x, (int)blockIdx.x);
            EpiSwiglu E{H, rs};
            pg8::gemm_phase<EpiSwiglu, pg8::StaticOrder>(lds, g, S, E);
        }
        xcd_barrier(xbar);
        {
            pg8::Gemm g{H, (const bf16_t*)(ws + WS_WDN) + (size_t)layer * DM * DFF, M_TOK, DM, DFF}; pg8::StaticOrder S; S.init(M_TOK, DM, (int)gridDim.x, (int)blockIdx.x);
            if (layer == 0) { EpiPlain E{Y, DM}; pg8::gemm_phase<EpiPlain, pg8::StaticOrder>(lds, g, S, E); }
            else { EpiNormOut E{ws, p.out, p.g_post_ffn + layer * DM, lds}; pg8::gemm_phase<EpiNormOut, pg8::StaticOrder>(lds, g, S, E); }
        }
        if (layer == 0) { xcd_barrier(xbar); { FRESH_TID(); (void)tid; ew_phase<false>(p, p.g_post_ffn + layer * DM, lane, wave); } xcd_barrier(xbar); }
    }
}

extern "C" void kernel_launch(void* const* d_in, const int* in_sizes, int n_in, void* d_out, int out_size, void* d_ws, size_t ws_size, hipStream_t stream) {
    static int grid_blocks = 0;
    if (!grid_blocks) {
        if (n_in != 13 || out_size != M_TOK * DM || ws_size < WS_END) { fprintf(stderr, "kernel_launch: unexpected sizes (n_in %d out %d ws %zu)\n", n_in, out_size, ws_size); grid_blocks = -1; return; }
        int dev = 0, cus = 0, per_cu = 0;
        hipGetDevice(&dev); hipDeviceGetAttribute(&cus, hipDeviceAttributeMultiprocessorCount, dev);
        hipFuncSetAttribute((const void*)fwd_mega, hipFuncAttributeMaxDynamicSharedMemorySize, LDS_BYTES);
        hipOccupancyMaxActiveBlocksPerMultiprocessor(&per_cu, (const void*)fwd_mega, 512, LDS_BYTES);
        if (per_cu < 1) { fprintf(stderr, "kernel_launch: occupancy query says %d blocks per CU\n", per_cu); per_cu = 1; }
        (void)hipGetLastError();
        grid_blocks = cus * per_cu;
    }
    if (grid_blocks < 0) return;
    Params p{};
    p.x_p = (const float*)d_in[0]; p.x_s = (const float*)d_in[1]; p.g_pre_mix = (const float*)d_in[2]; p.w_in = (const float*)d_in[3]; p.conv_w = (const float*)d_in[4];
    p.rpb = (const float*)d_in[5]; p.w_out = (const float*)d_in[6]; p.g_post_mix = (const float*)d_in[7]; p.g_pre_ffn = (const float*)d_in[8]; p.w_gate = (const float*)d_in[9];
    p.w_up = (const float*)d_in[10]; p.w_down = (const float*)d_in[11]; p.g_post_ffn = (const float*)d_in[12]; p.out = (float*)d_out; p.ws = (unsigned char*)d_ws;
    if (hipMemsetAsync((char*)d_ws + WS_CTL, 0, CTL_BYTES, stream) != hipSuccess) { fprintf(stderr, "kernel_launch: memset of the barrier words failed\n"); return; }
    void* args[] = {&p};
    hipError_t e = hipLaunchCooperativeKernel((const void*)fwd_mega, dim3(grid_blocks), dim3(512), args, LDS_BYTES, stream);
    if (e != hipSuccess) fprintf(stderr, "cooperative launch failed: %s (grid %d)\n", hipGetErrorString(e), grid_blocks);
}
```

```cpp
#include <hip/hip_runtime.h>
#include <hip/hip_cooperative_groups.h>
#include <cstdio>
namespace cg = cooperative_groups;
namespace pg8 {
#define PG8_LAS __attribute__((address_space(3)))
typedef unsigned short bf16_t;
typedef short bf16x8 __attribute__((ext_vector_type(8)));
typedef float f32x4 __attribute__((ext_vector_type(4)));
typedef unsigned u32x4 __attribute__((ext_vector_type(4)));
constexpr int BM = 256, BK = 64, HALF = 128, HTB = HALF * BK * 2  , STAGE_BYTES = 8 * HTB, NXCD = 8, WGM = 8;

__host__ __device__ __forceinline__ int lds_byte(int r, int c) { const int st = (r >> 4) * 2 + (c >> 5), rr = r & 15, cc = c & 31, ob = rr * 64 + cc * 2; return st * 1024 + (ob ^ (((ob >> 9) & 1) << 5)); }
__host__ __device__ __forceinline__ void stage_rc(int b, int& R, int& C) { const int st = b / 1024, sb = b % 1024, swz = sb ^ (((sb >> 9) & 1) << 5); R = (st >> 1) * 16 + swz / 64; C = (st & 1) * 32 + (swz % 64) / 2; }
__host__ __device__ __forceinline__ int perm32(int rho) { const int n = rho >> 4, i = rho & 15; return 8 * (i >> 2) + 4 * n + (i & 3); }

struct Unit { int pm, pn; };
struct Gemm { const bf16_t* A; const bf16_t* Bt; int M, N, K; };

struct StaticOrder {
    int nM, nN, nwg, G, c;
    __host__ __device__ void init(int M, int N, int G_, int c_) { nM = M / BM; nN = N / BM; nwg = nM * nN; G = G_; c = c_; }
    __host__ __device__ bool next(int i, Unit& u) const {
        const long L = (long)i * G + c; if (L >= nwg) return false;
        int wgid = (int)L; { const int q = nwg / NXCD, r = nwg % NXCD, xcd = wgid % NXCD, off = wgid / NXCD; wgid = (xcd < r ? xcd * (q + 1) : r * (q + 1) + (xcd - r) * q) + off; }
        const int nig = WGM * nN, gid = wgid / nig, fm = gid * WGM, gsz = (nM - fm) < WGM ? (nM - fm) : WGM;
        u.pm = fm + ((wgid % nig) % gsz); u.pn = (wgid % nig) / gsz; return true;
    }
    __device__ __forceinline__ void a_ready(const Unit&) const {}
    __device__ __forceinline__ void done(const Unit&) const {}
};
typedef float f32x2 __attribute__((ext_vector_type(2)));
template <class Epi, class Sched, bool ALIGN_EPI = true, bool SP2 = true>
__device__ __forceinline__ void gemm_phase(PG8_LAS unsigned char* lds, const Gemm g, const Sched& S, const Epi& E) {
    int tid_ = threadIdx.x; asm volatile("" : "+v"(tid_));
    const int tid = tid_, wid = __builtin_amdgcn_readfirstlane(tid >> 6), lane = tid & 63, wr = wid >> 2, wc = wid & 3, fr = lane & 15, fq = lane >> 4;
    const int K = g.K, nt = K / BK;
    unsigned voffA[2], voffB[2];
#pragma unroll
    for (int i = 0; i < 2; ++i) { int R, C; stage_rc(tid * 16 + i * 8192, R, C); const int Rb = Epi::PERM ? ((R & ~31) + perm32(R & 31)) : R;
        voffA[i] = (unsigned)(R * K + C) * 2u; voffB[i] = (unsigned)(Rb * K + C) * 2u; }
    const size_t kstep = (size_t)(BK * 2);
    const size_t hstep = (size_t)HALF * K * 2;
    const size_t tstep = 2 * hstep;
    const unsigned ldsw = (unsigned)wid * 1024u;
    const int aoff = lds_byte(wr * 64 + fr, fq * 8), boff = lds_byte(wc * 32 + fr, fq * 8);
#define PG8_SA(b, h) (((b) * 2 + (h)) * HTB)
#define PG8_SB(b, h) ((4 + (b) * 2 + (h)) * HTB)
#define PG8_STAGE(bufoff, gbase, voff) do { _Pragma("unroll") for (int _i = 0; _i < 2; ++_i) \
        __builtin_amdgcn_global_load_lds((const unsigned*)((const char*)(gbase) + (voff)[_i]), (PG8_LAS unsigned*)(lds + (bufoff) + ldsw + _i * 8192), 16, 0, 0); } while (0)
#define PG8_LDA(dst, b, h) do { _Pragma("unroll") for (int m = 0; m < 4; ++m) _Pragma("unroll") for (int k = 0; k < 2; ++k) dst[m][k] = *(const PG8_LAS bf16x8*)(lds + PG8_SA(b, h) + aoff + m * 2048 + k * 1024); } while (0)
#define PG8_LDB(dst, b, h) do { _Pragma("unroll") for (int n = 0; n < 2; ++n) _Pragma("unroll") for (int k = 0; k < 2; ++k) dst[n][k] = *(const PG8_LAS bf16x8*)(lds + PG8_SB(b, h) + boff + n * 2048 + k * 1024); } while (0)
#define PG8_MMA(ai, bj, At, Bt) do { __builtin_amdgcn_s_setprio(1); _Pragma("unroll") for (int m = 0; m < 4; ++m) _Pragma("unroll") for (int n = 0; n < 2; ++n) _Pragma("unroll") for (int k = 0; k < 2; ++k) \
        acc[ai][bj][m][n] = __builtin_amdgcn_mfma_f32_16x16x32_bf16(Bt[n][k], At[m][k], acc[ai][bj][m][n], 0, 0, 0); __builtin_amdgcn_s_setprio(0); } while (0)
#define PG8_WAIT_V(n) asm volatile("s_waitcnt vmcnt(" #n ")" ::: "memory")
#define PG8_WAIT_L(n) asm volatile("s_waitcnt lgkmcnt(" #n ")" ::: "memory")
#define PG8_BAR __builtin_amdgcn_s_barrier()
#define PG8_SCHED __builtin_amdgcn_sched_barrier(0)
    Unit cur, nxt; int ui = 0; unsigned epre[4];
#pragma unroll
    for (int i = 0; i < 4; ++i) epre[i] = 0u;
    if (!S.next(0, cur)) return;
    f32x4 acc[2][2][4][2];
#pragma unroll
    for (int a = 0; a < 2; ++a)
#pragma unroll
        for (int b = 0; b < 2; ++b)
#pragma unroll
            for (int m = 0; m < 4; ++m)
#pragma unroll
                for (int n = 0; n < 2; ++n) acc[a][b][m][n] = (f32x4){0.f, 0.f, 0.f, 0.f};
    bf16x8 At[4][2], B0[2][2], B1[2][2];
    const char* cA = (const char*)g.A + (size_t)cur.pm * tstep; const char* cB = (const char*)g.Bt + (size_t)cur.pn * tstep;
    S.a_ready(cur);
    if constexpr (SP2) {
        PG8_STAGE(PG8_SB(0, 0), cB, voffB); PG8_STAGE(PG8_SB(0, 1), cB + hstep, voffB); PG8_STAGE(PG8_SA(0, 0), cA, voffA); PG8_STAGE(PG8_SA(0, 1), cA + hstep, voffA);
        if (wr == 1) PG8_BAR;
        PG8_WAIT_V(2); PG8_BAR;
        PG8_STAGE(PG8_SB(1, 0), cB + kstep, voffB); PG8_STAGE(PG8_SA(1, 0), cA + kstep, voffA); PG8_STAGE(PG8_SB(1, 1), cB + hstep + kstep, voffB);
        PG8_WAIT_V(6); PG8_BAR;
    } else {
        PG8_STAGE(PG8_SB(0, 0), cB, voffB); PG8_STAGE(PG8_SA(0, 0), cA, voffA); PG8_STAGE(PG8_SB(0, 1), cB + hstep, voffB); PG8_STAGE(PG8_SA(0, 1), cA + hstep, voffA);
        if (wr == 1) PG8_BAR;
        PG8_WAIT_V(4); PG8_BAR;
        PG8_STAGE(PG8_SB(1, 0), cB + kstep, voffB); PG8_STAGE(PG8_SA(1, 0), cA + kstep, voffA); PG8_STAGE(PG8_SB(1, 1), cB + hstep + kstep, voffB);
        PG8_WAIT_V(6); PG8_BAR;
    }
    for (;;) {
        const bool has_next = S.next(ui + 1, nxt);
        const char* nA = has_next ? (const char*)g.A + (size_t)nxt.pm * tstep : cA; const char* nB = has_next ? (const char*)g.Bt + (size_t)nxt.pn * tstep : cB;
        for (int t = 0; t < nt; t += 2) {
            const bool last = (t == nt - 2);
            const char* a1 = cA + (size_t)(t + 1) * kstep;
            const char* a2 = last ? nA : cA + (size_t)(t + 2) * kstep; const char* b2 = last ? nB : cB + (size_t)(t + 2) * kstep;
            const char* a3 = a2 + kstep; const char* b3 = b2 + kstep;
            if (last && has_next) S.a_ready(nxt);
            if (last) E.prefetch(epre, cur, wr, fr);
            if constexpr (SP2) {
            PG8_LDB(B0, 0, 0); PG8_LDB(B1, 0, 1); PG8_SCHED; PG8_LDA(At, 0, 0); PG8_STAGE(PG8_SA(1, 1), a1 + hstep, voffA);
            PG8_WAIT_V(8); PG8_WAIT_L(0); PG8_BAR; PG8_MMA(0, 0, At, B0); PG8_MMA(0, 1, At, B1); PG8_BAR; PG8_SCHED;
            PG8_LDA(At, 0, 1); PG8_STAGE(PG8_SB(0, 0), b2, voffB); PG8_STAGE(PG8_SB(0, 1), b2 + hstep, voffB); PG8_STAGE(PG8_SA(0, 0), a2, voffA);
            PG8_WAIT_V(8); PG8_WAIT_L(0); PG8_BAR; PG8_MMA(1, 0, At, B0); PG8_MMA(1, 1, At, B1); PG8_BAR; PG8_SCHED;
            PG8_LDB(B0, 1, 0); PG8_LDB(B1, 1, 1); PG8_SCHED; PG8_LDA(At, 1, 0); PG8_STAGE(PG8_SA(0, 1), a2 + hstep, voffA);
            PG8_WAIT_V(8); PG8_WAIT_L(0); PG8_BAR; PG8_MMA(0, 0, At, B0); PG8_MMA(0, 1, At, B1); PG8_BAR; PG8_SCHED;
            PG8_LDA(At, 1, 1); PG8_STAGE(PG8_SB(1, 0), b3, voffB); PG8_STAGE(PG8_SB(1, 1), b3 + hstep, voffB); PG8_STAGE(PG8_SA(1, 0), a3, voffA);
            PG8_WAIT_V(8); PG8_WAIT_L(0); PG8_BAR; PG8_MMA(1, 0, At, B0); PG8_MMA(1, 1, At, B1); PG8_BAR; PG8_SCHED;
            } else {
            PG8_LDB(B0, 0, 0); PG8_SCHED; PG8_LDA(At, 0, 0); PG8_STAGE(PG8_SA(1, 1), a1 + hstep, voffA);
            PG8_WAIT_L(8); PG8_BAR; PG8_WAIT_L(0); PG8_MMA(0, 0, At, B0); PG8_BAR; PG8_SCHED;
            PG8_LDB(B1, 0, 1); PG8_STAGE(PG8_SB(0, 0), b2, voffB);
            PG8_BAR; PG8_WAIT_L(0); PG8_MMA(0, 1, At, B1); PG8_BAR;
            PG8_LDA(At, 0, 1); PG8_STAGE(PG8_SA(0, 0), a2, voffA);
            PG8_BAR; PG8_WAIT_L(0); PG8_MMA(1, 0, At, B0); PG8_BAR; PG8_SCHED;
            PG8_STAGE(PG8_SB(0, 1), b2 + hstep, voffB);
            PG8_WAIT_V(6); PG8_BAR; PG8_MMA(1, 1, At, B1); PG8_BAR;
            PG8_LDB(B0, 1, 0); PG8_SCHED; PG8_LDA(At, 1, 0); PG8_STAGE(PG8_SA(0, 1), a2 + hstep, voffA);
            PG8_WAIT_L(8); PG8_BAR; PG8_WAIT_L(0); PG8_MMA(0, 0, At, B0); PG8_BAR; PG8_SCHED;
            PG8_LDB(B1, 1, 1); PG8_STAGE(PG8_SB(1, 0), b3, voffB);
            PG8_BAR; PG8_WAIT_L(0); PG8_MMA(0, 1, At, B1); PG8_BAR;
            PG8_LDA(At, 1, 1); PG8_STAGE(PG8_SA(1, 0), a3, voffA);
            PG8_BAR; PG8_WAIT_L(0); PG8_MMA(1, 0, At, B0); PG8_BAR; PG8_SCHED;
            PG8_STAGE(PG8_SB(1, 1), b3 + hstep, voffB);
            PG8_WAIT_V(6); PG8_BAR; PG8_MMA(1, 1, At, B1); PG8_BAR;
            }
        }
        if constexpr (ALIGN_EPI) { if (wr == 0) PG8_BAR; }
        if constexpr (!Epi::AFTER_DRAIN) { E(acc, cur, wr, wc, fr, fq, epre); S.done(cur); }
        if (!has_next) break;
#pragma unroll
        for (int a = 0; a < 2; ++a)
#pragma unroll
            for (int b = 0; b < 2; ++b)
#pragma unroll
                for (int m = 0; m < 4; ++m)
#pragma unroll
                    for (int n = 0; n < 2; ++n) acc[a][b][m][n] = (f32x4){0.f, 0.f, 0.f, 0.f};
        cur = nxt; cA = nA; cB = nB; ++ui;
        if constexpr (ALIGN_EPI) { if (wr == 1) PG8_BAR; }
    }
    PG8_WAIT_V(0);
    if constexpr (!ALIGN_EPI) { if (wr == 0) PG8_BAR; }
    PG8_BAR;
    if constexpr (Epi::AFTER_DRAIN) { E.fused(acc, cur, wr, wc, fr, fq, lds, wid, lane); S.done(cur); }
#undef PG8_SA
#undef PG8_SB
#undef PG8_STAGE
#undef PG8_LDA
#undef PG8_LDB
#undef PG8_MMA
#undef PG8_WAIT_V
#undef PG8_WAIT_L
#undef PG8_BAR
#undef PG8_SCHED
}
}

using pg8::bf16_t; using pg8::bf16x8; using pg8::f32x4; using pg8::u32x4;
#define LAS __attribute__((address_space(3)))
typedef short s16x4 __attribute__((ext_vector_type(4)));
typedef unsigned u32x2 __attribute__((ext_vector_type(2)));
constexpr int M_TOK = 81920, NP_ROWS = 16384, DM = 1024, DIN = 3072, DFF = 2816;
constexpr float RMS_EPS = 1e-6f, LOG2E = 1.4426950408889634f, QSCALE = 0.125f * 1.4426950408889634f;
constexpr size_t MiB = 1u << 20;
constexpr size_t WS_WIN = 0, WS_WOUT = 12 * MiB, WS_WGU = 16 * MiB, WS_WDN = 38 * MiB, WS_COS = 49 * MiB, WS_SIN = 50 * MiB, WS_RS = 51 * MiB,
                 WS_XB = 52 * MiB, WS_MIXED = 212 * MiB, WS_Y = 372 * MiB, WS_PROJ = 532 * MiB, WS_H = 532 * MiB, WS_CTL = 1012 * MiB, CTL_BYTES = 53248, WS_QCTR = WS_CTL + 16384, WS_CNT1 = WS_CTL + 32768, WS_X1 = 1013 * MiB, WS_END = 1015 * MiB;
constexpr size_t M64 = (size_t)M_TOK * 64;
constexpr size_t PB_QD = 0, PB_KD = 6 * M64, PB_VD = 12 * M64, PB_QN = 18 * M64, PB_KN = 22 * M64, PB_VN = 26 * M64, PB_CV = 30 * M64;
constexpr int DCV = 1152;
constexpr int LDS_BYTES = 147456;
constexpr int NWAVES = 8;

struct Params {
    const float *x_p, *x_s, *g_pre_mix, *w_in, *conv_w, *rpb, *w_out, *g_post_mix, *g_pre_ffn, *w_gate, *w_up, *w_down, *g_post_ffn;
    float* out; unsigned char* ws;
};

typedef float f32x2_t __attribute__((ext_vector_type(2)));
typedef __bf16 bf16x2_t __attribute__((ext_vector_type(2)));
__device__ __forceinline__ unsigned pk_bf16(float lo, float hi) { const f32x2_t v = {lo, hi}; const bf16x2_t b = __builtin_convertvector(v, bf16x2_t); return __builtin_bit_cast(unsigned, b); }
__device__ __forceinline__ float bf_lo(unsigned w) { return __uint_as_float(w << 16); }
__device__ __forceinline__ float bf_hi(unsigned w) { return __uint_as_float(w & 0xffff0000u); }
__device__ __forceinline__ float wave_sum(float v) {
#pragma unroll
    for (int o = 1; o < 64; o <<= 1) v += __shfl_xor(v, o);
    return v;
}
__device__ __forceinline__ void seq_of_row(int row, int& S, int& seq0) {
    if (row < NP_ROWS) { S = 2048; seq0 = row & ~2047; } else { S = 8192; seq0 = NP_ROWS + ((row - NP_ROWS) & ~8191); }
}

__device__ __forceinline__ int rs_idx(int row) { return (row & ~31) | ((row & 15) << 1) | ((row >> 4) & 1); }
__device__ __forceinline__ void rs_store(unsigned short* rsb, int row, float v) { rsb[rs_idx(row)] = (unsigned short)(pk_bf16(v, v) & 0xffffu); }
__device__ __forceinline__ void rs_prefetch(unsigned (&pre)[4], const unsigned short* rsb, int pm, int wr, int fr) {
    const unsigned* r32 = (const unsigned*)rsb;
#pragma unroll
    for (int i = 0; i < 4; ++i) pre[i] = r32[((pm * 256 + wr * 64 + (i >> 1) * 128 + (i & 1) * 32) >> 1) + fr];
}
__device__ __forceinline__ float rs_get(const unsigned (&pre)[4], int ai, int m) { const unsigned w = pre[ai * 2 + (m >> 1)]; return (m & 1) ? bf_hi(w) : bf_lo(w); }
struct EpiProj {
    static constexpr bool PERM = true, AFTER_DRAIN = false;
    bf16_t* O; const unsigned short* rs; const unsigned* cs;
    __device__ __forceinline__ void prefetch(unsigned (&pre)[4], const pg8::Unit& u, int wr, int fr) const { rs_prefetch(pre, rs, u.pm, wr, fr); }
    __device__ __forceinline__ void operator()(const f32x4 (&acc)[2][2][4][2], const pg8::Unit& u, int wr, int wc, int fr, int fq, const unsigned (&pre)[4]) const {
        const int row0 = u.pm * 256 + wr * 64 + fr;
        const int p4 = ((4 * wc + fq) & 7) * 4;
        const unsigned* __restrict__ cs = this->cs; bf16_t* __restrict__ O = this->O;
#pragma unroll
        for (int ai = 0; ai < 2; ++ai)
#pragma unroll
            for (int m = 0; m < 4; ++m) {
                if (m == 0 && ai == 1) asm volatile("" ::: "memory");
                const int row = row0 + ai * 128 + m * 16; const float r = rs_get(pre, ai, m);
                const int pos = row < NP_ROWS ? (row & 2047) : ((row - NP_ROWS) & 8191);
#pragma unroll
                for (int bj = 0; bj < 2; ++bj) {
                    const int cb = 2 * u.pn + bj;
                    bf16_t* dst;
                    if (cb < 15) { const int hl = wc >> 1; size_t tb; int head;
                        if (cb < 3) { tb = PB_QD; head = 2 * cb + hl; } else if (cb < 6) { tb = PB_KD; head = 2 * (cb - 3) + hl; } else if (cb < 9) { tb = PB_VD; head = 2 * (cb - 6) + hl; }
                        else if (cb < 11) { tb = PB_QN; head = 2 * (cb - 9) + hl; } else if (cb < 13) { tb = PB_KN; head = 2 * (cb - 11) + hl; } else { tb = PB_VN; head = 2 * (cb - 13) + hl; }
                        dst = O + tb + ((size_t)head * M_TOK + row) * 64 + 32 * (wc & 1) + 8 * fq;
                    } else dst = O + PB_CV + (size_t)row * DCV + 128 * (cb - 15) + 32 * wc + 8 * fq;
                    f32x4 v0 = acc[ai][bj][m][0] * r, v1 = acc[ai][bj][m][1] * r;
                    if (cb < 6) {
                        const u32x4 t4 = *(const u32x4*)(cs + pos * 32 + p4);
                        const f32x4 c4 = (f32x4){bf_lo(t4.x), bf_lo(t4.y), bf_lo(t4.z), bf_lo(t4.w)}, s4 = (f32x4){bf_hi(t4.x), bf_hi(t4.y), bf_hi(t4.z), bf_hi(t4.w)};
                        const f32x4 n0 = v0 * c4 - v1 * s4, n1 = v0 * s4 + v1 * c4; v0 = n0; v1 = n1;
                    }
                    if (cb < 3 || cb == 9 || cb == 10) { v0 = v0 * QSCALE; v1 = v1 * QSCALE; }
                    u32x4 w; w.x = pk_bf16(v0[0], v0[1]); w.y = pk_bf16(v0[2], v0[3]); w.z = pk_bf16(v1[0], v1[1]); w.w = pk_bf16(v1[2], v1[3]);
                    *(u32x4*)dst = w;
                }
            }
    }
};
struct EpiPlain {
    static constexpr bool PERM = true, AFTER_DRAIN = false;
    bf16_t* O; int ldc;
    __device__ __forceinline__ void prefetch(unsigned (&)[4], const pg8::Unit&, int, int) const {}
    __device__ __forceinline__ void operator()(const f32x4 (&acc)[2][2][4][2], const pg8::Unit& u, int wr, int wc, int fr, int fq, const unsigned (&)[4]) const {
        const int row0 = u.pm * 256 + wr * 64 + fr, col0 = u.pn * 256 + wc * 32 + 8 * fq;
#pragma unroll
        for (int ai = 0; ai < 2; ++ai)
#pragma unroll
            for (int m = 0; m < 4; ++m) {
                bf16_t* rowp = O + (size_t)(row0 + ai * 128 + m * 16) * ldc + col0;
#pragma unroll
                for (int bj = 0; bj < 2; ++bj) {
                    const f32x4 v0 = acc[ai][bj][m][0], v1 = acc[ai][bj][m][1];
                    u32x4 w; w.x = pk_bf16(v0[0], v0[1]); w.y = pk_bf16(v0[2], v0[3]); w.z = pk_bf16(v1[0], v1[1]); w.w = pk_bf16(v1[2], v1[3]);
                    *(u32x4*)(rowp + bj * 128) = w;
                }
            }
    }
};
__device__ __forceinline__ void row_exchange(float (&part)[8], float* xslots, unsigned* cnt, unsigned want, LAS unsigned char* lds, int pm, int pn, int wr, int wc, int fr, int fq) {
    LAS float* P = (LAS float*)(lds + 131072); LAS float* S = (LAS float*)(lds + 131072 + 4096);
    const int wid = wr * 4 + wc, lane = fq * 16 + fr;
#pragma unroll
    for (int i = 0; i < 8; ++i) { float s = part[i]; s += __shfl_xor(s, 16); s += __shfl_xor(s, 32); if (fq == 0) P[((i >> 2) * 128 + wr * 64 + (i & 3) * 16 + fr) * 4 + wc] = s; }
    asm volatile("s_waitcnt lgkmcnt(0)" ::: "memory"); __builtin_amdgcn_s_barrier(); asm volatile("" ::: "memory");
    const int row = wid * 32 + (lane & 31);
    if (lane < 32) { const float t = (P[row * 4 + 0] + P[row * 4 + 1]) + (P[row * 4 + 2] + P[row * 4 + 3]);
        __hip_atomic_store((unsigned*)xslots + (size_t)(pm * 256 + row) * 4 + pn, __float_as_uint(t), __ATOMIC_RELAXED, __HIP_MEMORY_SCOPE_AGENT); }
    asm volatile("s_waitcnt vmcnt(0)" ::: "memory");
    if (lane == 0) __hip_atomic_fetch_add(cnt + 16 * pm, 1u, __ATOMIC_RELAXED, __HIP_MEMORY_SCOPE_AGENT);
    if (wid == 0) {
        unsigned sp = 0;
        while ((unsigned)__builtin_amdgcn_readfirstlane(__hip_atomic_load(cnt + 16 * pm, __ATOMIC_RELAXED, __HIP_MEMORY_SCOPE_AGENT)) < want) { __builtin_amdgcn_s_sleep(1); if (++sp > (1u << 20)) break; }
        __builtin_amdgcn_fence(__ATOMIC_ACQUIRE, "agent");
    }
    asm volatile("s_waitcnt vmcnt(0) lgkmcnt(0)" ::: "memory"); __builtin_amdgcn_s_barrier(); asm volatile("" ::: "memory");
    if (lane < 32) { const unsigned* sl = (const unsigned*)xslots + (size_t)(pm * 256 + row) * 4; float tot = 0.f;
#pragma unroll
        for (int t = 0; t < 4; ++t) tot += __uint_as_float(__hip_atomic_load(sl + t, __ATOMIC_RELAXED, __HIP_MEMORY_SCOPE_AGENT));
        S[row] = 1.0f / sqrtf(tot * (1.0f / DM) + RMS_EPS); }
    asm volatile("s_waitcnt lgkmcnt(0)" ::: "memory"); __builtin_amdgcn_s_barrier(); asm volatile("" ::: "memory");
#pragma unroll
    for (int i = 0; i < 8; ++i) part[i] = S[(i >> 2) * 128 + wr * 64 + (i & 3) * 16 + fr];
}
struct EpiNormOut {
    static constexpr bool PERM = true, AFTER_DRAIN = false;
    unsigned char* ws; float* out; const float* g; LAS unsigned char* lds;
    __device__ __forceinline__ void prefetch(unsigned (&)[4], const pg8::Unit&, int, int) const {}
    __device__ __forceinline__ void operator()(f32x4 (&acc)[2][2][4][2], const pg8::Unit& u, int wr, int wc, int fr, int fq, const unsigned (&)[4]) const {
        const int row0 = u.pm * 256 + wr * 64 + fr, col0 = u.pn * 256 + wc * 32 + 8 * fq;
        const bf16_t* xb = (const bf16_t*)(ws + WS_XB);
        float part[8];
#pragma unroll
        for (int i = 0; i < 8; ++i) { float s = 0.f;
#pragma unroll
            for (int bj = 0; bj < 2; ++bj)
#pragma unroll
                for (int n = 0; n < 2; ++n) { const f32x4 v = acc[i >> 2][bj][i & 3][n]; s += (v[0] * v[0] + v[1] * v[1]) + (v[2] * v[2] + v[3] * v[3]); }
            part[i] = s; }
        row_exchange(part, (float*)(ws + WS_X1), (unsigned*)(ws + WS_CNT1), 32u, lds, u.pm, u.pn, wr, wc, fr, fq);
#pragma unroll
        for (int i = 0; i < 8; ++i) { const int ai = i >> 2, m = i & 3; const size_t off = (size_t)(row0 + ai * 128 + m * 16) * DM + col0; const float r = part[i];
#pragma unroll
            for (int bj = 0; bj < 2; ++bj) { const u32x4 xw = __builtin_nontemporal_load((const u32x4*)(xb + off + bj * 128));
                const f32x4 g0 = *(const f32x4*)(g + col0 + bj * 128), g1 = *(const f32x4*)(g + col0 + bj * 128 + 4);
                const f32x4 v0 = (f32x4){bf_lo(xw.x), bf_hi(xw.x), bf_lo(xw.y), bf_hi(xw.y)} + acc[ai][bj][m][0] * r * g0;
                const f32x4 v1 = (f32x4){bf_lo(xw.z), bf_hi(xw.z), bf_lo(xw.w), bf_hi(xw.w)} + acc[ai][bj][m][1] * r * g1;
                float* orow = out + off + bj * 128; __builtin_nontemporal_store(v0, (f32x4*)orow); __builtin_nontemporal_store(v1, (f32x4*)(orow + 4)); }
            if ((i & 3) == 3) asm volatile("" ::: "memory"); }
    }
};
__device__ __forceinline__ float silu_mul(float g, float u) { return g * __builtin_amdgcn_rcpf(1.0f + __builtin_amdgcn_exp2f(-g * LOG2E)) * u; }
struct EpiSwiglu {
    static constexpr bool PERM = true, AFTER_DRAIN = false;
    bf16_t* O; const unsigned short* rs;
    __device__ __forceinline__ void prefetch(unsigned (&pre)[4], const pg8::Unit& u, int wr, int fr) const { rs_prefetch(pre, rs, u.pm, wr, fr); }
    __device__ __forceinline__ void operator()(const f32x4 (&acc)[2][2][4][2], const pg8::Unit& u, int wr, int wc, int fr, int fq, const unsigned (&pre)[4]) const {
        const int row0 = u.pm * 256 + wr * 64 + fr, col0 = u.pn * 128 + wc * 32 + 8 * fq;
#pragma unroll
        for (int ai = 0; ai < 2; ++ai)
#pragma unroll
            for (int m = 0; m < 4; ++m) {
                const int row = row0 + ai * 128 + m * 16; const float r = rs_get(pre, ai, m);
                const f32x4 g0 = acc[ai][0][m][0] * r, g1 = acc[ai][0][m][1] * r, u0 = acc[ai][1][m][0] * r, u1 = acc[ai][1][m][1] * r;
                u32x4 w; w.x = pk_bf16(silu_mul(g0[0], u0[0]), silu_mul(g0[1], u0[1])); w.y = pk_bf16(silu_mul(g0[2], u0[2]), silu_mul(g0[3], u0[3]));
                w.z = pk_bf16(silu_mul(g1[0], u1[0]), silu_mul(g1[1], u1[1])); w.w = pk_bf16(silu_mul(g1[2], u1[2]), silu_mul(g1[3], u1[3]));
                *(u32x4*)(O + (size_t)row * DFF + col0) = w;
            }
    }
};

__device__ __forceinline__ void wt_item(const float* __restrict__ W, int ldw, int srccol, const float* __restrict__ gain, bf16_t* __restrict__ WT, int K, int n0, int k0, LAS float* scr, int lane) {
#pragma unroll 8
    for (int i = 0; i < 32; ++i) { const int kk = 2 * i + (lane >> 5); float v = W[(size_t)(k0 + kk) * ldw + srccol]; if (gain) v *= gain[k0 + kk]; scr[kk * 33 + (lane & 31)] = v; }
    asm volatile("s_waitcnt lgkmcnt(0)" ::: "memory");
    const int c = lane & 7;
#pragma unroll
    for (int j = 0; j < 4; ++j) { const int n = (lane >> 3) + 8 * j; const LAS float* s = scr + (8 * c) * 33 + n;
        u32x4 o; o.x = pk_bf16(s[0 * 33], s[1 * 33]); o.y = pk_bf16(s[2 * 33], s[3 * 33]); o.z = pk_bf16(s[4 * 33], s[5 * 33]); o.w = pk_bf16(s[6 * 33], s[7 * 33]);
        *(u32x4*)(WT + (size_t)(n0 + n) * K + k0 + 8 * c) = o; }
    asm volatile("s_waitcnt lgkmcnt(0)" ::: "memory");
}
__device__ __forceinline__ void prologue(const Params& p, LAS unsigned char* lds, int tid, int lane, int wave) {
    unsigned char* ws = p.ws;
    LAS float* scr = (LAS float*)(lds + wave * 16384);
    const int gw = blockIdx.x * NWAVES + wave, NGW = gridDim.x * NWAVES;
    constexpr int I_IN = 16 * 96, I_OUT = 16 * 32, I_GU = 16 * 176, I_DN = 44 * 32, I_L = I_IN + I_OUT + I_GU + I_DN;
    for (int it = gw; it < 2 * I_L; it += NGW) {
        const int l = it / I_L; int r = it - l * I_L; const int n = lane & 31;
        if (r < I_IN) { const int kb = r / 96, nb = r % 96, n0 = 32 * nb; const int ph = n0 + n; int src = ph;
            if (ph < 768) { const int fl = ph & 63; src = (ph & ~63) + 32 * ((fl >> 2) & 1) + 4 * (fl >> 3) + (fl & 3); }
            wt_item(p.w_in + (size_t)l * DM * DIN, DIN, src, p.g_pre_mix + l * DM, (bf16_t*)(ws + WS_WIN) + (size_t)l * DIN * DM, DM, n0, 64 * kb, scr, lane); continue; }
        r -= I_IN;
        if (r < I_OUT) { const int kb = r / 32, nb = r % 32, n0 = 32 * nb;
            wt_item(p.w_out + (size_t)l * DM * DM, DM, n0 + n, nullptr, (bf16_t*)(ws + WS_WOUT) + (size_t)l * DM * DM, DM, n0, 64 * kb, scr, lane); continue; }
        r -= I_OUT;
        if (r < I_GU) { const int kb = r / 176, nb = r % 176, n0 = 32 * nb, pn = n0 >> 8, cc = n0 & 255;
            const float* W = (cc < 128 ? p.w_gate : p.w_up) + (size_t)l * DM * DFF;
            wt_item(W, DFF, 128 * pn + (cc & 127) + n, p.g_pre_ffn + l * DM, (bf16_t*)(ws + WS_WGU) + (size_t)l * 2 * DFF * DM, DM, n0, 64 * kb, scr, lane); continue; }
        r -= I_GU;
        { const int kb = r / 32, nb = r % 32, n0 = 32 * nb;
            wt_item(p.w_down + (size_t)l * DFF * DM, DM, n0 + n, nullptr, (bf16_t*)(ws + WS_WDN) + (size_t)l * DM * DFF, DFF, n0, 64 * kb, scr, lane); }
    }
    { unsigned* cs = (unsigned*)(ws + WS_COS);
      for (int idx = blockIdx.x * 512 + tid; idx < 8192 * 32; idx += gridDim.x * 512) {
          const int pos = idx >> 5, i = idx & 31; double inv = 1.0; for (int k = 0; k < i; ++k) inv *= 0.7498942093324559;
          double rev = (double)pos * inv * 0.15915494309189535; rev -= __builtin_rint(rev);
          const float f = (float)rev; cs[idx] = pk_bf16(__builtin_amdgcn_cosf(f), __builtin_amdgcn_sinf(f)); } }
    { bf16_t* xb = (bf16_t*)(ws + WS_XB); unsigned short* rs = (unsigned short*)(ws + WS_RS);
      for (int row = gw; row < M_TOK; row += NGW) {
          const float* xr = row < NP_ROWS ? p.x_p + (size_t)row * DM : p.x_s + (size_t)(row - NP_ROWS) * DM;
          f32x4 v[4]; float ss = 0.f;
#pragma unroll
          for (int j = 0; j < 4; ++j) { v[j] = ((const f32x4*)xr)[64 * j + lane]; ss += (v[j][0] * v[j][0] + v[j][1] * v[j][1]) + (v[j][2] * v[j][2] + v[j][3] * v[j][3]); }
          ss = wave_sum(ss);
          u32x2* o8 = (u32x2*)(xb + (size_t)row * DM);
#pragma unroll
          for (int j = 0; j < 4; ++j) { u32x2 w; w.x = pk_bf16(v[j][0], v[j][1]); w.y = pk_bf16(v[j][2], v[j][3]); o8[64 * j + lane] = w; }
          if (lane == 0) rs_store(rs, row, 1.0f / sqrtf(ss * (1.0f / DM) + RMS_EPS));
      } }
}

template <bool FINAL>
__device__ __forceinline__ void ew_phase(const Params& p, const float* __restrict__ g, int lane, int wave) {
    unsigned char* ws = p.ws; const bf16_t* Y = (const bf16_t*)(ws + WS_Y); bf16_t* xb = (bf16_t*)(ws + WS_XB); unsigned short* rs = (unsigned short*)(ws + WS_RS);
    const int gw = blockIdx.x * NWAVES + wave, NGW = gridDim.x * NWAVES;
    f32x4 gv[4];
#pragma unroll
    for (int j = 0; j < 4; ++j) gv[j] = ((const f32x4*)g)[64 * j + lane];
    u32x2 yq[2][4], xq[2][4];
#pragma unroll
    for (int d = 0; d < 2; ++d) { int r0 = gw + d * NGW; r0 = r0 < M_TOK ? r0 : gw;
#pragma unroll
        for (int j = 0; j < 4; ++j) { yq[d][j] = ((const u32x2*)(Y + (size_t)r0 * DM))[64 * j + lane]; xq[d][j] = ((const u32x2*)(xb + (size_t)r0 * DM))[64 * j + lane]; } }
    for (int row = gw; row < M_TOK; row += NGW) {
        u32x2* xr = (u32x2*)(xb + (size_t)row * DM);
        u32x2 yc[4], xc[4];
#pragma unroll
        for (int j = 0; j < 4; ++j) { yc[j] = yq[0][j]; xc[j] = xq[0][j]; yq[0][j] = yq[1][j]; xq[0][j] = xq[1][j]; }
        { int r2 = row + 2 * NGW; r2 = r2 < M_TOK ? r2 : row;
#pragma unroll
          for (int j = 0; j < 4; ++j) { yq[1][j] = ((const u32x2*)(Y + (size_t)r2 * DM))[64 * j + lane]; xq[1][j] = ((const u32x2*)(xb + (size_t)r2 * DM))[64 * j + lane]; } }
        f32x4 xv[4], yf[4]; float ss = 0.f;
#pragma unroll
        for (int j = 0; j < 4; ++j) { const u32x2 w = yc[j], xw = xc[j];
            xv[j] = (f32x4){bf_lo(xw.x), bf_hi(xw.x), bf_lo(xw.y), bf_hi(xw.y)};
            yf[j] = (f32x4){bf_lo(w.x), bf_hi(w.x), bf_lo(w.y), bf_hi(w.y)}; ss += (yf[j][0] * yf[j][0] + yf[j][1] * yf[j][1]) + (yf[j][2] * yf[j][2] + yf[j][3] * yf[j][3]); }
        ss = wave_sum(ss); const float r = 1.0f / sqrtf(ss * (1.0f / DM) + RMS_EPS);
        float s2 = 0.f;
#pragma unroll
        for (int j = 0; j < 4; ++j) { const f32x4 xn = xv[j] + yf[j] * r * gv[j]; xv[j] = xn; s2 += (xn[0] * xn[0] + xn[1] * xn[1]) + (xn[2] * xn[2] + xn[3] * xn[3]); }
        if (FINAL) { float* orow = p.out + (size_t)row * DM;
#pragma unroll
            for (int j = 0; j < 4; ++j) ((f32x4*)orow)[64 * j + lane] = xv[j];
        } else {
            s2 = wave_sum(s2);
#pragma unroll
            for (int j = 0; j < 4; ++j) { u32x2 w; w.x = pk_bf16(xv[j][0], xv[j][1]); w.y = pk_bf16(xv[j][2], xv[j][3]); xr[64 * j + lane] = w; }
            if (lane == 0) rs_store(rs, row, 1.0f / sqrtf(s2 * (1.0f / DM) + RMS_EPS));
        }
    }
}

__device__ __forceinline__ bf16x8 ld8(const bf16_t* p) { return *(const bf16x8*)p; }
__device__ __forceinline__ void attn_store(bf16_t* orow, const f32x4 (&o)[4], float l, int fq) {
    l += __shfl_xor(l, 16); l += __shfl_xor(l, 32);
    const float inv = 1.0f / l;
#pragma unroll
    for (int c = 0; c < 4; ++c) { u32x2 w; w.x = pk_bf16(o[c][0] * inv, o[c][1] * inv); w.y = pk_bf16(o[c][2] * inv, o[c][3] * inv); *(u32x2*)(orow + 16 * c + 4 * fq) = w; }
}

struct PairRegs { bf16x8 k[2][2]; u32x4 v[2][2]; };

template <int NG> struct DilU { int seq0, L, r, u0, h; };
template <int D, int NG>
__device__ __forceinline__ DilU<NG> dilu_params(int item) {
    constexpr int CH = 16 * NG;
    DilU<NG> P; P.h = item % 6; const int cidx = item / 6, row0g = cidx * CH;
    int S; seq_of_row(row0g, S, P.seq0);
    constexpr int LG_CH = (CH == 16) ? 4 : (CH == 32) ? 5 : 6, LG_D = (D == 1) ? 0 : (D == 4) ? 2 : 4;
    const int lc = (row0g - P.seq0) >> LG_CH, lgLc = ((S == 2048) ? 11 : 13) - LG_D - LG_CH;
    P.L = S >> LG_D; P.r = lc >> lgLc; P.u0 = (lc & ((1 << lgLc) - 1)) << LG_CH;
    return P;
}
template <int D, int NG>
__device__ __forceinline__ void dilu_load(PairRegs& R, int p, const DilU<NG>& P, const bf16_t* proj, unsigned kofs, unsigned vofs) {
    const int rb = P.h * M_TOK + P.seq0 + P.r;
#pragma unroll
    for (int ab = 0; ab < 2; ++ab) {
        int x0 = P.u0 - 64 + 16 * (2 * p + ab); x0 = x0 < 0 ? 0 : (x0 > P.L - 16 ? P.L - 16 : x0);
        const size_t tb = (size_t)(rb + x0 * D) * 128;
        const char* kb = (const char*)(proj + PB_KD) + tb; const char* vb = (const char*)(proj + PB_VD) + tb;
        R.k[ab][0] = *(const bf16x8*)(kb + kofs); R.k[ab][1] = *(const bf16x8*)(kb + kofs + 64);
        R.v[ab][0] = *(const u32x4*)(vb + vofs); R.v[ab][1] = *(const u32x4*)(vb + vofs + 8 * D * 128);
    }
}
template <int D, int NG, int MODE, int PFD>
__device__ __forceinline__ void dilu_stream(const bf16_t* __restrict__ proj, bf16_t* __restrict__ mixed, bf16_t* __restrict__ ACC, float* __restrict__ LACC, LAS unsigned char* vst, unsigned* ctr, int xcd, int lane) {
    constexpr int NP = (NG + 9) / 2, NPV = ((NP + PFD - 1) / PFD) * PFD, CH = 16 * NG, NITEMS = (M_TOK / CH) * 6, PER = NITEMS / 8;
    static_assert(PFD - 1 <= NP, "ring prologue loads real pairs only");
#define DQ_TICKET(v) do { v = 0u; if (lane == 0) v = __hip_atomic_fetch_add(ctr, 1u, __ATOMIC_RELAXED, __HIP_MEMORY_SCOPE_AGENT); } while (0)
    const int base = xcd * PER;
    unsigned tk0, tk1; DQ_TICKET(tk0); DQ_TICKET(tk1);
    const int first = (int)__builtin_amdgcn_readfirstlane(tk0);
    if (first >= PER) return;
    int nxt = (int)__builtin_amdgcn_readfirstlane(tk1);
    const int fr = lane & 15, fq = lane >> 4, vr = lane >> 3, dlt = 4 * fq - fr;
    const unsigned kofs = (unsigned)((fr * D) * 128 + fq * 16), vofs = (unsigned)((vr * D) * 128 + (lane & 7) * 16);
    const unsigned wofs = vr * 160 + (lane & 7) * 16, trofs = (4 * fq + ((lane & 15) >> 2)) * 160 + (lane & 3) * 8;
    int it = base + first, par = 0;
    DilU<NG> P = dilu_params<D, NG>(it);
    PairRegs ring[PFD];
    bf16x8 q[NG][2];
#pragma unroll
    for (int g = 0; g < NG; ++g) { const bf16_t* qp = proj + PB_QD + (size_t)((P.h * M_TOK + P.seq0 + P.r + (P.u0 + 16 * g + fr) * D) * 64 + 8 * fq); q[g][0] = ld8(qp); q[g][1] = ld8(qp + 32); }
#pragma unroll
    for (int s = 0; s < PFD - 1; ++s) dilu_load<D, NG>(ring[s], s, P, proj, kofs, vofs);
    for (;;) {
        const bool has_next = nxt < PER; const int itn = base + nxt;
        unsigned tkn; DQ_TICKET(tkn);
        const DilU<NG> PN = dilu_params<D, NG>(has_next ? itn : it);
        bf16x8 qn[NG][2];
#pragma unroll
        for (int g = 0; g < NG; ++g) { const bf16_t* qp = proj + PB_QD + (size_t)((PN.h * M_TOK + PN.seq0 + PN.r + (PN.u0 + 16 * g + fr) * D) * 64 + 8 * fq); qn[g][0] = ld8(qp); qn[g][1] = ld8(qp + 32); }
        u32x2 pacc[NG][4]; float pl[NG];
        if (MODE != 0) {
#pragma unroll
            for (int g = 0; g < NG; ++g) { const int rowq = P.seq0 + P.r + (P.u0 + 16 * g + fr) * D; const bf16_t* ap = ACC + (size_t)(rowq * 6 + P.h) * 64 + 4 * fq;
#pragma unroll
                for (int c = 0; c < 4; ++c) pacc[g][c] = *(const u32x2*)(ap + 16 * c);
                pl[g] = LACC[rowq * 6 + P.h]; }
        }
        f32x4 o[NG][4]; float l[NG];
#pragma unroll
        for (int g = 0; g < NG; ++g) { l[g] = 0.f;
#pragma unroll
            for (int c = 0; c < 4; ++c) o[g][c] = (f32x4){0.f, 0.f, 0.f, 0.f}; }
#pragma unroll
        for (int p = 0; p < NPV; ++p) {
            const int m = p + PFD - 1;
            if (m < NPV) { if (m < NP) dilu_load<D, NG>(ring[m % PFD], m, P, proj, kofs, vofs); }
            else { if (m - NPV < NP) dilu_load<D, NG>(ring[m % PFD], m - NPV, PN, proj, kofs, vofs); }
            if (p >= NP) continue;
            const PairRegs& R = ring[p % PFD];
            LAS unsigned char* vbuf = vst + (((p & 1) ^ par) * 5120);
#pragma unroll
            for (int ab = 0; ab < 2; ++ab) { *(LAS u32x4*)(vbuf + ab * 2560 + wofs) = R.v[ab][0]; *(LAS u32x4*)(vbuf + ab * 2560 + wofs + 8 * 160) = R.v[ab][1]; }
            asm volatile("s_waitcnt lgkmcnt(0)" ::: "memory");
            bf16x8 vt[4];
#pragma unroll
            for (int c = 0; c < 4; ++c) {
                const s16x4 ta = __builtin_amdgcn_ds_read_tr16_b64_v4i16((LAS s16x4*)(vbuf + trofs + c * 32));
                const s16x4 tb = __builtin_amdgcn_ds_read_tr16_b64_v4i16((LAS s16x4*)(vbuf + 2560 + trofs + c * 32));
                vt[c] = (bf16x8){ta[0], ta[1], ta[2], ta[3], tb[0], tb[1], tb[2], tb[3]};
            }
            bool tok[2];
#pragma unroll
            for (int ab = 0; ab < 2; ++ab) { const int x0 = P.u0 - 64 + 16 * (2 * p + ab); tok[ab] = (x0 >= 0 && x0 < P.L); }
#pragma unroll
            for (int g = 0; g < NG; ++g) {
                const int dja = 2 * p - g, djb = 2 * p + 1 - g;
                const bool acta = dja >= 0 && dja <= 8, actb = djb >= 0 && djb <= 8;
                if (!acta && !actb) continue;
                f32x4 pr[2];
#pragma unroll
                for (int ab = 0; ab < 2; ++ab) {
                    const int dj = ab ? djb : dja; const bool act = ab ? actb : acta;
                    if (!act) { pr[ab] = (f32x4){0.f, 0.f, 0.f, 0.f}; continue; }
                    f32x4 s = {0.f, 0.f, 0.f, 0.f};
                    s = __builtin_amdgcn_mfma_f32_16x16x32_bf16(R.k[ab][0], q[g][0], s, 0, 0, 0);
                    s = __builtin_amdgcn_mfma_f32_16x16x32_bf16(R.k[ab][1], q[g][1], s, 0, 0, 0);
#pragma unroll
                    for (int e = 0; e < 4; ++e) {
                        float ex = __builtin_amdgcn_exp2f(s[e]);
                        bool ok = tok[ab];
                        if (dj == 0) ok = ok && (dlt + e >= 0);
                        if (dj == 8) ok = ok && (dlt + e <= 0);
                        ex = ok ? ex : 0.f;
                        pr[ab][e] = ex; l[g] += ex;
                    }
                }
                union { u32x4 u; bf16x8 h; } pp; pp.u.x = pk_bf16(pr[0][0], pr[0][1]); pp.u.y = pk_bf16(pr[0][2], pr[0][3]); pp.u.z = pk_bf16(pr[1][0], pr[1][1]); pp.u.w = pk_bf16(pr[1][2], pr[1][3]);
#pragma unroll
                for (int c = 0; c < 4; ++c) o[g][c] = __builtin_amdgcn_mfma_f32_16x16x32_bf16(vt[c], pp.h, o[g][c], 0, 0, 0);
            }
        }
#pragma unroll
        for (int g = 0; g < NG; ++g) {
            float lg = l[g]; lg += __shfl_xor(lg, 16); lg += __shfl_xor(lg, 32);
            const int rowq = P.seq0 + P.r + (P.u0 + 16 * g + fr) * D;
            bf16_t* ap = ACC + (size_t)(rowq * 6 + P.h) * 64 + 4 * fq; float* lp = LACC + rowq * 6 + P.h;
            if (MODE == 0) {
#pragma unroll
                for (int c = 0; c < 4; ++c) { u32x2 w; w.x = pk_bf16(o[g][c][0], o[g][c][1]); w.y = pk_bf16(o[g][c][2], o[g][c][3]); *(u32x2*)(ap + 16 * c) = w; }
                if (fq == 0) *lp = lg;
            } else if (MODE == 1) {
#pragma unroll
                for (int c = 0; c < 4; ++c) { const u32x2 pw = pacc[g][c]; const f32x4 t = (f32x4){bf_lo(pw.x), bf_hi(pw.x), bf_lo(pw.y), bf_hi(pw.y)} + o[g][c];
                    u32x2 w; w.x = pk_bf16(t[0], t[1]); w.y = pk_bf16(t[2], t[3]); *(u32x2*)(ap + 16 * c) = w; }
                if (fq == 0) *lp = pl[g] + lg;
            } else {
                const float inv = 1.0f / (pl[g] + lg);
                bf16_t* orow = mixed + (size_t)rowq * DM + P.h * 64 + 4 * fq;
#pragma unroll
                for (int c = 0; c < 4; ++c) { const u32x2 pw = pacc[g][c]; const f32x4 t = ((f32x4){bf_lo(pw.x), bf_hi(pw.x), bf_lo(pw.y), bf_hi(pw.y)} + o[g][c]) * inv; u32x2 w; w.x = pk_bf16(t[0], t[1]); w.y = pk_bf16(t[2], t[3]); *(u32x2*)(orow + 16 * c) = w; }
            }
        }
        if (!has_next) break;
        it = itn; nxt = (int)__builtin_amdgcn_readfirstlane(tkn); P = PN; par ^= (NP & 1);
#pragma unroll
        for (int g = 0; g < NG; ++g) { q[g][0] = qn[g][0]; q[g][1] = qn[g][1]; }
    }
}

#ifndef CFG_NG
#define CFG_NG 2
#define CFG_PF 2
#endif
#undef DQ_TICKET
struct Na2P { int kvrow; const bf16_t* qp; const LAS float* bb; int rs0, rows, kc0, qc, cs, orow, h, d1; };
__device__ __forceinline__ Na2P na2_params(const bf16_t* proj, const LAS float* tbl, int item, int lane) {
    Na2P P; const int fr = lane & 15, fq = lane >> 4;
    int S, t; if (item < 8 * 16 * 16) { S = 2048; t = item; } else { S = 8192; t = item - 8 * 16 * 16; }
    const int rows = S >> 6, per = (rows >> 1) * 16, seq = t / per, u = t - seq * per, rp = u >> 4, cb = u & 3; P.h = (u >> 2) & 3;
    const int seq0 = (S == 2048) ? seq * 2048 : NP_ROWS + seq * 8192, r = 2 * rp;
    int rs0 = r - 4; rs0 = rs0 < 0 ? 0 : (rs0 > rows - 8 ? rows - 8 : rs0);
    int rs1 = r - 3; rs1 = rs1 < 0 ? 0 : (rs1 > rows - 8 ? rows - 8 : rs1);
    P.rs0 = rs0; P.rows = rows; P.d1 = rs1 - rs0;
    int kc0 = 16 * cb - 8; kc0 = kc0 < 0 ? 0 : (kc0 > 32 ? 32 : kc0); P.kc0 = kc0;
    P.qc = 16 * cb + fr; int cs = P.qc - 8; cs = cs < 0 ? 0 : (cs > 48 ? 48 : cs); P.cs = cs;
    P.kvrow = P.h * M_TOK + seq0 + kc0;
    P.orow = seq0 + r * 64 + P.qc;
    P.qp = proj + PB_QN + ((size_t)P.h * M_TOK + P.orow) * 64 + 8 * fq;
    P.bb = tbl + P.h * 465 + (rs0 - r + 7) * 31;
    return P;
}
__device__ __forceinline__ void na2_load(PairRegs& R, int n, const Na2P& P, const bf16_t* proj, unsigned kofs, unsigned vofs) {
    int kr = P.rs0 + n; kr = kr > P.rows - 1 ? P.rows - 1 : kr;
#pragma unroll
    for (int hh = 0; hh < 2; ++hh) {
        const size_t tb = (size_t)(P.kvrow + kr * 64 + 16 * hh) * 128;
        const char* kb = (const char*)(proj + PB_KN) + tb; const char* vb = (const char*)(proj + PB_VN) + tb;
        R.k[hh][0] = *(const bf16x8*)(kb + kofs); R.k[hh][1] = *(const bf16x8*)(kb + kofs + 64);
        R.v[hh][0] = *(const u32x4*)(vb + vofs); R.v[hh][1] = *(const u32x4*)(vb + vofs + 8 * 128);
    }
}
template <int PFD>
__device__ __forceinline__ void na2_stream(const bf16_t* __restrict__ proj, bf16_t* __restrict__ mixed, LAS unsigned char* vst, const LAS float* tbl, int first, int stride, int lane) {
    constexpr int NP = 9, NPV = ((NP + PFD - 1) / PFD) * PFD, NITEMS = (M_TOK / 128) * 16;
    if (first >= NITEMS) return;
    const int fr = lane & 15, fq = lane >> 4, vr = lane >> 3;
    const unsigned kofs = (unsigned)(fr * 128 + fq * 16), vofs = (unsigned)(vr * 128 + (lane & 7) * 16);
    const unsigned wofs = vr * 160 + (lane & 7) * 16, trofs = (4 * fq + ((lane & 15) >> 2)) * 160 + (lane & 3) * 8;
    int it = first;
    Na2P P = na2_params(proj, tbl, it, lane);
    PairRegs ring[PFD];
    bf16x8 q[2][2];
#pragma unroll
    for (int g = 0; g < 2; ++g) { q[g][0] = ld8(P.qp + g * 4096); q[g][1] = ld8(P.qp + g * 4096 + 32); }
#pragma unroll
    for (int s = 0; s < PFD - 1; ++s) na2_load(ring[s], s, P, proj, kofs, vofs);
    for (;;) {
        const int itn = it + stride; const bool has_next = itn < NITEMS;
        const Na2P PN = na2_params(proj, tbl, has_next ? itn : it, lane);
        bf16x8 qn[2][2];
#pragma unroll
        for (int g = 0; g < 2; ++g) { qn[g][0] = ld8(PN.qp + g * 4096); qn[g][1] = ld8(PN.qp + g * 4096 + 32); }
        f32x4 o[2][4]; float l[2];
#pragma unroll
        for (int g = 0; g < 2; ++g) { l[g] = 0.f;
#pragma unroll
            for (int c = 0; c < 4; ++c) o[g][c] = (f32x4){0.f, 0.f, 0.f, 0.f}; }
#pragma unroll
        for (int p = 0; p < NPV; ++p) {
            const int m = p + PFD - 1;
            if (m < NPV) { if (m < NP) na2_load(ring[m % PFD], m, P, proj, kofs, vofs); }
            else { if (m - NPV < NP) na2_load(ring[m % PFD], m - NPV, PN, proj, kofs, vofs); }
            if (p >= NP) continue;
            const PairRegs& R = ring[p % PFD];
            LAS unsigned char* vbuf = vst + (p % 3) * 5120;
#pragma unroll
            for (int ab = 0; ab < 2; ++ab) { *(LAS u32x4*)(vbuf + ab * 2560 + wofs) = R.v[ab][0]; *(LAS u32x4*)(vbuf + ab * 2560 + wofs + 8 * 160) = R.v[ab][1]; }
            asm volatile("s_waitcnt lgkmcnt(0)" ::: "memory");
            bf16x8 vt[4];
#pragma unroll
            for (int c = 0; c < 4; ++c) {
                const s16x4 ta = __builtin_amdgcn_ds_read_tr16_b64_v4i16((LAS s16x4*)(vbuf + trofs + c * 32));
                const s16x4 tb = __builtin_amdgcn_ds_read_tr16_b64_v4i16((LAS s16x4*)(vbuf + 2560 + trofs + c * 32));
                vt[c] = (bf16x8){ta[0], ta[1], ta[2], ta[3], tb[0], tb[1], tb[2], tb[3]};
            }
#pragma unroll
            for (int g = 0; g < 2; ++g) {
                if (g == 0 && p == 8) continue;
                const bool act = (g == 0) ? true : (p == 0 ? P.d1 == 0 : (p == 8 ? P.d1 == 1 : true));
                const LAS float* brow = P.bb + (p - g) * 31;
                f32x4 pr[2];
#pragma unroll
                for (int hh = 0; hh < 2; ++hh) {
                    f32x4 s = {0.f, 0.f, 0.f, 0.f};
                    s = __builtin_amdgcn_mfma_f32_16x16x32_bf16(R.k[hh][0], q[g][0], s, 0, 0, 0);
                    s = __builtin_amdgcn_mfma_f32_16x16x32_bf16(R.k[hh][1], q[g][1], s, 0, 0, 0);
#pragma unroll
                    for (int e = 0; e < 4; ++e) { const int kc = P.kc0 + 16 * hh + 4 * fq + e; const bool valid = act && (kc >= P.cs) && (kc < P.cs + 16);
                        int dc = kc - P.qc + 15; dc = dc < 0 ? 0 : (dc > 30 ? 30 : dc);
                        const float ex = __builtin_amdgcn_exp2f(s[e] + brow[dc]); pr[hh][e] = valid ? ex : 0.f; l[g] += pr[hh][e]; }
                }
                union { u32x4 u; bf16x8 h; } pp; pp.u.x = pk_bf16(pr[0][0], pr[0][1]); pp.u.y = pk_bf16(pr[0][2], pr[0][3]); pp.u.z = pk_bf16(pr[1][0], pr[1][1]); pp.u.w = pk_bf16(pr[1][2], pr[1][3]);
#pragma unroll
                for (int c = 0; c < 4; ++c) o[g][c] = __builtin_amdgcn_mfma_f32_16x16x32_bf16(vt[c], pp.h, o[g][c], 0, 0, 0);
            }
        }
#pragma unroll
        for (int g = 0; g < 2; ++g) attn_store(mixed + (size_t)(P.orow + g * 64) * DM + 384 + P.h * 64, o[g], l[g], fq);
        if (!has_next) break;
        it = itn; P = PN;
#pragma unroll
        for (int g = 0; g < 2; ++g) { q[g][0] = qn[g][0]; q[g][1] = qn[g][1]; }
    }
}

constexpr int DIL_NG = CFG_NG, DIL_PF = CFG_PF;
__device__ __forceinline__ void mix_a(const Params& p, int layer, LAS unsigned char* lds, int tid, int lane, int wave) {
    unsigned char* ws = p.ws; const bf16_t* proj = (const bf16_t*)(ws + WS_PROJ); bf16_t* mixed = (bf16_t*)(ws + WS_MIXED);
    LAS float* tbl = (LAS float*)(lds + 131072);
    for (int i = tid; i < 4 * 465; i += 512) tbl[i] = p.rpb[layer * 4 * 465 + i] * LOG2E;
    __syncthreads();
    LAS unsigned char* vst = lds + wave * 16384;
    const int vcu = (gridDim.x % 8 == 0) ? (int)(blockIdx.x % 8) * (int)(gridDim.x / 8) + (int)(blockIdx.x / 8) : (int)blockIdx.x;
    const int gw = vcu * NWAVES + wave, NGW = gridDim.x * NWAVES;
    na2_stream<2>(proj, mixed, vst, tbl, gw, NGW, lane);
    dilu_stream<16, DIL_NG, 0, DIL_PF>(proj, mixed, (bf16_t*)(ws + WS_Y), (float*)(ws + WS_Y + 128 * MiB), vst, (unsigned*)(ws + WS_QCTR) + ((layer * 3 + 0) * 8 + (int)(blockIdx.x & 7)) * 64, (int)(blockIdx.x & 7), lane);
}
__device__ __forceinline__ void mix_b(const Params& p, int layer, LAS unsigned char* lds, int tid, int lane, int wave) {
    unsigned char* ws = p.ws; const bf16_t* proj = (const bf16_t*)(ws + WS_PROJ); bf16_t* mixed = (bf16_t*)(ws + WS_MIXED);
    LAS unsigned char* vst = lds + wave * 16384;
    const int vcu = (gridDim.x % 8 == 0) ? (int)(blockIdx.x % 8) * (int)(gridDim.x / 8) + (int)(blockIdx.x / 8) : (int)blockIdx.x;
    const int gw = vcu * NWAVES + wave, NGW = gridDim.x * NWAVES;
    const float* cw = p.conv_w + layer * 3 * 384;
    for (int idx = blockIdx.x * 512 + tid; idx < M_TOK * 48; idx += gridDim.x * 512) {
        const int row = idx / 48, c0 = (idx - row * 48) * 8;
        int S, seq0; seq_of_row(row, S, seq0); const int pos = row - seq0;
        const bf16_t* base = proj + PB_CV + (size_t)row * DCV + c0;
        const u32x4 gb = *(const u32x4*)base;
        float acc[8];
#pragma unroll
        for (int k = 0; k < 8; ++k) acc[k] = 0.f;
#pragma unroll
        for (int j = 0; j < 3; ++j) {
            const int pp = pos + j - 1;
            if (pp >= 0 && pp < S) {
                const bf16_t* bj = base + (ptrdiff_t)(j - 1) * DCV;
                const u32x4 gc = *(const u32x4*)(bj + 384), hi = *(const u32x4*)(bj + 768);
                const f32x4 w0 = *(const f32x4*)(cw + j * 384 + c0), w1 = *(const f32x4*)(cw + j * 384 + c0 + 4);
                acc[0] += w0[0] * bf_lo(gc.x) * bf_lo(hi.x); acc[1] += w0[1] * bf_hi(gc.x) * bf_hi(hi.x);
                acc[2] += w0[2] * bf_lo(gc.y) * bf_lo(hi.y); acc[3] += w0[3] * bf_hi(gc.y) * bf_hi(hi.y);
                acc[4] += w1[0] * bf_lo(gc.z) * bf_lo(hi.z); acc[5] += w1[1] * bf_hi(gc.z) * bf_hi(hi.z);
                acc[6] += w1[2] * bf_lo(gc.w) * bf_lo(hi.w); acc[7] += w1[3] * bf_hi(gc.w) * bf_hi(hi.w);
            }
        }
        u32x4 w; w.x = pk_bf16(acc[0] * bf_lo(gb.x), acc[1] * bf_hi(gb.x)); w.y = pk_bf16(acc[2] * bf_lo(gb.y), acc[3] * bf_hi(gb.y));
        w.z = pk_bf16(acc[4] * bf_lo(gb.z), acc[5] * bf_hi(gb.z)); w.w = pk_bf16(acc[6] * bf_lo(gb.w), acc[7] * bf_hi(gb.w));
        *(u32x4*)(mixed + (size_t)row * DM + 640 + c0) = w;
    }
    dilu_stream<4, DIL_NG, 1, DIL_PF>(proj, mixed, (bf16_t*)(ws + WS_Y), (float*)(ws + WS_Y + 128 * MiB), vst, (unsigned*)(ws + WS_QCTR) + ((layer * 3 + 1) * 8 + (int)(blockIdx.x & 7)) * 64, (int)(blockIdx.x & 7), lane);
}
__device__ __forceinline__ void mix_c(const Params& p, int layer, LAS unsigned char* lds, int lane, int wave) {
    unsigned char* ws = p.ws; const bf16_t* proj = (const bf16_t*)(ws + WS_PROJ); bf16_t* mixed = (bf16_t*)(ws + WS_MIXED);
    LAS unsigned char* vst = lds + wave * 16384;
    const int vcu = (gridDim.x % 8 == 0) ? (int)(blockIdx.x % 8) * (int)(gridDim.x / 8) + (int)(blockIdx.x / 8) : (int)blockIdx.x;
    const int gw = vcu * NWAVES + wave, NGW = gridDim.x * NWAVES;
    dilu_stream<1, DIL_NG, 2, DIL_PF>(proj, mixed, (bf16_t*)(ws + WS_Y), (float*)(ws + WS_Y + 128 * MiB), vst, (unsigned*)(ws + WS_QCTR) + ((layer * 3 + 2) * 8 + (int)(blockIdx.x & 7)) * 64, (int)(blockIdx.x & 7), lane);
}

#define XB_TMO      128
#define XB_XCNT(j)  (256  + 64 * (j))
#define XB_XSUB(j)  (1280 + 64 * (j))
#define XB_XGEN(j)  (2304 + 64 * (j))
#define XB_TOP      3328
#define XB_TOPGEN   3392
#define XCD_BAR_WORDS 3456
#define XB_SPIN_CAP (1u << 18)

__device__ __forceinline__ unsigned xb_ld(unsigned* p)              { return __hip_atomic_load(p, __ATOMIC_RELAXED, __HIP_MEMORY_SCOPE_AGENT); }
__device__ __forceinline__ unsigned xb_add(unsigned* p, unsigned v) { return __hip_atomic_fetch_add(p, v, __ATOMIC_RELAXED, __HIP_MEMORY_SCOPE_AGENT); }
__device__ __forceinline__ unsigned xb_xcc_id() { return (unsigned)__builtin_amdgcn_s_getreg((3 << 11) | 20) & 0xFu; }
#define XB_SPIN(cond, bar) do { unsigned _sp = 0; while (cond) { __builtin_amdgcn_s_sleep(1); \
    if ((++_sp & 255u) == 0u) { if (xb_ld(&(bar)[XB_TMO])) break; if (_sp > XB_SPIN_CAP) { atomicAdd(&(bar)[XB_TMO], 1u); break; } } } } while (0)

struct XcdBarrier {
    unsigned* bar; unsigned x;
    volatile LAS unsigned* st;
};

__device__ __forceinline__ XcdBarrier xcd_barrier_post(unsigned* bar, volatile LAS unsigned* st) {
    XcdBarrier b; b.bar = bar; b.x = xb_xcc_id(); b.st = st;
    if (threadIdx.x == 0) (void)xb_add(&bar[XB_XCNT(b.x)], 1u);
    return b;
}
__device__ __forceinline__ void xcd_barrier_complete(unsigned* bar, unsigned x, unsigned& nloc, unsigned& nx) {
    const unsigned G = gridDim.x * gridDim.y * gridDim.z;
    unsigned sum, cnt, mine, sp = 0u;
    for (;;) {
        sum = 0u; cnt = 0u; mine = 0u;
#pragma unroll
        for (unsigned j = 0; j < 16; ++j) { const unsigned c = xb_ld(&bar[XB_XCNT(j)]); sum += c; cnt += (c > 0u) ? 1u : 0u; mine = (j == x) ? c : mine; }
        if (sum == G) break;
        __builtin_amdgcn_s_sleep(1);
        if ((++sp & 255u) == 0u) { if (xb_ld(&bar[XB_TMO])) break; if (sp > XB_SPIN_CAP) { atomicAdd(&bar[XB_TMO], 1u); break; } }
    }
    nloc = mine > 0u ? mine : 1u; nx = cnt > 0u ? cnt : 1u;
}

__device__ __forceinline__ void xcd_barrier(const XcdBarrier& b) {
    asm volatile("s_waitcnt vmcnt(0)" ::: "memory");
    __syncthreads();
    if (threadIdx.x == 0) {
        unsigned* bar = b.bar;
        __builtin_amdgcn_s_waitcnt(0);
        unsigned nloc = b.st[0], nx = b.st[1];
        if (nloc == 0u) { xcd_barrier_complete(bar, b.x, nloc, nx); b.st[0] = nloc; b.st[1] = nx; }
        const unsigned old = xb_add(&bar[XB_XSUB(b.x)], 1u);
        const unsigned gen = old / nloc;
        if (old + 1u == (gen + 1u) * nloc) {
            __builtin_amdgcn_fence(__ATOMIC_RELEASE, "agent");
            asm volatile("s_waitcnt vmcnt(0)" ::: "memory");
            const unsigned og = xb_add(&bar[XB_TOP], 1u);
            const unsigned tg = og / nx;
            if (og + 1u == (tg + 1u) * nx) xb_add(&bar[XB_TOPGEN], 1u);
            else XB_SPIN(xb_ld(&bar[XB_TOPGEN]) == tg, bar);
            __builtin_amdgcn_fence(__ATOMIC_ACQUIRE, "agent");
            xb_add(&bar[XB_XGEN(b.x)], 1u);
            asm volatile("s_waitcnt vmcnt(0)" ::: "memory");
        } else {
            XB_SPIN(xb_ld(&bar[XB_XGEN(b.x)]) == gen, bar);
            __builtin_amdgcn_fence(__ATOMIC_ACQUIRE, "agent");
            asm volatile("s_waitcnt vmcnt(0)" ::: "memory");
        }
    }
    __syncthreads();
}

__global__ void __launch_bounds__(512) fwd_mega(Params p) {
    extern __shared__ __attribute__((aligned(16))) unsigned char lds_raw[];
    LAS unsigned char* lds = (LAS unsigned char*)lds_raw;
    cg::grid_group grid = cg::this_grid();
    unsigned char* ws = p.ws;
#define FRESH_TID() int tid = threadIdx.x; asm volatile("" : "+v"(tid)); const int lane = tid & 63, wave = __builtin_amdgcn_readfirstlane(tid >> 6)
    bf16_t* xb = (bf16_t*)(ws + WS_XB); bf16_t* proj = (bf16_t*)(ws + WS_PROJ); bf16_t* mixed = (bf16_t*)(ws + WS_MIXED); bf16_t* Y = (bf16_t*)(ws + WS_Y); bf16_t* H = (bf16_t*)(ws + WS_H);
    const unsigned short* rs = (const unsigned short*)(ws + WS_RS);

    if (threadIdx.x < 4) ((volatile LAS unsigned*)(lds + 139264))[threadIdx.x] = 0u;
    __syncthreads();
    const XcdBarrier xbar = xcd_barrier_post((unsigned*)(ws + WS_CTL), (volatile LAS unsigned*)(lds + 139264));
    { FRESH_TID(); prologue(p, lds, tid, lane, wave); }
    grid.sync();
    for (int layer = 0; layer < 2; ++layer) {
        {
            pg8::Gemm g{xb, (const bf16_t*)(ws + WS_WIN) + (size_t)layer * DIN * DM, M_TOK, DIN, DM}; pg8::StaticOrder S; S.init(M_TOK, DIN, (int)gridDim.x, (int)blockIdx.x);
            EpiProj E{proj, rs, (const unsigned*)(ws + WS_COS)};
            pg8::gemm_phase<EpiProj, pg8::StaticOrder>(lds, g, S, E);
        }
        xcd_barrier(xbar);
        { FRESH_TID(); mix_a(p, layer, lds, tid, lane, wave); }
        xcd_barrier(xbar);
        { FRESH_TID(); mix_b(p, layer, lds, tid, lane, wave); }
        xcd_barrier(xbar);
        { FRESH_TID(); (void)tid; mix_c(p, layer, lds, lane, wave); }
        xcd_barrier(xbar);
        {
            pg8::Gemm g{mixed, (const bf16_t*)(ws + WS_WOUT) + (size_t)layer * DM * DM, M_TOK, DM, DM}; pg8::StaticOrder S; S.init(M_TOK, DM, (int)gridDim.x, (int)blockIdx.x);
            EpiPlain E{Y, DM};
            pg8::gemm_phase<EpiPlain, pg8::StaticOrder>(lds, g, S, E);
        }
        xcd_barrier(xbar);
        { FRESH_TID(); (void)tid; ew_phase<false>(p, p.g_post_mix + layer * DM, lane, wave); }
        xcd_barrier(xbar);
        {
            pg8::Gemm g{xb, (const bf16_t*)(ws + WS_WGU) + (size_t)layer * 2 * DFF * DM, M_TOK, 2 * DFF, DM}; pg8::StaticOrder S; S.init(M_TOK, 2 * DFF, (int)gridDim.x, (int)blockIdx.x);
            EpiSwiglu E{H, rs};
            pg8::gemm_phase<EpiSwiglu, pg8::StaticOrder>(lds, g, S, E);
        }
        xcd_barrier(xbar);
        {
            pg8::Gemm g{H, (const bf16_t*)(ws + WS_WDN) + (size_t)layer * DM * DFF, M_TOK, DM, DFF}; pg8::StaticOrder S; S.init(M_TOK, DM, (int)gridDim.x, (int)blockIdx.x);
            if (layer == 0) { EpiPlain E{Y, DM}; pg8::gemm_phase<EpiPlain, pg8::StaticOrder>(lds, g, S, E); }
            else { EpiNormOut E{ws, p.out, p.g_post_ffn + layer * DM, lds}; pg8::gemm_phase<EpiNormOut, pg8::StaticOrder>(lds, g, S, E); }
        }
        if (layer == 0) { xcd_barrier(xbar); { FRESH_TID(); (void)tid; ew_phase<false>(p, p.g_post_ffn + layer * DM, lane, wave); } xcd_barrier(xbar); }
    }
}

extern "C" void kernel_launch(void* const* d_in, const int* in_sizes, int n_in, void* d_out, int out_size, void* d_ws, size_t ws_size, hipStream_t stream) {
    static int grid_blocks = 0;
    if (!grid_blocks) {
        if (n_in != 13 || out_size != M_TOK * DM || ws_size < WS_END) { fprintf(stderr, "kernel_launch: unexpected sizes (n_in %d out %d ws %zu)\n", n_in, out_size, ws_size); grid_blocks = -1; return; }
        int dev = 0, cus = 0, per_cu = 0;
        hipGetDevice(&dev); hipDeviceGetAttribute(&cus, hipDeviceAttributeMultiprocessorCount, dev);
        hipFuncSetAttribute((const void*)fwd_mega, hipFuncAttributeMaxDynamicSharedMemorySize, LDS_BYTES);
        hipOccupancyMaxActiveBlocksPerMultiprocessor(&per_cu, (const void*)fwd_mega, 512, LDS_BYTES);
        if (per_cu < 1) { fprintf(stderr, "kernel_launch: occupancy query says %d blocks per CU\n", per_cu); per_cu = 1; }
        (void)hipGetLastError();
        grid_blocks = cus * per_cu;
    }
    if (grid_blocks < 0) return;
    Params p{};
    p.x_p = (const float*)d_in[0]; p.x_s = (const float*)d_in[1]; p.g_pre_mix = (const float*)d_in[2]; p.w_in = (const float*)d_in[3]; p.conv_w = (const float*)d_in[4];
    p.rpb = (const float*)d_in[5]; p.w_out = (const float*)d_in[6]; p.g_post_mix = (const float*)d_in[7]; p.g_pre_ffn = (const float*)d_in[8]; p.w_gate = (const float*)d_in[9];
    p.w_up = (const float*)d_in[10]; p.w_down = (const float*)d_in[11]; p.g_post_ffn = (const float*)d_in[12]; p.out = (float*)d_out; p.ws = (unsigned char*)d_ws;
    if (hipMemsetAsync((char*)d_ws + WS_CTL, 0, CTL_BYTES, stream) != hipSuccess) { fprintf(stderr, "kernel_launch: memset of the barrier words failed\n"); return; }
    void* args[] = {&p};
    hipError_t e = hipLaunchCooperativeKernel((const void*)fwd_mega, dim3(grid_blocks), dim3(512), args, LDS_BYTES, stream);
    if (e != hipSuccess) fprintf(stderr, "cooperative launch failed: %s (grid %d)\n", hipGetErrorString(e), grid_blocks);
}
```
